# Optimizing an MI355X kernel written in HIP

```python
import math
import jax, jax.numpy as jnp
from jax import lax
import numpy as np

D_MODEL = 1024
BATCH = 8
SEQ = 4096
DEPTH = 2

N_A_LAYERS = (DEPTH + 1) // 2
N_B_LAYERS = DEPTH - N_A_LAYERS
HEAD_DIM = 64
N_HEADS = D_MODEL // (2 * HEAD_DIM)
DIL_GROUPS = ((128, 1), (512, 4), (2048, 16))
N_GROUPS = len(DIL_GROUPS)
ATTN_BLOCK = 128
DIFF_V_DIM = 2 * HEAD_DIM
D_FF = ((8 * D_MODEL // 3 + 127) // 128) * 128
CONV_WIDTH = 3
NUM_BUCKETS = 32
MAX_DISTANCE = 2048
RMS_EPS = 1e-6
SUBLN_EPS = 1e-5

kernel_name = 'hybrid_dilated_diffattn_yoco'


def rms_norm(x, g, eps=RMS_EPS):
    xf = x.astype(jnp.float32)
    y = xf * lax.rsqrt(jnp.mean(xf * xf, axis=-1, keepdims=True) + eps)
    return (y * g.astype(jnp.float32)).astype(x.dtype)


def rel_bias(table, dist):
    n = jnp.maximum(dist, 0)
    max_exact = NUM_BUCKETS // 2
    nf = jnp.maximum(n, 1).astype(jnp.float32)
    large = max_exact + (jnp.log(nf / max_exact) / math.log(MAX_DISTANCE / max_exact)
                         * (NUM_BUCKETS - max_exact)).astype(jnp.int32)
    large = jnp.minimum(large, NUM_BUCKETS - 1)
    bucket = jnp.where(n < max_exact, n, large)
    return jnp.take(table, bucket, axis=1).astype(jnp.float32)


def dilated_group_attention(q, k, v, table, window, dilation):
    b, s, h, dh = q.shape
    r = dilation
    n = s // r
    wu = window // dilation
    nb = -(-n // ATTN_BLOCK)
    n_p = nb * ATTN_BLOCK

    def to_blocks(t):
        t = t.reshape(b, n, r, h, dh)
        t = jnp.pad(t, ((0, 0), (0, n_p - n), (0, 0), (0, 0), (0, 0)))
        return t.reshape(b, nb, ATTN_BLOCK, r, h, dh)

    def with_prev(t):
        prev = jnp.pad(t, ((0, 0), (1, 0), (0, 0), (0, 0), (0, 0), (0, 0)))[:, :-1]
        return jnp.concatenate([prev, t], axis=2)

    qb = to_blocks(q)
    kc = with_prev(to_blocks(k))
    vc = with_prev(to_blocks(v))

    qi = jnp.arange(ATTN_BLOCK)[:, None]
    ki = jnp.arange(2 * ATTN_BLOCK)[None, :]
    dist_u = qi + ATTN_BLOCK - ki
    band = (dist_u >= 0) & (dist_u <= wu)
    has_prev = (jnp.arange(nb)[:, None, None] > 0) | (ki[None] >= ATTN_BLOCK)
    mask = band[None] & has_prev
    bias = rel_bias(table, dist_u * r)

    logits = jnp.einsum('bnqrhd,bnkrhd->bnrhqk', qb, kc,
                        preferred_element_type=jnp.float32) * (dh ** -0.5) + bias[None, None, None]
    logits = jnp.where(mask[None, :, None, None], logits, -jnp.inf)
    m = jnp.max(logits, axis=-1, keepdims=True)
    p = jnp.exp(logits - m)
    den = jnp.sum(p, axis=-1, keepdims=True)
    o = jnp.einsum('bnrhqk,bnkrhd->bnqrhd', p / den, vc.astype(jnp.float32))
    lse = (m + jnp.log(den))[..., 0]

    o = o.reshape(b, n_p, r, h, dh)[:, :n].reshape(b, s, h, dh)
    lse = lse.transpose(0, 1, 4, 2, 3).reshape(b, n_p, r, h)[:, :n].reshape(b, s, h)
    return o, lse


def dilated_mixer(x, w_in, w_out, table):
    b, s, _ = x.shape
    proj = (x @ w_in).reshape(b, s, N_GROUPS, 3, N_HEADS, HEAD_DIM)
    outs, lses = [], []
    for g, (window, dil) in enumerate(DIL_GROUPS):
        o, lse = dilated_group_attention(proj[:, :, g, 0], proj[:, :, g, 1], proj[:, :, g, 2],
                                         table, window, dil)
        outs.append(o)
        lses.append(lse)
    alpha = jax.nn.softmax(jnp.stack(lses, axis=-1), axis=-1)
    o = jnp.einsum('gbshd,bshg->bshd', jnp.stack(outs), alpha)
    return o.reshape(b, s, N_HEADS * HEAD_DIM).astype(x.dtype) @ w_out


def diff_mixer(x, k_sh, v_sh, w_q, lq1, lk1, lq2, lk2, subln_g, w_out, table, lambda_init):
    b, s, _ = x.shape
    q = (x @ w_q).reshape(b, s, N_HEADS, 2, HEAD_DIM)
    f32 = jnp.float32
    lam = (jnp.exp(jnp.sum(lq1.astype(f32) * lk1.astype(f32)))
           - jnp.exp(jnp.sum(lq2.astype(f32) * lk2.astype(f32))) + lambda_init)
    nq = s // ATTN_BLOCK
    qb = q.reshape(b, nq, ATTN_BLOCK, N_HEADS, 2, HEAD_DIM).transpose(1, 0, 2, 3, 4, 5)
    kpos = jnp.arange(s)
    scale = HEAD_DIM ** -0.5

    def block(args):
        i, qblk = args
        qpos = i * ATTN_BLOCK + jnp.arange(ATTN_BLOCK)
        dist = qpos[:, None] - kpos[None, :]
        bias = rel_bias(table, dist)
        logits = jnp.einsum('bqhcd,bkhcd->bhcqk', qblk, k_sh,
                            preferred_element_type=f32) * scale + bias[None, :, None]
        logits = jnp.where(dist >= 0, logits, -jnp.inf)
        p = jax.nn.softmax(logits, axis=-1)
        a = p[:, :, 0] - lam * p[:, :, 1]
        return jnp.einsum('bhqk,bkhe->bqhe', a, v_sh.astype(f32))

    o = lax.map(block, (jnp.arange(nq), qb))
    o = o.transpose(1, 0, 2, 3, 4).reshape(b, s, N_HEADS, DIFF_V_DIM)
    o = rms_norm(o, subln_g, SUBLN_EPS) * (1.0 - lambda_init)
    return o.reshape(b, s, N_HEADS * DIFF_V_DIM).astype(x.dtype) @ w_out


def conv_ffn(x, w_up, conv_w, conv_b, w_down):
    s = x.shape[1]
    u = x @ w_up
    up = jnp.pad(u, ((0, 0), (CONV_WIDTH - 1, 0), (0, 0)))
    c = conv_b
    for j in range(CONV_WIDTH):
        c = c + conv_w[j] * up[:, j:j + s]
    gate, val = jnp.split(c, 2, axis=-1)
    return (jax.nn.gelu(gate, approximate=False) * val) @ w_down


def setup_inputs(seed: int = 0) -> dict:
    key = jax.random.key(seed)
    ks = jax.random.split(key, 20)
    f32 = jnp.float32
    D = D_MODEL
    qkv_a = N_GROUPS * 3 * N_HEADS * HEAD_DIM
    a_width = N_HEADS * HEAD_DIM
    qk_b = N_HEADS * 2 * HEAD_DIM
    v_b = N_HEADS * DIFF_V_DIM
    nrm = lambda k, shp: jax.random.normal(k, shp, f32)
    return {
        'x': nrm(ks[0], (BATCH, SEQ, D)),
        'rel_bias_table': 0.2 * nrm(ks[1], (N_HEADS, NUM_BUCKETS)),
        'norm_g': 1.0 + 0.05 * nrm(ks[2], (DEPTH, 4, D)),
        'w_in_a': nrm(ks[3], (N_A_LAYERS, D, qkv_a)) * D ** -0.5,
        'w_out_a': nrm(ks[4], (N_A_LAYERS, a_width, D)) * a_width ** -0.5,
        'kv_norm_g': 1.0 + 0.05 * nrm(ks[5], (D,)),
        'w_k_shared': nrm(ks[6], (D, qk_b)) * D ** -0.5,
        'w_v_shared': nrm(ks[7], (D, v_b)) * D ** -0.5,
        'w_q_b': nrm(ks[8], (N_B_LAYERS, D, qk_b)) * D ** -0.5,
        'lam_q1': 0.1 * nrm(ks[9], (N_B_LAYERS, HEAD_DIM)),
        'lam_k1': 0.1 * nrm(ks[10], (N_B_LAYERS, HEAD_DIM)),
        'lam_q2': 0.1 * nrm(ks[11], (N_B_LAYERS, HEAD_DIM)),
        'lam_k2': 0.1 * nrm(ks[12], (N_B_LAYERS, HEAD_DIM)),
        'subln_g': 1.0 + 0.05 * nrm(ks[13], (N_B_LAYERS, DIFF_V_DIM)),
        'w_out_b': nrm(ks[14], (N_B_LAYERS, v_b, D)) * v_b ** -0.5,
        'w_up': nrm(ks[15], (DEPTH, D, 2 * D_FF)) * D ** -0.5,
        'conv_w': nrm(ks[16], (DEPTH, CONV_WIDTH, 2 * D_FF)) * CONV_WIDTH ** -0.5,
        'conv_b': 0.02 * nrm(ks[17], (DEPTH, 2 * D_FF)),
        'w_down': nrm(ks[18], (DEPTH, D_FF, D)) * D_FF ** -0.5,
    }


def reference(x, rel_bias_table, norm_g, w_in_a, w_out_a, kv_norm_g, w_k_shared, w_v_shared,
              w_q_b, lam_q1, lam_k1, lam_q2, lam_k2, subln_g, w_out_b, w_up, conv_w, conv_b,
              w_down):
    b, s, _ = x.shape
    h = x
    k_shared = None
    v_shared = None
    for layer in range(DEPTH):
        g = norm_g[layer]
        if layer < N_A_LAYERS:
            mix = dilated_mixer(rms_norm(h, g[0]), w_in_a[layer], w_out_a[layer], rel_bias_table)
        else:
            j = layer - N_A_LAYERS
            lambda_init = 0.8 - 0.6 * math.exp(-0.3 * layer)
            mix = diff_mixer(rms_norm(h, g[0]), k_shared, v_shared, w_q_b[j],
                             lam_q1[j], lam_k1[j], lam_q2[j], lam_k2[j], subln_g[j],
                             w_out_b[j], rel_bias_table, lambda_init)
        h = h + rms_norm(mix, g[1])
        ff = conv_ffn(rms_norm(h, g[2]), w_up[layer], conv_w[layer], conv_b[layer], w_down[layer])
        h = h + rms_norm(ff, g[3])
        if layer == N_A_LAYERS - 1:
            kv_src = rms_norm(h, kv_norm_g)
            k_shared = (kv_src @ w_k_shared).reshape(b, s, N_HEADS, 2, HEAD_DIM)
            v_shared = (kv_src @ w_v_shared).reshape(b, s, N_HEADS, DIFF_V_DIM)
    return h
```

```cpp
#include <hip/hip_runtime.h>
#include <cstdio>
#include <cstdint>
namespace pg8 {
#define PG8_LAS __attribute__((address_space(3)))
typedef unsigned short bf16_t;
typedef short bf16x8 __attribute__((ext_vector_type(8)));
typedef float f32x4 __attribute__((ext_vector_type(4)));
typedef unsigned u32x4 __attribute__((ext_vector_type(4)));
constexpr int BM = 256, BK = 64, HALF = 128, HTB = HALF * BK * 2  , STAGE_BYTES = 8 * HTB, NXCD = 8, WGM = 8;

__host__ __device__ __forceinline__ int lds_byte(int r, int c) { const int st = (r >> 4) * 2 + (c >> 5), rr = r & 15, cc = c & 31, ob = rr * 64 + cc * 2; return st * 1024 + (ob ^ (((ob >> 9) & 1) << 5)); }
__host__ __device__ __forceinline__ void stage_rc(int b, int& R, int& C) { const int st = b / 1024, sb = b % 1024, swz = sb ^ (((sb >> 9) & 1) << 5); R = (st >> 1) * 16 + swz / 64; C = (st & 1) * 32 + (swz % 64) / 2; }
__host__ __device__ __forceinline__ int perm32(int rho) { const int n = rho >> 4, i = rho & 15; return 8 * (i >> 2) + 4 * n + (i & 3); }

struct Unit { int pm, pn; };
struct Gemm { const bf16_t* A; const bf16_t* Bt; int M, N, K; };

struct StaticOrder {
    int nM, nN, nwg, G, c;
    __host__ __device__ void init(int M, int N, int G_, int c_) { nM = M / BM; nN = N / BM; nwg = nM * nN; G = G_; c = c_; }
    __host__ __device__ bool next(int i, Unit& u) const {
        const long L = (long)i * G + c; if (L >= nwg) return false;
        int wgid = (int)L; { const int q = nwg / NXCD, r = nwg % NXCD, xcd = wgid % NXCD, off = wgid / NXCD; wgid = (xcd < r ? xcd * (q + 1) : r * (q + 1) + (xcd - r) * q) + off; }
        const int nig = WGM * nN, gid = wgid / nig, fm = gid * WGM, gsz = (nM - fm) < WGM ? (nM - fm) : WGM;
        u.pm = fm + ((wgid % nig) % gsz); u.pn = (wgid % nig) / gsz; return true;
    }
    __device__ __forceinline__ void a_ready(const Unit&) const {}
    __device__ __forceinline__ void done(const Unit&) const {}
};

__device__ __forceinline__ unsigned cvt_pk_bf16(float lo, float hi) { unsigned r; asm volatile("v_cvt_pk_bf16_f32 %0, %1, %2" : "=v"(r) : "v"(lo), "v"(hi)); return r; }
typedef float f32x2 __attribute__((ext_vector_type(2)));
__device__ __forceinline__ f32x2 gelu_pk(f32x2 v) {
    const f32x2 av = __builtin_elementwise_abs(v), d = av * 0.2316418882f + 1.0f;
    f32x2 t; t.x = __builtin_amdgcn_rcpf(d.x); t.y = __builtin_amdgcn_rcpf(d.y);
    f32x2 q = t * 0.5307027145f + (-0.7265760135f); q = q * t + 0.7107068705f; q = q * t + (-0.142248368f); q = q * t + 0.127414796f; q = q * t;
    const f32x2 s = (v * v) * (-0.72134752044f);
    f32x2 e; e.x = __builtin_amdgcn_exp2f(s.x); e.y = __builtin_amdgcn_exp2f(s.y);
    const f32x2 m = v * (q * e), r = v - m;
    f32x2 o; o.x = v.x < 0.f ? m.x : r.x; o.y = v.y < 0.f ? m.y : r.y; return o;
}

template <int ACT  > struct EpiBf16 {
    static constexpr bool PERM = true, AFTER_DRAIN = false; static_assert(ACT == 0 || ACT == 1, "EpiBf16: ACT is 0 (none) or 1 (gelu_pk)");
    bf16_t* O; int ldc; const float* bias; int split_cols; size_t split_stride; float scale0;
    __device__ __forceinline__ void operator()(const f32x4 (&acc)[2][2][4][2], const Unit& u, int wr, int wc, int fr, int fq) const {
        const int row0 = u.pm * BM + wr * 64 + fr; int colt = u.pn * BM; bf16_t* base = O;
        float sc = 1.f; if (split_cols) { const int t = colt / split_cols; base += (size_t)t * split_stride; colt -= t * split_cols; if (t == 0) sc = scale0; }
        const int col0 = colt + wc * 32 + 8 * fq, bcol0 = u.pn * BM + wc * 32 + 8 * fq;
        f32x4 bv[2][2];
#pragma unroll
        for (int bj = 0; bj < 2; ++bj)
#pragma unroll
            for (int n = 0; n < 2; ++n) bv[bj][n] = bias ? *(const f32x4*)(bias + bcol0 + bj * HALF + 4 * n) : (f32x4){0.f, 0.f, 0.f, 0.f};
#pragma unroll
        for (int ai = 0; ai < 2; ++ai)
#pragma unroll
            for (int m = 0; m < 4; ++m) { bf16_t* rowp = base + (size_t)(row0 + ai * HALF + m * 16) * ldc + col0;
#pragma unroll
                for (int bj = 0; bj < 2; ++bj) { f32x4 v0 = acc[ai][bj][m][0] + bv[bj][0], v1 = acc[ai][bj][m][1] + bv[bj][1];
                    if (ACT == 1) { f32x2 a = gelu_pk((f32x2){v0[0], v0[1]}), b = gelu_pk((f32x2){v0[2], v0[3]}), c = gelu_pk((f32x2){v1[0], v1[1]}), d = gelu_pk((f32x2){v1[2], v1[3]});
                        v0 = (f32x4){a.x, a.y, b.x, b.y}; v1 = (f32x4){c.x, c.y, d.x, d.y}; }
                    v0 = v0 * sc; v1 = v1 * sc; u32x4 w; w.x = cvt_pk_bf16(v0[0], v0[1]); w.y = cvt_pk_bf16(v0[2], v0[3]); w.z = cvt_pk_bf16(v1[0], v1[1]); w.w = cvt_pk_bf16(v1[2], v1[3]);
                    *(u32x4*)(rowp + bj * HALF) = w; } }
    }
};
template <class Epi, class Sched, bool ALIGN_EPI = false, bool SP2 = false>
__device__ __forceinline__ void gemm_phase(PG8_LAS unsigned char* lds, const Gemm g, const Sched& S, const Epi& E) {
    const int tid = threadIdx.x, wid = __builtin_amdgcn_readfirstlane(tid >> 6), lane = tid & 63, wr = wid >> 2, wc = wid & 3, fr = lane & 15, fq = lane >> 4;
    const int K = g.K, nt = K / BK;
    unsigned voffA[2], voffB[2];
#pragma unroll
    for (int i = 0; i < 2; ++i) { int R, C; stage_rc(tid * 16 + i * 8192, R, C); const int Rb = Epi::PERM ? ((R & ~31) + perm32(R & 31)) : R;
        voffA[i] = (unsigned)(R * K + C) * 2u; voffB[i] = (unsigned)(Rb * K + C) * 2u; }
    const size_t kstep = (size_t)(BK * 2);
    const size_t hstep = (size_t)HALF * K * 2;
    const size_t tstep = 2 * hstep;
    const unsigned ldsw = (unsigned)wid * 1024u;
    const int aoff = lds_byte(wr * 64 + fr, fq * 8), boff = lds_byte(wc * 32 + fr, fq * 8);
#define PG8_SA(b, h) (((b) * 2 + (h)) * HTB)
#define PG8_SB(b, h) ((4 + (b) * 2 + (h)) * HTB)
#define PG8_STAGE(bufoff, gbase, voff) do { _Pragma("unroll") for (int _i = 0; _i < 2; ++_i) \
        __builtin_amdgcn_global_load_lds((const unsigned*)((const char*)(gbase) + (voff)[_i]), (PG8_LAS unsigned*)(lds + (bufoff) + ldsw + _i * 8192), 16, 0, 0); } while (0)
#define PG8_LDA(dst, b, h) do { _Pragma("unroll") for (int m = 0; m < 4; ++m) _Pragma("unroll") for (int k = 0; k < 2; ++k) dst[m][k] = *(const PG8_LAS bf16x8*)(lds + PG8_SA(b, h) + aoff + m * 2048 + k * 1024); } while (0)
#define PG8_LDB(dst, b, h) do { _Pragma("unroll") for (int n = 0; n < 2; ++n) _Pragma("unroll") for (int k = 0; k < 2; ++k) dst[n][k] = *(const PG8_LAS bf16x8*)(lds + PG8_SB(b, h) + boff + n * 2048 + k * 1024); } while (0)
#define PG8_MMA(ai, bj, At, Bt) do { __builtin_amdgcn_s_setprio(1); _Pragma("unroll") for (int m = 0; m < 4; ++m) _Pragma("unroll") for (int n = 0; n < 2; ++n) _Pragma("unroll") for (int k = 0; k < 2; ++k) \
        acc[ai][bj][m][n] = __builtin_amdgcn_mfma_f32_16x16x32_bf16(Bt[n][k], At[m][k], acc[ai][bj][m][n], 0, 0, 0); __builtin_amdgcn_s_setprio(0); } while (0)
#define PG8_WAIT_V(n) asm volatile("s_waitcnt vmcnt(" #n ")" ::: "memory")
#define PG8_WAIT_L(n) asm volatile("s_waitcnt lgkmcnt(" #n ")" ::: "memory")
#define PG8_BAR __builtin_amdgcn_s_barrier()
#define PG8_SCHED __builtin_amdgcn_sched_barrier(0)
    Unit cur, nxt; int ui = 0;
    if (!S.next(0, cur)) return;
    f32x4 acc[2][2][4][2];
#pragma unroll
    for (int a = 0; a < 2; ++a)
#pragma unroll
        for (int b = 0; b < 2; ++b)
#pragma unroll
            for (int m = 0; m < 4; ++m)
#pragma unroll
                for (int n = 0; n < 2; ++n) acc[a][b][m][n] = (f32x4){0.f, 0.f, 0.f, 0.f};
    bf16x8 At[4][2], B0[2][2], B1[2][2];
    const char* cA = (const char*)g.A + (size_t)cur.pm * tstep; const char* cB = (const char*)g.Bt + (size_t)cur.pn * tstep;
    S.a_ready(cur);
    if constexpr (SP2) {
        PG8_STAGE(PG8_SB(0, 0), cB, voffB); PG8_STAGE(PG8_SB(0, 1), cB + hstep, voffB); PG8_STAGE(PG8_SA(0, 0), cA, voffA); PG8_STAGE(PG8_SA(0, 1), cA + hstep, voffA);
        if (wr == 1) PG8_BAR;
        PG8_WAIT_V(2); PG8_BAR;
        PG8_STAGE(PG8_SB(1, 0), cB + kstep, voffB); PG8_STAGE(PG8_SA(1, 0), cA + kstep, voffA); PG8_STAGE(PG8_SB(1, 1), cB + hstep + kstep, voffB);
        PG8_WAIT_V(6); PG8_BAR;
    } else {
        PG8_STAGE(PG8_SB(0, 0), cB, voffB); PG8_STAGE(PG8_SA(0, 0), cA, voffA); PG8_STAGE(PG8_SB(0, 1), cB + hstep, voffB); PG8_STAGE(PG8_SA(0, 1), cA + hstep, voffA);
        if (wr == 1) PG8_BAR;
        PG8_WAIT_V(4); PG8_BAR;
        PG8_STAGE(PG8_SB(1, 0), cB + kstep, voffB); PG8_STAGE(PG8_SA(1, 0), cA + kstep, voffA); PG8_STAGE(PG8_SB(1, 1), cB + hstep + kstep, voffB);
        PG8_WAIT_V(6); PG8_BAR;
    }
    for (;;) {
        const bool has_next = S.next(ui + 1, nxt);
        const char* nA = has_next ? (const char*)g.A + (size_t)nxt.pm * tstep : cA; const char* nB = has_next ? (const char*)g.Bt + (size_t)nxt.pn * tstep : cB;
        for (int t = 0; t < nt; t += 2) {
            const bool last = (t == nt - 2);
            const char* a1 = cA + (size_t)(t + 1) * kstep;
            const char* a2 = last ? nA : cA + (size_t)(t + 2) * kstep; const char* b2 = last ? nB : cB + (size_t)(t + 2) * kstep;
            const char* a3 = a2 + kstep; const char* b3 = b2 + kstep;
            if (last && has_next) S.a_ready(nxt);
            if constexpr (SP2) {
            PG8_LDB(B0, 0, 0); PG8_LDB(B1, 0, 1); PG8_SCHED; PG8_LDA(At, 0, 0); PG8_STAGE(PG8_SA(1, 1), a1 + hstep, voffA);
            PG8_WAIT_V(8); PG8_WAIT_L(0); PG8_BAR; PG8_MMA(0, 0, At, B0); PG8_MMA(0, 1, At, B1); PG8_BAR; PG8_SCHED;
            PG8_LDA(At, 0, 1); PG8_STAGE(PG8_SB(0, 0), b2, voffB); PG8_STAGE(PG8_SB(0, 1), b2 + hstep, voffB); PG8_STAGE(PG8_SA(0, 0), a2, voffA);
            PG8_WAIT_V(8); PG8_WAIT_L(0); PG8_BAR; PG8_MMA(1, 0, At, B0); PG8_MMA(1, 1, At, B1); PG8_BAR; PG8_SCHED;
            PG8_LDB(B0, 1, 0); PG8_LDB(B1, 1, 1); PG8_SCHED; PG8_LDA(At, 1, 0); PG8_STAGE(PG8_SA(0, 1), a2 + hstep, voffA);
            PG8_WAIT_V(8); PG8_WAIT_L(0); PG8_BAR; PG8_MMA(0, 0, At, B0); PG8_MMA(0, 1, At, B1); PG8_BAR; PG8_SCHED;
            PG8_LDA(At, 1, 1); PG8_STAGE(PG8_SB(1, 0), b3, voffB); PG8_STAGE(PG8_SB(1, 1), b3 + hstep, voffB); PG8_STAGE(PG8_SA(1, 0), a3, voffA);
            PG8_WAIT_V(8); PG8_WAIT_L(0); PG8_BAR; PG8_MMA(1, 0, At, B0); PG8_MMA(1, 1, At, B1); PG8_BAR; PG8_SCHED;
            } else {
            PG8_LDB(B0, 0, 0); PG8_SCHED; PG8_LDA(At, 0, 0); PG8_STAGE(PG8_SA(1, 1), a1 + hstep, voffA);
            PG8_WAIT_L(8); PG8_BAR; PG8_WAIT_L(0); PG8_MMA(0, 0, At, B0); PG8_BAR; PG8_SCHED;
            PG8_LDB(B1, 0, 1); PG8_STAGE(PG8_SB(0, 0), b2, voffB);
            PG8_BAR; PG8_WAIT_L(0); PG8_MMA(0, 1, At, B1); PG8_BAR;
            PG8_LDA(At, 0, 1); PG8_STAGE(PG8_SA(0, 0), a2, voffA);
            PG8_BAR; PG8_WAIT_L(0); PG8_MMA(1, 0, At, B0); PG8_BAR; PG8_SCHED;
            PG8_STAGE(PG8_SB(0, 1), b2 + hstep, voffB);
            PG8_WAIT_V(6); PG8_BAR; PG8_MMA(1, 1, At, B1); PG8_BAR;
            PG8_LDB(B0, 1, 0); PG8_SCHED; PG8_LDA(At, 1, 0); PG8_STAGE(PG8_SA(0, 1), a2 + hstep, voffA);
            PG8_WAIT_L(8); PG8_BAR; PG8_WAIT_L(0); PG8_MMA(0, 0, At, B0); PG8_BAR; PG8_SCHED;
            PG8_LDB(B1, 1, 1); PG8_STAGE(PG8_SB(1, 0), b3, voffB);
            PG8_BAR; PG8_WAIT_L(0); PG8_MMA(0, 1, At, B1); PG8_BAR;
            PG8_LDA(At, 1, 1); PG8_STAGE(PG8_SA(1, 0), a3, voffA);
            PG8_BAR; PG8_WAIT_L(0); PG8_MMA(1, 0, At, B0); PG8_BAR; PG8_SCHED;
            PG8_STAGE(PG8_SB(1, 1), b3 + hstep, voffB);
            PG8_WAIT_V(6); PG8_BAR; PG8_MMA(1, 1, At, B1); PG8_BAR;
            }
        }
        if constexpr (ALIGN_EPI) { if (wr == 0) PG8_BAR; }
        if constexpr (!Epi::AFTER_DRAIN) { E(acc, cur, wr, wc, fr, fq); S.done(cur); }
        if (!has_next) break;
#pragma unroll
        for (int a = 0; a < 2; ++a)
#pragma unroll
            for (int b = 0; b < 2; ++b)
#pragma unroll
                for (int m = 0; m < 4; ++m)
#pragma unroll
                    for (int n = 0; n < 2; ++n) acc[a][b][m][n] = (f32x4){0.f, 0.f, 0.f, 0.f};
        cur = nxt; cA = nA; cB = nB; ++ui;
        if constexpr (ALIGN_EPI) { if (wr == 1) PG8_BAR; }
    }
    PG8_WAIT_V(0);
    if constexpr (!ALIGN_EPI) { if (wr == 0) PG8_BAR; }
    PG8_BAR;
    if constexpr (Epi::AFTER_DRAIN) { E.fused(acc, cur, wr, wc, fr, fq, lds, wid, lane); S.done(cur); }
#undef PG8_SA
#undef PG8_SB
#undef PG8_STAGE
#undef PG8_LDA
#undef PG8_LDB
#undef PG8_MMA
#undef PG8_WAIT_V
#undef PG8_WAIT_L
#undef PG8_BAR
#undef PG8_SCHED
}
}

#ifndef PG8_SP2
#define PG8_SP2 true
#endif
#ifndef PG8_ALIGN
#define PG8_ALIGN true
#endif

constexpr int NWAVES = 8, NTHR = 512;
constexpr int BATCH = 8, SEQ = 4096, DM = 1024, TOK = BATCH * SEQ;
constexpr int NQKVA = 4608, AW = 512, NKVQ = 3072, FF = 2816, NUP = 5632;
constexpr float LOG2E = 1.4426950408889634f;
constexpr float C2 = 0.125f * LOG2E;
constexpr float RMS_EPS = 1e-6f, SUBLN_EPS = 1e-5f;
constexpr float LAMBDA_INIT = 0.8f - 0.6f * 0.7408182206817179f;

constexpr size_t MiB = 1u << 20;
constexpr size_t WS_WIN = 1 * MiB, WS_WOA = 10 * MiB, WS_WKVQ = 11 * MiB, WS_WOB = 17 * MiB, WS_WUP0 = 19 * MiB, WS_WUP1 = 30 * MiB;
constexpr size_t WS_WDN0 = 41 * MiB, WS_WDN1 = WS_WDN0 + (size_t)DM * FF * 2;
constexpr size_t WS_TABB = 63 * MiB, WS_TABA = WS_TABB + 256 * 1024;
constexpr size_t WS_XN = 64 * MiB;
constexpr size_t WS_BIG = 128 * MiB;
constexpr size_t WS_END = 512 * MiB;
constexpr int TABB_STRIDE = 64 + SEQ;

constexpr int LDS_BYTES = 147456;

#define GAS __attribute__((address_space(1)))
#define LAS __attribute__((address_space(3)))
typedef unsigned short bf16;
typedef unsigned v4u __attribute__((ext_vector_type(4)));
typedef unsigned v2u __attribute__((ext_vector_type(2)));
typedef float f32x4 __attribute__((ext_vector_type(4)));
#define LDS_WAIT() asm volatile("s_waitcnt lgkmcnt(0)" ::: "memory")
__device__ __forceinline__ unsigned f2bf(float f) { unsigned u = __builtin_bit_cast(unsigned, f); return (u + 0x7fffu + ((u >> 16) & 1u)) >> 16; }
__device__ __forceinline__ unsigned pk2(float lo, float hi) { return f2bf(lo) | (f2bf(hi) << 16); }
__device__ __forceinline__ float bflo(unsigned w) { return __uint_as_float(w << 16); }
__device__ __forceinline__ float bfhi(unsigned w) { return __uint_as_float(w & 0xffff0000u); }
__device__ __forceinline__ float wave_sum(float v) {
#pragma unroll
    for (int o = 1; o < 64; o <<= 1) v += __shfl_xor(v, o);
    return v;
}
__device__ __forceinline__ int t5_bucket(int n) {
    if (n < 16) return n;
    return 16 + (n >= 22) + (n >= 30) + (n >= 40) + (n >= 54) + (n >= 73) + (n >= 99) + (n >= 134) + (n >= 182) + (n >= 246) + (n >= 332) + (n >= 450) + (n >= 609) + (n >= 825) + (n >= 1117) + (n >= 1513);
}

struct Args {
    const float* in[19]; float* out; unsigned char* ws; int ph_lo, ph_hi;
};

__device__ __forceinline__ void tr_item(const float* W, int K, int N, bf16* WT, int k0, int n0, int drow0, const float* gk, float cs, LAS float* scr, int lane) {
#pragma unroll 8
    for (int i = 0; i < 32; ++i) { const int kk = 2 * i + (lane >> 5); const float g = gk ? gk[k0 + kk] : 1.f;
        scr[kk * 33 + (lane & 31)] = W[(size_t)(k0 + kk) * N + n0 + (lane & 31)] * (g * cs); }
    LDS_WAIT(); asm volatile("" ::: "memory");
    const int c = lane & 7;
#pragma unroll
    for (int j = 0; j < 4; ++j) { const int n = (lane >> 3) + 8 * j; const LAS float* s = scr + (8 * c) * 33 + n;
        v4u o; o.x = pk2(s[0 * 33], s[1 * 33]); o.y = pk2(s[2 * 33], s[3 * 33]); o.z = pk2(s[4 * 33], s[5 * 33]); o.w = pk2(s[6 * 33], s[7 * 33]);
        *(v4u*)(WT + (size_t)(drow0 + n) * K + k0 + 8 * c) = o; }
    LDS_WAIT(); asm volatile("" ::: "memory");
}
__device__ __forceinline__ void tr_mat(int r, const float* W, int K, int N, bf16* WT, int rowoff, const float* gk, int kind, LAS float* scr, int lane) {
    const int nblk = N / 32, kb = r / nblk, nb = r % nblk, n0 = nb * 32; int dr = n0; float cs = 1.f;
    if (kind == 1) cs = ((n0 % 1536) < 512) ? C2 : 1.f;
    if (kind == 2) cs = C2;
    if (kind == 3) dr = (n0 < FF) ? 256 * (n0 / 128) + (n0 % 128) : 256 * ((n0 - FF) / 128) + 128 + ((n0 - FF) % 128);
    tr_item(W, K, N, WT, kb * 64, n0, dr + rowoff, gk, cs, scr, lane);
}

__device__ __forceinline__ void prologue(const Args& a, LAS unsigned char* lds, int gw, int ngw, int wave, int lane) {
    LAS float* scr = (LAS float*)(lds + wave * 16384);
    unsigned char* ws = a.ws;
    const float* norm_g = a.in[2];
    constexpr int I_WIN = 16 * 144, I_WOA = 8 * 32, I_SQ = 16 * 32, I_UP = 16 * 176, I_DN = 44 * 32;
    constexpr int NITEMS = I_WIN + I_WOA + 4 * I_SQ + 2 * I_UP + 2 * I_DN;
    for (int it = gw; it < NITEMS; it += ngw) {
        int r = it;
        if (r < I_WIN) { tr_mat(r, a.in[3], DM, NQKVA, (bf16*)(ws + WS_WIN), 0, norm_g + 0 * DM, 1, scr, lane); continue; } r -= I_WIN;
        if (r < I_WOA) { tr_mat(r, a.in[4], AW, DM, (bf16*)(ws + WS_WOA), 0, nullptr, 0, scr, lane); continue; } r -= I_WOA;
        if (r < I_SQ) { tr_mat(r, a.in[6], DM, DM, (bf16*)(ws + WS_WKVQ), 0, a.in[5], 0, scr, lane); continue; } r -= I_SQ;
        if (r < I_SQ) { tr_mat(r, a.in[7], DM, DM, (bf16*)(ws + WS_WKVQ), 1024, a.in[5], 0, scr, lane); continue; } r -= I_SQ;
        if (r < I_SQ) { tr_mat(r, a.in[8], DM, DM, (bf16*)(ws + WS_WKVQ), 2048, norm_g + 4 * DM, 2, scr, lane); continue; } r -= I_SQ;
        if (r < I_SQ) { tr_mat(r, a.in[14], DM, DM, (bf16*)(ws + WS_WOB), 0, nullptr, 0, scr, lane); continue; } r -= I_SQ;
        if (r < I_UP) { tr_mat(r, a.in[15], DM, NUP, (bf16*)(ws + WS_WUP0), 0, norm_g + 2 * DM, 3, scr, lane); continue; } r -= I_UP;
        if (r < I_UP) { tr_mat(r, a.in[15] + (size_t)DM * NUP, DM, NUP, (bf16*)(ws + WS_WUP1), 0, norm_g + 6 * DM, 3, scr, lane); continue; } r -= I_UP;
        if (r < I_DN) { tr_mat(r, a.in[18], FF, DM, (bf16*)(ws + WS_WDN0), 0, nullptr, 0, scr, lane); continue; } r -= I_DN;
        tr_mat(r, a.in[18] + (size_t)FF * DM, FF, DM, (bf16*)(ws + WS_WDN1), 0, nullptr, 0, scr, lane);
    }
    const float* table = a.in[1];
    float* tabB = (float*)(ws + WS_TABB); float* tabA = (float*)(ws + WS_TABA);
    const int gt = gw * 64 + lane, ngt = ngw * 64;
    for (int i = gt; i < 8 * TABB_STRIDE; i += ngt) { const int h = i / TABB_STRIDE, d = i % TABB_STRIDE - 64; tabB[i] = d < 0 ? 0.f : table[h * 32 + t5_bucket(d)] * LOG2E; }
    for (int i = gt; i < 3 * 8 * 132; i += ngt) { const int g = i / (8 * 132), h = (i / 132) % 8, du = i % 132; const int r = 1 << (2 * g);
        tabA[i] = du <= 128 ? table[h * 32 + t5_bucket(du * r)] * LOG2E : 0.f; }
    const float* x = a.in[0]; bf16* XN = (bf16*)(ws + WS_XN);
    for (int m = gw; m < TOK; m += ngw) {
        const f32x4* xr = (const f32x4*)(x + (size_t)m * DM) + lane; f32x4 v[4]; float s = 0.f;
#pragma unroll
        for (int j = 0; j < 4; ++j) { v[j] = xr[64 * j]; s += (v[j].x * v[j].x + v[j].y * v[j].y) + (v[j].z * v[j].z + v[j].w * v[j].w); }
        const float rs = 1.f / sqrtf(wave_sum(s) * (1.f / DM) + RMS_EPS);
        v2u* o8 = (v2u*)(XN + (size_t)m * DM) + lane;
#pragma unroll
        for (int j = 0; j < 4; ++j) { v2u w; w.x = pk2(v[j].x * rs, v[j].y * rs); w.y = pk2(v[j].z * rs, v[j].w * rs); o8[64 * j] = w; }
    }
}

__device__ __forceinline__ void rowpass(const bf16* mix, const float* g, const float* hin, float* hout, bf16* xn, int gw, int ngw, int lane) {
    for (int m = gw; m < TOK; m += ngw) {
        const v2u* mr = (const v2u*)(mix + (size_t)m * DM) + lane; f32x4 v[4]; float s = 0.f;
#pragma unroll
        for (int j = 0; j < 4; ++j) { const v2u w = mr[64 * j]; v[j] = (f32x4){bflo(w.x), bfhi(w.x), bflo(w.y), bfhi(w.y)};
            s += (v[j].x * v[j].x + v[j].y * v[j].y) + (v[j].z * v[j].z + v[j].w * v[j].w); }
        const float rs = 1.f / sqrtf(wave_sum(s) * (1.f / DM) + RMS_EPS);
        const f32x4* gr = (const f32x4*)g + lane; const f32x4* hr = (const f32x4*)(hin + (size_t)m * DM) + lane; f32x4* ho = (f32x4*)(hout + (size_t)m * DM) + lane;
        float s2 = 0.f;
#pragma unroll
        for (int j = 0; j < 4; ++j) { const f32x4 gv = gr[64 * j], hv = hr[64 * j]; v[j] = hv + v[j] * rs * gv; ho[64 * j] = v[j];
            s2 += (v[j].x * v[j].x + v[j].y * v[j].y) + (v[j].z * v[j].z + v[j].w * v[j].w); }
        if (xn) {
            const float rs2 = 1.f / sqrtf(wave_sum(s2) * (1.f / DM) + RMS_EPS);
            v2u* o8 = (v2u*)(xn + (size_t)m * DM) + lane;
#pragma unroll
            for (int j = 0; j < 4; ++j) { v2u w; w.x = pk2(v[j].x * rs2, v[j].y * rs2); w.y = pk2(v[j].z * rs2, v[j].w * rs2); o8[64 * j] = w; }
        }
    }
}

__device__ __forceinline__ void ld8(const bf16* p, float* f) { const v4u w = *(const v4u*)p; f[0] = bflo(w.x); f[1] = bfhi(w.x); f[2] = bflo(w.y); f[3] = bfhi(w.y); f[4] = bflo(w.z); f[5] = bfhi(w.z); f[6] = bflo(w.w); f[7] = bfhi(w.w); }

__device__ __forceinline__ void dilated_naive(const bf16* qkv, const float* tabA, bf16* Oa, int gtid, int gstride) {
    for (int idx = gtid; idx < TOK * 8; idx += gstride) {
        const int h = idx & 7, t = idx >> 3, s = t & (SEQ - 1);
        float m = -INFINITY, l = 0.f; float o[64];
#pragma unroll
        for (int d = 0; d < 64; ++d) o[d] = 0.f;
        for (int g = 0; g < 3; ++g) {
            const int r = 1 << (2 * g); const int mu = s >> (2 * g); const int jmax = mu < 128 ? mu : 128;
            const bf16* qp = qkv + (size_t)t * NQKVA + g * 1536 + h * 64; float q[64];
#pragma unroll
            for (int c = 0; c < 8; ++c) ld8(qp + 8 * c, q + 8 * c);
            const float* tb = tabA + (g * 8 + h) * 132;
            for (int j = 0; j <= jmax; ++j) {
                const bf16* kp = qkv + (size_t)(t - j * r) * NQKVA + g * 1536 + 512 + h * 64; const bf16* vp = kp + 512;
                float dot = 0.f;
#pragma unroll
                for (int c = 0; c < 8; ++c) { float kf[8]; ld8(kp + 8 * c, kf);
#pragma unroll
                    for (int e = 0; e < 8; ++e) dot += q[8 * c + e] * kf[e]; }
                const float tt = dot + tb[j]; const float mn = fmaxf(m, tt); const float al = exp2f(m - mn), p = exp2f(tt - mn);
                l = l * al + p; m = mn;
#pragma unroll
                for (int c = 0; c < 8; ++c) { float vf[8]; ld8(vp + 8 * c, vf);
#pragma unroll
                    for (int e = 0; e < 8; ++e) o[8 * c + e] = o[8 * c + e] * al + p * vf[e]; }
            }
        }
        const float il = 1.f / l; bf16* op = Oa + (size_t)t * AW + h * 64;
#pragma unroll
        for (int c = 0; c < 8; ++c) { v4u w; w.x = pk2(o[8 * c] * il, o[8 * c + 1] * il); w.y = pk2(o[8 * c + 2] * il, o[8 * c + 3] * il); w.z = pk2(o[8 * c + 4] * il, o[8 * c + 5] * il); w.w = pk2(o[8 * c + 6] * il, o[8 * c + 7] * il);
            *(v4u*)(op + 8 * c) = w; }
    }
}

__device__ __forceinline__ void diff_naive(const bf16* kvq, const float* tabB, const Args& a, bf16* Ob, int gw, int ngw, int lane) {
    float lam;
    { const float p1 = a.in[9][lane] * a.in[10][lane], p2 = a.in[11][lane] * a.in[12][lane]; lam = expf(wave_sum(p1)) - expf(wave_sum(p2)) + LAMBDA_INIT; }
    const float* subg = a.in[13];
    for (int w = gw; w < 8 * 8 * 256; w += ngw) {
        const int qg = 255 - (w >> 6), h = w & 7, b = (w >> 3) & 7;
        const int ql = lane >> 2, c = (lane >> 1) & 1, eh = lane & 1; const int q = qg * 16 + ql;
        const size_t row = (size_t)b * SEQ + q;
        float qv[64]; { const bf16* qp = kvq + row * NKVQ + 2048 + h * 128 + c * 64;
#pragma unroll
            for (int cc = 0; cc < 8; ++cc) ld8(qp + 8 * cc, qv + 8 * cc); }
        float o[64]; float m = -INFINITY, l = 0.f;
#pragma unroll
        for (int d = 0; d < 64; ++d) o[d] = 0.f;
        const float* tb = tabB + h * TABB_STRIDE + 64;
        const int kmax = qg * 16 + 15;
        for (int k = 0; k <= kmax; ++k) {
            const bf16* kp = kvq + ((size_t)b * SEQ + k) * NKVQ + h * 128 + c * 64; const bf16* vp = kvq + ((size_t)b * SEQ + k) * NKVQ + 1024 + h * 128 + eh * 64;
            float dot = 0.f;
#pragma unroll
            for (int cc = 0; cc < 8; ++cc) { float kf[8]; ld8(kp + 8 * cc, kf);
#pragma unroll
                for (int e = 0; e < 8; ++e) dot += qv[8 * cc + e] * kf[e]; }
            if (k <= q) {
                const float tt = dot + tb[q - k]; const float mn = fmaxf(m, tt); const float al = exp2f(m - mn), p = exp2f(tt - mn);
                l = l * al + p; m = mn;
#pragma unroll
                for (int cc = 0; cc < 8; ++cc) { float vf[8]; ld8(vp + 8 * cc, vf);
#pragma unroll
                    for (int e = 0; e < 8; ++e) o[8 * cc + e] = o[8 * cc + e] * al + p * vf[e]; }
            }
        }
        const float il = 1.f / l; float ss = 0.f;
#pragma unroll
        for (int d = 0; d < 64; ++d) { const float on = o[d] * il; const float other = __shfl_xor(on, 2); o[d] = on - lam * other; ss += o[d] * o[d]; }
        ss += __shfl_xor(ss, 1);
        const float rs = 1.f / sqrtf(ss * (1.f / 128.f) + SUBLN_EPS) * (1.f - LAMBDA_INIT);
        if (c == 0) { bf16* op = Ob + row * DM + h * 128 + eh * 64; const float* sg = subg + eh * 64;
#pragma unroll
            for (int cc = 0; cc < 8; ++cc) { v4u wv; wv.x = pk2(o[8 * cc] * rs * sg[8 * cc], o[8 * cc + 1] * rs * sg[8 * cc + 1]); wv.y = pk2(o[8 * cc + 2] * rs * sg[8 * cc + 2], o[8 * cc + 3] * rs * sg[8 * cc + 3]);
                wv.z = pk2(o[8 * cc + 4] * rs * sg[8 * cc + 4], o[8 * cc + 5] * rs * sg[8 * cc + 5]); wv.w = pk2(o[8 * cc + 6] * rs * sg[8 * cc + 6], o[8 * cc + 7] * rs * sg[8 * cc + 7]);
                *(v4u*)(op + 8 * cc) = wv; } }
    }
}

__device__ __forceinline__ void conv_naive(const bf16* u, int half, const float* cw, const float* cb, bf16* gated, int gtid, int gstride) {
    for (int it = gtid; it < 16384 * 352; it += gstride) {
        const int j8 = it % 352, rl = it / 352; const int t = half * 16384 + rl; const int s = t & (SEQ - 1); const int j = j8 * 8;
        const int ucol = 256 * (j / 128) + (j % 128);
        float cg[8], cv[8];
#pragma unroll
        for (int i = 0; i < 8; ++i) { cg[i] = cb[j + i]; cv[i] = cb[FF + j + i]; }
#pragma unroll
        for (int jj = 0; jj < 3; ++jj) { const int ds = 2 - jj;
            if (s - ds >= 0) { const bf16* up = u + (size_t)(rl - ds) * NUP + ucol; float ug[8], uv[8]; ld8(up, ug); ld8(up + 128, uv);
#pragma unroll
                for (int i = 0; i < 8; ++i) { cg[i] += cw[jj * NUP + j + i] * ug[i]; cv[i] += cw[jj * NUP + FF + j + i] * uv[i]; } } }
        float r[8];
#pragma unroll
        for (int i = 0; i < 8; ++i) r[i] = 0.5f * cg[i] * (1.f + erff(cg[i] * 0.70710678118654752f)) * cv[i];
        v4u w; w.x = pk2(r[0], r[1]); w.y = pk2(r[2], r[3]); w.z = pk2(r[4], r[5]); w.w = pk2(r[6], r[7]);
        *(v4u*)(gated + (size_t)t * FF + j) = w;
    }
}


#define FRAME_VARS \
    extern __shared__ __attribute__((aligned(16))) unsigned char lds_raw[]; \
    LAS unsigned char* lds = (LAS unsigned char*)lds_raw; (void)lds; \
    const int tid = threadIdx.x, lane = tid & 63, wave = __builtin_amdgcn_readfirstlane(tid >> 6); \
    const int G = gridDim.x, bx = blockIdx.x; \
    const int vcu = (G % 8 == 0) ? (bx % 8) * (G / 8) + bx / 8 : bx; \
    const int gw = vcu * NWAVES + wave, ngw = G * NWAVES; \
    const int gtid = bx * NTHR + tid, gstride = G * NTHR; (void)gw; (void)ngw; (void)gtid; (void)gstride; (void)lane; (void)wave;

__global__ void __launch_bounds__(NTHR, 2) k_prologue(Args a) { FRAME_VARS prologue(a, lds, gw, ngw, wave, lane); }
__global__ void __launch_bounds__(NTHR, 2) k_gemm(const bf16* A, const bf16* Bt, int M, int N, int K, bf16* O, int ldc) { FRAME_VARS
    pg8::Gemm g{A, Bt, M, N, K}; pg8::StaticOrder S; S.init(M, N, G, bx); pg8::EpiBf16<0> E{O, ldc, nullptr, 0, 0, 1.f};
    pg8::gemm_phase<pg8::EpiBf16<0>, pg8::StaticOrder, PG8_ALIGN, PG8_SP2>(lds, g, S, E); }
__global__ void __launch_bounds__(NTHR, 2) k_dilated(const bf16* qkv, const float* tabA, bf16* Oa) { FRAME_VARS dilated_naive(qkv, tabA, Oa, gtid, gstride); }
__global__ void __launch_bounds__(NTHR, 2) k_rowpass(const bf16* mix, const float* g, const float* hin, float* hout, bf16* xn) { FRAME_VARS rowpass(mix, g, hin, hout, xn, gw, ngw, lane); }
__global__ void __launch_bounds__(NTHR, 2) k_conv(const bf16* u, int half, const float* cw, const float* cb, bf16* gated) { FRAME_VARS conv_naive(u, half, cw, cb, gated, gtid, gstride); }
__global__ void __launch_bounds__(NTHR, 2) k_diff(const bf16* kvq, const float* tabB, Args a, bf16* Ob) { FRAME_VARS diff_naive(kvq, tabB, a, Ob, gw, ngw, lane); }

extern "C" void kernel_launch(void* const* d_in, const int* in_sizes, int n_in, void* d_out, int out_size, void* d_ws, size_t ws_size, hipStream_t stream) {
    static int grid = 0;
    if (grid == 0) {
        if (n_in != 19 || in_sizes[0] != TOK * DM || out_size != TOK * DM || ws_size < WS_END) {
            fprintf(stderr, "kernel_launch: unexpected shapes: n_in %d in0 %d out %d ws %zu (need %zu)\n", n_in, n_in > 0 ? in_sizes[0] : -1, out_size, ws_size, (size_t)WS_END); grid = -1; return; }
        int dev = 0, cus = 0;
        if (hipGetDevice(&dev) != hipSuccess || hipDeviceGetAttribute(&cus, hipDeviceAttributeMultiprocessorCount, dev) != hipSuccess) { grid = -1; return; }
        if (hipFuncSetAttribute((const void*)k_prologue, hipFuncAttributeMaxDynamicSharedMemorySize, LDS_BYTES) != hipSuccess ||
            hipFuncSetAttribute((const void*)k_gemm, hipFuncAttributeMaxDynamicSharedMemorySize, LDS_BYTES) != hipSuccess) { fprintf(stderr, "kernel_launch: hipFuncSetAttribute failed\n"); grid = -1; return; }
        grid = cus;
    }
    if (grid < 0) return;
    Args a{};
    for (int i = 0; i < 19; ++i) a.in[i] = (const float*)d_in[i];
    a.out = (float*)d_out; a.ws = (unsigned char*)d_ws;
    unsigned char* ws = (unsigned char*)d_ws; float* out = (float*)d_out;
    const float* norm_g = a.in[2];
    bf16* XN = (bf16*)(ws + WS_XN); bf16* BIG = (bf16*)(ws + WS_BIG);
    bf16* OA = (bf16*)(ws + 416 * MiB); bf16* MIX2 = (bf16*)(ws + 448 * MiB); bf16* GATED = (bf16*)(ws + 304 * MiB); bf16* OB = (bf16*)(ws + 320 * MiB);
    const dim3 gr(grid), bl(NTHR);
#define GEMM(A_, B_, M_, N_, K_, O_, LDC_) hipLaunchKernelGGL(k_gemm, gr, bl, LDS_BYTES, stream, (const bf16*)(A_), (const bf16*)(B_), M_, N_, K_, (bf16*)(O_), LDC_)
    hipLaunchKernelGGL(k_prologue, gr, bl, LDS_BYTES, stream, a);
    GEMM(XN, ws + WS_WIN, TOK, NQKVA, DM, BIG, NQKVA);
    hipLaunchKernelGGL(k_dilated, gr, bl, 0, stream, (const bf16*)BIG, (const float*)(ws + WS_TABA), OA);
    GEMM(OA, ws + WS_WOA, TOK, DM, AW, MIX2, DM);
    hipLaunchKernelGGL(k_rowpass, gr, bl, 0, stream, (const bf16*)MIX2, norm_g + 1 * DM, a.in[0], out, XN);
    for (int lay = 0; lay < 2; ++lay) {
        if (lay == 1) {
            GEMM(XN, ws + WS_WKVQ, TOK, NKVQ, DM, BIG, NKVQ);
            hipLaunchKernelGGL(k_diff, gr, bl, 0, stream, (const bf16*)BIG, (const float*)(ws + WS_TABB), a, OB);
            GEMM(OB, ws + WS_WOB, TOK, DM, DM, MIX2, DM);
            hipLaunchKernelGGL(k_rowpass, gr, bl, 0, stream, (const bf16*)MIX2, norm_g + 5 * DM, (const float*)out, out, XN);
        }
        const unsigned char* wup = ws + (lay ? WS_WUP1 : WS_WUP0); const unsigned char* wdn = ws + (lay ? WS_WDN1 : WS_WDN0);
        for (int half = 0; half < 2; ++half) {
            GEMM(XN + (size_t)half * (TOK / 2) * DM, wup, TOK / 2, NUP, DM, BIG, NUP);
            hipLaunchKernelGGL(k_conv, gr, bl, 0, stream, (const bf16*)BIG, half, a.in[16] + (size_t)lay * 3 * NUP, a.in[17] + (size_t)lay * NUP, GATED);
        }
        GEMM(GATED, wdn, TOK, DM, FF, BIG, DM);
        hipLaunchKernelGGL(k_rowpass, gr, bl, 0, stream, (const bf16*)BIG, norm_g + (lay * 4 + 3) * DM, (const float*)out, out, lay == 0 ? XN : (bf16*)nullptr);
    }
}
```

```cpp
#include <hip/hip_runtime.h>
#include <hip/hip_cooperative_groups.h>
#include <cstdio>
#include <cstdint>
namespace pg8 {
#define PG8_LAS __attribute__((address_space(3)))
typedef unsigned short bf16_t;
typedef short bf16x8 __attribute__((ext_vector_type(8)));
typedef float f32x4 __attribute__((ext_vector_type(4)));
typedef unsigned u32x4 __attribute__((ext_vector_type(4)));
constexpr int BM = 256, BK = 64, HALF = 128, HTB = HALF * BK * 2  , STAGE_BYTES = 8 * HTB, NXCD = 8, WGM = 8;

__host__ __device__ __forceinline__ int lds_byte(int r, int c) { const int st = (r >> 4) * 2 + (c >> 5), rr = r & 15, cc = c & 31, ob = rr * 64 + cc * 2; return st * 1024 + (ob ^ (((ob >> 9) & 1) << 5)); }
__host__ __device__ __forceinline__ void stage_rc(int b, int& R, int& C) { const int st = b / 1024, sb = b % 1024, swz = sb ^ (((sb >> 9) & 1) << 5); R = (st >> 1) * 16 + swz / 64; C = (st & 1) * 32 + (swz % 64) / 2; }
__host__ __device__ __forceinline__ int perm32(int rho) { const int n = rho >> 4, i = rho & 15; return 8 * (i >> 2) + 4 * n + (i & 3); }

struct Unit { int pm, pn; };
struct Gemm { const bf16_t* A; const bf16_t* Bt; int M, N, K; };

struct StaticOrder {
    int nM, nN, nwg, G, c;
    __host__ __device__ void init(int M, int N, int G_, int c_) { nM = M / BM; nN = N / BM; nwg = nM * nN; G = G_; c = c_; }
    __host__ __device__ bool next(int i, Unit& u) const {
        const long L = (long)i * G + c; if (L >= nwg) return false;
        int wgid = (int)L; { const int q = nwg / NXCD, r = nwg % NXCD, xcd = wgid % NXCD, off = wgid / NXCD; wgid = (xcd < r ? xcd * (q + 1) : r * (q + 1) + (xcd - r) * q) + off; }
        const int nig = WGM * nN, gid = wgid / nig, fm = gid * WGM, gsz = (nM - fm) < WGM ? (nM - fm) : WGM;
        u.pm = fm + ((wgid % nig) % gsz); u.pn = (wgid % nig) / gsz; return true;
    }
    __device__ __forceinline__ void a_ready(const Unit&) const {}
    __device__ __forceinline__ void done(const Unit&) const {}
};

__device__ __forceinline__ unsigned cvt_pk_bf16(float lo, float hi) { unsigned r; asm volatile("v_cvt_pk_bf16_f32 %0, %1, %2" : "=v"(r) : "v"(lo), "v"(hi)); return r; }
typedef float f32x2 __attribute__((ext_vector_type(2)));
__device__ __forceinline__ f32x2 gelu_pk(f32x2 v) {
    const f32x2 av = __builtin_elementwise_abs(v), d = av * 0.2316418882f + 1.0f;
    f32x2 t; t.x = __builtin_amdgcn_rcpf(d.x); t.y = __builtin_amdgcn_rcpf(d.y);
    f32x2 q = t * 0.5307027145f + (-0.7265760135f); q = q * t + 0.7107068705f; q = q * t + (-0.142248368f); q = q * t + 0.127414796f; q = q * t;
    const f32x2 s = (v * v) * (-0.72134752044f);
    f32x2 e; e.x = __builtin_amdgcn_exp2f(s.x); e.y = __builtin_amdgcn_exp2f(s.y);
    const f32x2 m = v * (q * e), r = v - m;
    f32x2 o; o.x = v.x < 0.f ? m.x : r.x; o.y = v.y < 0.f ? m.y : r.y; return o;
}

template <int ACT  > struct EpiBf16 {
    static constexpr bool PERM = true, AFTER_DRAIN = false; static_assert(ACT == 0 || ACT == 1, "EpiBf16: ACT is 0 (none) or 1 (gelu_pk)");
    bf16_t* O; int ldc; const float* bias; int split_cols; size_t split_stride; float scale0;
    __device__ __forceinline__ void operator()(const f32x4 (&acc)[2][2][4][2], const Unit& u, int wr, int wc, int fr, int fq) const {
        const int row0 = u.pm * BM + wr * 64 + fr; int colt = u.pn * BM; bf16_t* base = O;
        float sc = 1.f; if (split_cols) { const int t = colt / split_cols; base += (size_t)t * split_stride; colt -= t * split_cols; if (t == 0) sc = scale0; }
        const int col0 = colt + wc * 32 + 8 * fq, bcol0 = u.pn * BM + wc * 32 + 8 * fq;
        f32x4 bv[2][2];
#pragma unroll
        for (int bj = 0; bj < 2; ++bj)
#pragma unroll
            for (int n = 0; n < 2; ++n) bv[bj][n] = bias ? *(const f32x4*)(bias + bcol0 + bj * HALF + 4 * n) : (f32x4){0.f, 0.f, 0.f, 0.f};
#pragma unroll
        for (int ai = 0; ai < 2; ++ai)
#pragma unroll
            for (int m = 0; m < 4; ++m) { bf16_t* rowp = base + (size_t)(row0 + ai * HALF + m * 16) * ldc + col0;
#pragma unroll
                for (int bj = 0; bj < 2; ++bj) { f32x4 v0 = acc[ai][bj][m][0] + bv[bj][0], v1 = acc[ai][bj][m][1] + bv[bj][1];
                    if (ACT == 1) { f32x2 a = gelu_pk((f32x2){v0[0], v0[1]}), b = gelu_pk((f32x2){v0[2], v0[3]}), c = gelu_pk((f32x2){v1[0], v1[1]}), d = gelu_pk((f32x2){v1[2], v1[3]});
                        v0 = (f32x4){a.x, a.y, b.x, b.y}; v1 = (f32x4){c.x, c.y, d.x, d.y}; }
                    v0 = v0 * sc; v1 = v1 * sc; u32x4 w; w.x = cvt_pk_bf16(v0[0], v0[1]); w.y = cvt_pk_bf16(v0[2], v0[3]); w.z = cvt_pk_bf16(v1[0], v1[1]); w.w = cvt_pk_bf16(v1[2], v1[3]);
                    *(u32x4*)(rowp + bj * HALF) = w; } }
    }
};
template <class Epi, class Sched, bool ALIGN_EPI = false, bool SP2 = false>
__device__ __forceinline__ void gemm_phase(PG8_LAS unsigned char* lds, const Gemm g, const Sched& S, const Epi& E) {
    int tid_l = threadIdx.x; asm volatile("" : "+v"(tid_l));
    const int tid = tid_l, wid = __builtin_amdgcn_readfirstlane(tid >> 6), lane = tid & 63, wr = wid >> 2, wc = wid & 3, fr = lane & 15, fq = lane >> 4;
    const int K = g.K, nt = K / BK;
    unsigned voffA[2], voffB[2];
#pragma unroll
    for (int i = 0; i < 2; ++i) { int R, C; stage_rc(tid * 16 + i * 8192, R, C); const int Rb = Epi::PERM ? ((R & ~31) + perm32(R & 31)) : R;
        voffA[i] = (unsigned)(R * K + C) * 2u; voffB[i] = (unsigned)(Rb * K + C) * 2u; }
    const size_t kstep = (size_t)(BK * 2);
    const size_t hstep = (size_t)HALF * K * 2;
    const size_t tstep = 2 * hstep;
    const unsigned ldsw = (unsigned)wid * 1024u;
    const int aoff = lds_byte(wr * 64 + fr, fq * 8), boff = lds_byte(wc * 32 + fr, fq * 8);
#define PG8_SA(b, h) (((b) * 2 + (h)) * HTB)
#define PG8_SB(b, h) ((4 + (b) * 2 + (h)) * HTB)
#define PG8_STAGE(bufoff, gbase, voff) do { _Pragma("unroll") for (int _i = 0; _i < 2; ++_i) \
        __builtin_amdgcn_global_load_lds((const unsigned*)((const char*)(gbase) + (voff)[_i]), (PG8_LAS unsigned*)(lds + (bufoff) + ldsw + _i * 8192), 16, 0, 0); } while (0)
#define PG8_LDA(dst, b, h) do { _Pragma("unroll") for (int m = 0; m < 4; ++m) _Pragma("unroll") for (int k = 0; k < 2; ++k) dst[m][k] = *(const PG8_LAS bf16x8*)(lds + PG8_SA(b, h) + aoff + m * 2048 + k * 1024); } while (0)
#define PG8_LDB(dst, b, h) do { _Pragma("unroll") for (int n = 0; n < 2; ++n) _Pragma("unroll") for (int k = 0; k < 2; ++k) dst[n][k] = *(const PG8_LAS bf16x8*)(lds + PG8_SB(b, h) + boff + n * 2048 + k * 1024); } while (0)
#define PG8_MMA(ai, bj, At, Bt) do { __builtin_amdgcn_s_setprio(1); _Pragma("unroll") for (int m = 0; m < 4; ++m) _Pragma("unroll") for (int n = 0; n < 2; ++n) _Pragma("unroll") for (int k = 0; k < 2; ++k) \
        acc[ai][bj][m][n] = __builtin_amdgcn_mfma_f32_16x16x32_bf16(Bt[n][k], At[m][k], acc[ai][bj][m][n], 0, 0, 0); __builtin_amdgcn_s_setprio(0); } while (0)
#define PG8_WAIT_V(n) asm volatile("s_waitcnt vmcnt(" #n ")" ::: "memory")
#define PG8_WAIT_L(n) asm volatile("s_waitcnt lgkmcnt(" #n ")" ::: "memory")
#define PG8_BAR __builtin_amdgcn_s_barrier()
#define PG8_SCHED __builtin_amdgcn_sched_barrier(0)
    Unit cur, nxt; int ui = 0;
    if (!S.next(0, cur)) return;
    f32x4 acc[2][2][4][2];
#pragma unroll
    for (int a = 0; a < 2; ++a)
#pragma unroll
        for (int b = 0; b < 2; ++b)
#pragma unroll
            for (int m = 0; m < 4; ++m)
#pragma unroll
                for (int n = 0; n < 2; ++n) acc[a][b][m][n] = (f32x4){0.f, 0.f, 0.f, 0.f};
    bf16x8 At[4][2], B0[2][2], B1[2][2];
    const char* cA = (const char*)g.A + (size_t)cur.pm * tstep; const char* cB = (const char*)g.Bt + (size_t)cur.pn * tstep;
    S.a_ready(cur);
    if constexpr (SP2) {
        PG8_STAGE(PG8_SB(0, 0), cB, voffB); PG8_STAGE(PG8_SB(0, 1), cB + hstep, voffB); PG8_STAGE(PG8_SA(0, 0), cA, voffA); PG8_STAGE(PG8_SA(0, 1), cA + hstep, voffA);
        if (wr == 1) PG8_BAR;
        PG8_WAIT_V(2); PG8_BAR;
        PG8_STAGE(PG8_SB(1, 0), cB + kstep, voffB); PG8_STAGE(PG8_SA(1, 0), cA + kstep, voffA); PG8_STAGE(PG8_SB(1, 1), cB + hstep + kstep, voffB);
        PG8_WAIT_V(6); PG8_BAR;
    } else {
        PG8_STAGE(PG8_SB(0, 0), cB, voffB); PG8_STAGE(PG8_SA(0, 0), cA, voffA); PG8_STAGE(PG8_SB(0, 1), cB + hstep, voffB); PG8_STAGE(PG8_SA(0, 1), cA + hstep, voffA);
        if (wr == 1) PG8_BAR;
        PG8_WAIT_V(4); PG8_BAR;
        PG8_STAGE(PG8_SB(1, 0), cB + kstep, voffB); PG8_STAGE(PG8_SA(1, 0), cA + kstep, voffA); PG8_STAGE(PG8_SB(1, 1), cB + hstep + kstep, voffB);
        PG8_WAIT_V(6); PG8_BAR;
    }
    for (;;) {
        const bool has_next = S.next(ui + 1, nxt);
        const char* nA = has_next ? (const char*)g.A + (size_t)nxt.pm * tstep : cA; const char* nB = has_next ? (const char*)g.Bt + (size_t)nxt.pn * tstep : cB;
        for (int t = 0; t < nt; t += 2) {
            const bool last = (t == nt - 2);
            const char* a1 = cA + (size_t)(t + 1) * kstep;
            const char* a2 = last ? nA : cA + (size_t)(t + 2) * kstep; const char* b2 = last ? nB : cB + (size_t)(t + 2) * kstep;
            const char* a3 = a2 + kstep; const char* b3 = b2 + kstep;
            if (last && has_next) S.a_ready(nxt);
            if constexpr (SP2) {
            PG8_LDB(B0, 0, 0); PG8_LDB(B1, 0, 1); PG8_SCHED; PG8_LDA(At, 0, 0); PG8_STAGE(PG8_SA(1, 1), a1 + hstep, voffA);
            PG8_WAIT_V(8); PG8_WAIT_L(0); PG8_BAR; PG8_MMA(0, 0, At, B0); PG8_MMA(0, 1, At, B1); PG8_BAR; PG8_SCHED;
            PG8_LDA(At, 0, 1); PG8_STAGE(PG8_SB(0, 0), b2, voffB); PG8_STAGE(PG8_SB(0, 1), b2 + hstep, voffB); PG8_STAGE(PG8_SA(0, 0), a2, voffA);
            PG8_WAIT_V(8); PG8_WAIT_L(0); PG8_BAR; PG8_MMA(1, 0, At, B0); PG8_MMA(1, 1, At, B1); PG8_BAR; PG8_SCHED;
            PG8_LDB(B0, 1, 0); PG8_LDB(B1, 1, 1); PG8_SCHED; PG8_LDA(At, 1, 0); PG8_STAGE(PG8_SA(0, 1), a2 + hstep, voffA);
            PG8_WAIT_V(8); PG8_WAIT_L(0); PG8_BAR; PG8_MMA(0, 0, At, B0); PG8_MMA(0, 1, At, B1); PG8_BAR; PG8_SCHED;
            PG8_LDA(At, 1, 1); PG8_STAGE(PG8_SB(1, 0), b3, voffB); PG8_STAGE(PG8_SB(1, 1), b3 + hstep, voffB); PG8_STAGE(PG8_SA(1, 0), a3, voffA);
            PG8_WAIT_V(8); PG8_WAIT_L(0); PG8_BAR; PG8_MMA(1, 0, At, B0); PG8_MMA(1, 1, At, B1); PG8_BAR; PG8_SCHED;
            } else {
            PG8_LDB(B0, 0, 0); PG8_SCHED; PG8_LDA(At, 0, 0); PG8_STAGE(PG8_SA(1, 1), a1 + hstep, voffA);
            PG8_WAIT_L(8); PG8_BAR; PG8_WAIT_L(0); PG8_MMA(0, 0, At, B0); PG8_BAR; PG8_SCHED;
            PG8_LDB(B1, 0, 1); PG8_STAGE(PG8_SB(0, 0), b2, voffB);
            PG8_BAR; PG8_WAIT_L(0); PG8_MMA(0, 1, At, B1); PG8_BAR;
            PG8_LDA(At, 0, 1); PG8_STAGE(PG8_SA(0, 0), a2, voffA);
            PG8_BAR; PG8_WAIT_L(0); PG8_MMA(1, 0, At, B0); PG8_BAR; PG8_SCHED;
            PG8_STAGE(PG8_SB(0, 1), b2 + hstep, voffB);
            PG8_WAIT_V(6); PG8_BAR; PG8_MMA(1, 1, At, B1); PG8_BAR;
            PG8_LDB(B0, 1, 0); PG8_SCHED; PG8_LDA(At, 1, 0); PG8_STAGE(PG8_SA(0, 1), a2 + hstep, voffA);
            PG8_WAIT_L(8); PG8_BAR; PG8_WAIT_L(0); PG8_MMA(0, 0, At, B0); PG8_BAR; PG8_SCHED;
            PG8_LDB(B1, 1, 1); PG8_STAGE(PG8_SB(1, 0), b3, voffB);
            PG8_BAR; PG8_WAIT_L(0); PG8_MMA(0, 1, At, B1); PG8_BAR;
            PG8_LDA(At, 1, 1); PG8_STAGE(PG8_SA(1, 0), a3, voffA);
            PG8_BAR; PG8_WAIT_L(0); PG8_MMA(1, 0, At, B0); PG8_BAR; PG8_SCHED;
            PG8_STAGE(PG8_SB(1, 1), b3 + hstep, voffB);
            PG8_WAIT_V(6); PG8_BAR; PG8_MMA(1, 1, At, B1); PG8_BAR;
            }
        }
        if constexpr (ALIGN_EPI) { if (wr == 0) PG8_BAR; }
        if constexpr (!Epi::AFTER_DRAIN) { E(acc, cur, wr, wc, fr, fq); S.done(cur); }
        if (!has_next) break;
#pragma unroll
        for (int a = 0; a < 2; ++a)
#pragma unroll
            for (int b = 0; b < 2; ++b)
#pragma unroll
                for (int m = 0; m < 4; ++m)
#pragma unroll
                    for (int n = 0; n < 2; ++n) acc[a][b][m][n] = (f32x4){0.f, 0.f, 0.f, 0.f};
        cur = nxt; cA = nA; cB = nB; ++ui;
        if constexpr (ALIGN_EPI) { if (wr == 1) PG8_BAR; }
    }
    PG8_WAIT_V(0);
    if constexpr (!ALIGN_EPI) { if (wr == 0) PG8_BAR; }
    PG8_BAR;
    if constexpr (Epi::AFTER_DRAIN) { E.fused(acc, cur, wr, wc, fr, fq, lds, wid, lane); S.done(cur); }
#undef PG8_SA
#undef PG8_SB
#undef PG8_STAGE
#undef PG8_LDA
#undef PG8_LDB
#undef PG8_MMA
#undef PG8_WAIT_V
#undef PG8_WAIT_L
#undef PG8_BAR
#undef PG8_SCHED
}
}

#ifndef PG8_SP2
#define PG8_SP2 true
#endif
#ifndef PG8_ALIGN
#define PG8_ALIGN true
#endif

constexpr int NWAVES = 8, NTHR = 512;
constexpr int BATCH = 8, SEQ = 4096, DM = 1024, TOK = BATCH * SEQ;
constexpr int NQKVA = 4608, AW = 512, NKVQ = 3072, FF = 2816, NUP = 5632;
constexpr float LOG2E = 1.4426950408889634f;
constexpr float C2 = 0.125f * LOG2E;
constexpr float RMS_EPS = 1e-6f, SUBLN_EPS = 1e-5f;
constexpr float LAMBDA_INIT = 0.8f - 0.6f * 0.7408182206817179f;

constexpr size_t MiB = 1u << 20;
constexpr size_t WS_WIN = 1 * MiB, WS_WOA = 10 * MiB, WS_WKVQ = 11 * MiB, WS_WOB = 17 * MiB, WS_WUP0 = 19 * MiB, WS_WUP1 = 30 * MiB;
constexpr size_t WS_WDN0 = 41 * MiB, WS_WDN1 = WS_WDN0 + (size_t)DM * FF * 2;
constexpr size_t WS_TABB = 63 * MiB, WS_TABA = WS_TABB + 256 * 1024;
constexpr size_t WS_PAR = 62 * MiB;
constexpr int PAR_NORMG = 0, PAR_CONVW = 8 * 1024, PAR_CONVB = PAR_CONVW + 6 * 5632, PAR_LAM = PAR_CONVB + 2 * 5632, PAR_SUBG = PAR_LAM + 256, PAR_END = PAR_SUBG + 128;
constexpr size_t WS_XN = 64 * MiB;
constexpr size_t WS_BIG = 128 * MiB;
constexpr size_t WS_END = 512 * MiB;
constexpr int TABB_STRIDE = 64 + SEQ;

constexpr int LDS_BYTES = 147456;

#define GAS __attribute__((address_space(1)))
#define LAS __attribute__((address_space(3)))
typedef unsigned short bf16;
typedef unsigned v4u __attribute__((ext_vector_type(4)));
typedef unsigned v2u __attribute__((ext_vector_type(2)));
typedef float f32x4 __attribute__((ext_vector_type(4)));
#define LDS_WAIT() asm volatile("s_waitcnt lgkmcnt(0)" ::: "memory")
#define LAUNDER_V(x) asm volatile("" : "+v"(x))
#define LAUNDER_S(x) asm volatile("" : "+s"(x))
__device__ __forceinline__ unsigned f2bf(float f) { unsigned u = __builtin_bit_cast(unsigned, f); return (u + 0x7fffu + ((u >> 16) & 1u)) >> 16; }
__device__ __forceinline__ unsigned pk2(float lo, float hi) { return f2bf(lo) | (f2bf(hi) << 16); }
__device__ __forceinline__ float bflo(unsigned w) { return __uint_as_float(w << 16); }
__device__ __forceinline__ float bfhi(unsigned w) { return __uint_as_float(w & 0xffff0000u); }
__device__ __forceinline__ float wave_sum(float v) {
#pragma unroll
    for (int o = 1; o < 64; o <<= 1) v += __shfl_xor(v, o);
    return v;
}
__device__ __forceinline__ int t5_bucket(int n) {
    if (n < 16) return n;
    return 16 + (n >= 22) + (n >= 30) + (n >= 40) + (n >= 54) + (n >= 73) + (n >= 99) + (n >= 134) + (n >= 182) + (n >= 246) + (n >= 332) + (n >= 450) + (n >= 609) + (n >= 825) + (n >= 1117) + (n >= 1513);
}

#define PHASE_IDS \
    int tid_ = threadIdx.x; LAUNDER_V(tid_); const int lane = tid_ & 63, wave = __builtin_amdgcn_readfirstlane(tid_ >> 6); \
    const int G_ = gridDim.x, bx_ = blockIdx.x; const int vcu_ = (G_ % 8 == 0) ? (bx_ % 8) * (G_ / 8) + bx_ / 8 : bx_; \
    const int gw = vcu_ * NWAVES + wave, ngw = G_ * NWAVES, gtid = bx_ * NTHR + tid_, gstride = G_ * NTHR; \
    (void)lane; (void)wave; (void)gw; (void)ngw; (void)gtid; (void)gstride;

struct Args {
    const float* in[19]; float* out; unsigned char* ws; int ph_lo, ph_hi;
};

__device__ __forceinline__ void tr_item(const float* W, int K, int N, bf16* WT, int k0, int n0, int drow0, const float* gk, float cs, LAS float* scr, int lane) {
#pragma unroll 8
    for (int i = 0; i < 32; ++i) { const int kk = 2 * i + (lane >> 5); const float g = gk ? gk[k0 + kk] : 1.f;
        scr[kk * 33 + (lane & 31)] = W[(size_t)(k0 + kk) * N + n0 + (lane & 31)] * (g * cs); }
    LDS_WAIT(); asm volatile("" ::: "memory");
    const int c = lane & 7;
#pragma unroll
    for (int j = 0; j < 4; ++j) { const int n = (lane >> 3) + 8 * j; const LAS float* s = scr + (8 * c) * 33 + n;
        v4u o; o.x = pk2(s[0 * 33], s[1 * 33]); o.y = pk2(s[2 * 33], s[3 * 33]); o.z = pk2(s[4 * 33], s[5 * 33]); o.w = pk2(s[6 * 33], s[7 * 33]);
        *(v4u*)(WT + (size_t)(drow0 + n) * K + k0 + 8 * c) = o; }
    LDS_WAIT(); asm volatile("" ::: "memory");
}
__device__ __forceinline__ void tr_mat(int r, const float* W, int K, int N, bf16* WT, int rowoff, const float* gk, int kind, LAS float* scr, int lane) {
    const int nblk = N / 32, kb = r / nblk, nb = r % nblk, n0 = nb * 32; int dr = n0; float cs = 1.f;
    if (kind == 1) cs = ((n0 % 1536) < 512) ? C2 : 1.f;
    if (kind == 2) cs = C2;
    if (kind == 3) dr = (n0 < FF) ? 256 * (n0 / 128) + (n0 % 128) : 256 * ((n0 - FF) / 128) + 128 + ((n0 - FF) % 128);
    tr_item(W, K, N, WT, kb * 64, n0, dr + rowoff, gk, cs, scr, lane);
}

__device__ __forceinline__ void prologue(const Args& a, LAS unsigned char* lds) {
    PHASE_IDS
    LAS float* scr = (LAS float*)(lds + wave * 16384);
    unsigned char* ws = a.ws;
    const float* norm_g = a.in[2];
    constexpr int I_WIN = 16 * 144, I_WOA = 8 * 32, I_SQ = 16 * 32, I_UP = 16 * 176, I_DN = 44 * 32;
    constexpr int NITEMS = I_WIN + I_WOA + 4 * I_SQ + 2 * I_UP + 2 * I_DN;
    for (int it = gw; it < NITEMS; it += ngw) {
        int r = it;
        if (r < I_WIN) { tr_mat(r, a.in[3], DM, NQKVA, (bf16*)(ws + WS_WIN), 0, norm_g + 0 * DM, 1, scr, lane); continue; } r -= I_WIN;
        if (r < I_WOA) { tr_mat(r, a.in[4], AW, DM, (bf16*)(ws + WS_WOA), 0, nullptr, 0, scr, lane); continue; } r -= I_WOA;
        if (r < I_SQ) { tr_mat(r, a.in[6], DM, DM, (bf16*)(ws + WS_WKVQ), 0, a.in[5], 0, scr, lane); continue; } r -= I_SQ;
        if (r < I_SQ) { tr_mat(r, a.in[7], DM, DM, (bf16*)(ws + WS_WKVQ), 1024, a.in[5], 0, scr, lane); continue; } r -= I_SQ;
        if (r < I_SQ) { tr_mat(r, a.in[8], DM, DM, (bf16*)(ws + WS_WKVQ), 2048, norm_g + 4 * DM, 2, scr, lane); continue; } r -= I_SQ;
        if (r < I_SQ) { tr_mat(r, a.in[14], DM, DM, (bf16*)(ws + WS_WOB), 0, nullptr, 0, scr, lane); continue; } r -= I_SQ;
        if (r < I_UP) { tr_mat(r, a.in[15], DM, NUP, (bf16*)(ws + WS_WUP0), 0, norm_g + 2 * DM, 3, scr, lane); continue; } r -= I_UP;
        if (r < I_UP) { tr_mat(r, a.in[15] + (size_t)DM * NUP, DM, NUP, (bf16*)(ws + WS_WUP1), 0, norm_g + 6 * DM, 3, scr, lane); continue; } r -= I_UP;
        if (r < I_DN) { tr_mat(r, a.in[18], FF, DM, (bf16*)(ws + WS_WDN0), 0, nullptr, 0, scr, lane); continue; } r -= I_DN;
        tr_mat(r, a.in[18] + (size_t)FF * DM, FF, DM, (bf16*)(ws + WS_WDN1), 0, nullptr, 0, scr, lane);
    }
    { float* par = (float*)(ws + WS_PAR); const int gt0 = gw * 64 + lane, ngt0 = ngw * 64;
      for (int i = gt0; i < PAR_END; i += ngt0) { float v;
        if (i < PAR_CONVW) v = a.in[2][i]; else if (i < PAR_CONVB) v = a.in[16][i - PAR_CONVW]; else if (i < PAR_LAM) v = a.in[17][i - PAR_CONVB];
        else if (i < PAR_SUBG) { const int k = i - PAR_LAM; v = a.in[9 + (k >> 6)][k & 63]; } else v = a.in[13][i - PAR_SUBG];
        par[i] = v; } }
    const float* table = a.in[1];
    float* tabB = (float*)(ws + WS_TABB); float* tabA = (float*)(ws + WS_TABA);
    const int gt = gw * 64 + lane, ngt = ngw * 64;
    for (int i = gt; i < 8 * TABB_STRIDE; i += ngt) { const int h = i / TABB_STRIDE, d = i % TABB_STRIDE - 64; tabB[i] = d < 0 ? 0.f : table[h * 32 + t5_bucket(d)] * LOG2E; }
    for (int i = gt; i < 3 * 8 * 132; i += ngt) { const int g = i / (8 * 132), h = (i / 132) % 8, du = i % 132; const int r = 1 << (2 * g);
        tabA[i] = du <= 128 ? table[h * 32 + t5_bucket(du * r)] * LOG2E : 0.f; }
    const float* x = a.in[0]; bf16* XN = (bf16*)(ws + WS_XN);
    for (int m = gw; m < TOK; m += ngw) {
        const f32x4* xr = (const f32x4*)(x + (size_t)m * DM) + lane; f32x4 v[4]; float s = 0.f;
#pragma unroll
        for (int j = 0; j < 4; ++j) { v[j] = xr[64 * j]; s += (v[j].x * v[j].x + v[j].y * v[j].y) + (v[j].z * v[j].z + v[j].w * v[j].w); }
        const float rs = 1.f / sqrtf(wave_sum(s) * (1.f / DM) + RMS_EPS);
        v2u* o8 = (v2u*)(XN + (size_t)m * DM) + lane;
#pragma unroll
        for (int j = 0; j < 4; ++j) { v2u w; w.x = pk2(v[j].x * rs, v[j].y * rs); w.y = pk2(v[j].z * rs, v[j].w * rs); o8[64 * j] = w; }
    }
}

__device__ __forceinline__ void rowpass(const bf16* mix, const float* g, const float* hin, float* hout, bf16* xn) {
    PHASE_IDS
    for (int m = gw; m < TOK; m += ngw) {
        const v2u* mr = (const v2u*)(mix + (size_t)m * DM) + lane; f32x4 v[4]; float s = 0.f;
#pragma unroll
        for (int j = 0; j < 4; ++j) { const v2u w = mr[64 * j]; v[j] = (f32x4){bflo(w.x), bfhi(w.x), bflo(w.y), bfhi(w.y)};
            s += (v[j].x * v[j].x + v[j].y * v[j].y) + (v[j].z * v[j].z + v[j].w * v[j].w); }
        const float rs = 1.f / sqrtf(wave_sum(s) * (1.f / DM) + RMS_EPS);
        const f32x4* gr = (const f32x4*)g + lane; const f32x4* hr = (const f32x4*)(hin + (size_t)m * DM) + lane; f32x4* ho = (f32x4*)(hout + (size_t)m * DM) + lane;
        float s2 = 0.f;
#pragma unroll
        for (int j = 0; j < 4; ++j) { const f32x4 gv = gr[64 * j], hv = hr[64 * j]; v[j] = hv + v[j] * rs * gv; ho[64 * j] = v[j];
            s2 += (v[j].x * v[j].x + v[j].y * v[j].y) + (v[j].z * v[j].z + v[j].w * v[j].w); }
        if (xn) {
            const float rs2 = 1.f / sqrtf(wave_sum(s2) * (1.f / DM) + RMS_EPS);
            v2u* o8 = (v2u*)(xn + (size_t)m * DM) + lane;
#pragma unroll
            for (int j = 0; j < 4; ++j) { v2u w; w.x = pk2(v[j].x * rs2, v[j].y * rs2); w.y = pk2(v[j].z * rs2, v[j].w * rs2); o8[64 * j] = w; }
        }
    }
}

__device__ __forceinline__ void ld8(const bf16* p, float* f) { const v4u w = *(const v4u*)p; f[0] = bflo(w.x); f[1] = bfhi(w.x); f[2] = bflo(w.y); f[3] = bfhi(w.y); f[4] = bflo(w.z); f[5] = bfhi(w.z); f[6] = bflo(w.w); f[7] = bfhi(w.w); }

__device__ __forceinline__ void dilated_naive(const bf16* qkv, const float* tabA, bf16* Oa) {
    PHASE_IDS
    for (int idx = gtid; idx < TOK * 8; idx += gstride) {
        const int h = idx & 7, t = idx >> 3, s = t & (SEQ - 1);
        float m = -INFINITY, l = 0.f; float o[64];
#pragma unroll
        for (int d = 0; d < 64; ++d) o[d] = 0.f;
        for (int g = 0; g < 3; ++g) {
            const int r = 1 << (2 * g); const int mu = s >> (2 * g); const int jmax = mu < 128 ? mu : 128;
            const bf16* qp = qkv + (size_t)t * NQKVA + g * 1536 + h * 64; float q[64];
#pragma unroll
            for (int c = 0; c < 8; ++c) ld8(qp + 8 * c, q + 8 * c);
            const float* tb = tabA + (g * 8 + h) * 132;
#pragma unroll 1
            for (int j = 0; j <= jmax; ++j) {
                const bf16* kp = qkv + (size_t)(t - j * r) * NQKVA + g * 1536 + 512 + h * 64; const bf16* vp = kp + 512;
                float dot = 0.f;
#pragma unroll
                for (int c = 0; c < 8; ++c) { float kf[8]; ld8(kp + 8 * c, kf);
#pragma unroll
                    for (int e = 0; e < 8; ++e) dot += q[8 * c + e] * kf[e]; }
                const float tt = dot + tb[j]; const float mn = fmaxf(m, tt); const float al = exp2f(m - mn), p = exp2f(tt - mn);
                l = l * al + p; m = mn;
#pragma unroll
                for (int c = 0; c < 8; ++c) { float vf[8]; ld8(vp + 8 * c, vf);
#pragma unroll
                    for (int e = 0; e < 8; ++e) o[8 * c + e] = o[8 * c + e] * al + p * vf[e]; }
            }
        }
        const float il = 1.f / l; bf16* op = Oa + (size_t)t * AW + h * 64;
#pragma unroll
        for (int c = 0; c < 8; ++c) { v4u w; w.x = pk2(o[8 * c] * il, o[8 * c + 1] * il); w.y = pk2(o[8 * c + 2] * il, o[8 * c + 3] * il); w.z = pk2(o[8 * c + 4] * il, o[8 * c + 5] * il); w.w = pk2(o[8 * c + 6] * il, o[8 * c + 7] * il);
            *(v4u*)(op + 8 * c) = w; }
    }
}

__device__ __forceinline__ void diff_naive(const bf16* kvq, const float* tabB, const float* par, bf16* Ob) {
    PHASE_IDS
    float lam;
    { const float* lp = par + PAR_LAM; const float p1 = lp[lane] * lp[64 + lane], p2 = lp[128 + lane] * lp[192 + lane]; lam = expf(wave_sum(p1)) - expf(wave_sum(p2)) + LAMBDA_INIT; }
    const float* subg = par + PAR_SUBG;
#pragma unroll 1
    for (int w = gw; w < 8 * 8 * 512; w += ngw) {
        const int qg = 511 - (w >> 6), h = w & 7, b = (w >> 3) & 7;
        const int ql = lane >> 3, c = (lane >> 2) & 1, eq = lane & 3; const int q = qg * 8 + ql;
        const size_t row = (size_t)b * SEQ + q;
        v4u qw[8]; { const bf16* qp = kvq + row * NKVQ + 2048 + h * 128 + c * 64;
#pragma unroll
            for (int cc = 0; cc < 8; ++cc) qw[cc] = *(const v4u*)(qp + 8 * cc); }
        float o[32]; float m = -INFINITY, l = 0.f;
#pragma unroll
        for (int d = 0; d < 32; ++d) o[d] = 0.f;
        const float* tb = tabB + h * TABB_STRIDE + 64;
        const int kmax = qg * 8 + 7;
#pragma unroll 1
        for (int k = 0; k <= kmax; ++k) {
            const bf16* kp = kvq + ((size_t)b * SEQ + k) * NKVQ + h * 128 + c * 64; const bf16* vp = kvq + ((size_t)b * SEQ + k) * NKVQ + 1024 + h * 128 + eq * 32;
            float dot = 0.f;
#pragma unroll
            for (int cc = 0; cc < 8; ++cc) { float kf[8]; ld8(kp + 8 * cc, kf); const v4u qq = qw[cc];
                dot += bflo(qq.x) * kf[0] + bfhi(qq.x) * kf[1] + bflo(qq.y) * kf[2] + bfhi(qq.y) * kf[3] + bflo(qq.z) * kf[4] + bfhi(qq.z) * kf[5] + bflo(qq.w) * kf[6] + bfhi(qq.w) * kf[7]; }
            if (k <= q) {
                const float tt = dot + tb[q - k]; const float mn = fmaxf(m, tt); const float al = exp2f(m - mn), p = exp2f(tt - mn);
                l = l * al + p; m = mn;
#pragma unroll
                for (int cc = 0; cc < 4; ++cc) { float vf[8]; ld8(vp + 8 * cc, vf);
#pragma unroll
                    for (int e = 0; e < 8; ++e) o[8 * cc + e] = o[8 * cc + e] * al + p * vf[e]; }
            }
        }
        const float il = 1.f / l; float ss = 0.f;
#pragma unroll
        for (int d = 0; d < 32; ++d) { const float on = o[d] * il; const float other = __shfl_xor(on, 4); o[d] = on - lam * other; ss += o[d] * o[d]; }
        ss += __shfl_xor(ss, 1); ss += __shfl_xor(ss, 2);
        const float rs = 1.f / sqrtf(ss * (1.f / 128.f) + SUBLN_EPS) * (1.f - LAMBDA_INIT);
        if (c == 0) { bf16* op = Ob + row * DM + h * 128 + eq * 32; const float* sg = subg + eq * 32;
#pragma unroll
            for (int cc = 0; cc < 4; ++cc) { v4u wv; wv.x = pk2(o[8 * cc] * rs * sg[8 * cc], o[8 * cc + 1] * rs * sg[8 * cc + 1]); wv.y = pk2(o[8 * cc + 2] * rs * sg[8 * cc + 2], o[8 * cc + 3] * rs * sg[8 * cc + 3]);
                wv.z = pk2(o[8 * cc + 4] * rs * sg[8 * cc + 4], o[8 * cc + 5] * rs * sg[8 * cc + 5]); wv.w = pk2(o[8 * cc + 6] * rs * sg[8 * cc + 6], o[8 * cc + 7] * rs * sg[8 * cc + 7]);
                *(v4u*)(op + 8 * cc) = wv; } }
    }
}

__device__ __forceinline__ void conv_naive(const bf16* u, int half, const float* cw, const float* cb, bf16* gated) {
    PHASE_IDS
    for (int it = gtid; it < 16384 * 352; it += gstride) {
        const int j8 = it % 352, rl = it / 352; const int t = half * 16384 + rl; const int s = t & (SEQ - 1); const int j = j8 * 8;
        const int ucol = 256 * (j / 128) + (j % 128);
        float cg[8], cv[8];
#pragma unroll
        for (int i = 0; i < 8; ++i) { cg[i] = cb[j + i]; cv[i] = cb[FF + j + i]; }
#pragma unroll
        for (int jj = 0; jj < 3; ++jj) { const int ds = 2 - jj;
            if (s - ds >= 0) { const bf16* up = u + (size_t)(rl - ds) * NUP + ucol; float ug[8], uv[8]; ld8(up, ug); ld8(up + 128, uv);
#pragma unroll
                for (int i = 0; i < 8; ++i) { cg[i] += cw[jj * NUP + j + i] * ug[i]; cv[i] += cw[jj * NUP + FF + j + i] * uv[i]; } } }
        float r[8];
#pragma unroll
        for (int i = 0; i < 8; ++i) r[i] = 0.5f * cg[i] * (1.f + erff(cg[i] * 0.70710678118654752f)) * cv[i];
        v4u w; w.x = pk2(r[0], r[1]); w.y = pk2(r[2], r[3]); w.z = pk2(r[4], r[5]); w.w = pk2(r[6], r[7]);
        *(v4u*)(gated + (size_t)t * FF + j) = w;
    }
}


namespace cg = cooperative_groups;
#define GEMM_PHASE(A_, B_, M_, N_, K_, O_, LDC_) do { pg8::Gemm g{(const bf16*)(A_), (const bf16*)(B_), M_, N_, K_}; pg8::StaticOrder S; S.init(M_, N_, (int)gridDim.x, (int)blockIdx.x); \
    pg8::EpiBf16<0> E{(bf16*)(O_), LDC_, nullptr, 0, 0, 1.f}; pg8::gemm_phase<pg8::EpiBf16<0>, pg8::StaticOrder, PG8_ALIGN, PG8_SP2>(lds, g, S, E); } while (0)
__global__ void __launch_bounds__(NTHR, 2) fwd(Args a) {
    extern __shared__ __attribute__((aligned(16))) unsigned char lds_raw[];
    LAS unsigned char* lds = (LAS unsigned char*)lds_raw;
    cg::grid_group grid = cg::this_grid();
    unsigned char* ws = a.ws;
    prologue(a, lds); grid.sync();
    const float* xin = a.in[0]; float* out = a.out;
#define WSP(T, off) ((T*)(ws + (off)))
#define PARP(off) (WSP(const float, WS_PAR) + (off))
    GEMM_PHASE(WSP(bf16, WS_XN), ws + WS_WIN, TOK, NQKVA, DM, WSP(bf16, WS_BIG), NQKVA); grid.sync();
    dilated_naive(WSP(const bf16, WS_BIG), WSP(const float, WS_TABA), WSP(bf16, 416 * MiB)); grid.sync();
    GEMM_PHASE(WSP(bf16, 416 * MiB), ws + WS_WOA, TOK, DM, AW, WSP(bf16, 448 * MiB), DM); grid.sync();
    rowpass(WSP(const bf16, 448 * MiB), PARP(PAR_NORMG + 1 * DM), xin, out, WSP(bf16, WS_XN)); grid.sync();
#pragma unroll 1
    for (int lay = 0; lay < 2; ++lay) {
        if (lay == 1) {
            GEMM_PHASE(WSP(bf16, WS_XN), ws + WS_WKVQ, TOK, NKVQ, DM, WSP(bf16, WS_BIG), NKVQ); grid.sync();
            diff_naive(WSP(const bf16, WS_BIG), WSP(const float, WS_TABB), PARP(0), WSP(bf16, 320 * MiB)); grid.sync();
            GEMM_PHASE(WSP(bf16, 320 * MiB), ws + WS_WOB, TOK, DM, DM, WSP(bf16, 448 * MiB), DM); grid.sync();
            rowpass(WSP(const bf16, 448 * MiB), PARP(PAR_NORMG + 5 * DM), out, out, WSP(bf16, WS_XN)); grid.sync();
        }
#pragma unroll 1
        for (int half = 0; half < 2; ++half) {
            GEMM_PHASE(WSP(bf16, WS_XN) + (size_t)half * (TOK / 2) * DM, ws + (lay ? WS_WUP1 : WS_WUP0), TOK / 2, NUP, DM, WSP(bf16, WS_BIG), NUP); grid.sync();
            conv_naive(WSP(const bf16, WS_BIG), half, PARP(PAR_CONVW + lay * 3 * NUP), PARP(PAR_CONVB + lay * NUP), WSP(bf16, 304 * MiB)); grid.sync();
        }
        GEMM_PHASE(WSP(bf16, 304 * MiB), ws + (lay ? WS_WDN1 : WS_WDN0), TOK, DM, FF, WSP(bf16, WS_BIG), DM); grid.sync();
        rowpass(WSP(const bf16, WS_BIG), PARP(PAR_NORMG + (lay * 4 + 3) * DM), out, out, lay == 0 ? WSP(bf16, WS_XN) : (bf16*)nullptr);
        if (lay == 0) grid.sync();
    }
}

extern "C" void kernel_launch(void* const* d_in, const int* in_sizes, int n_in, void* d_out, int out_size, void* d_ws, size_t ws_size, hipStream_t stream) {
    static int grid = 0;
    if (grid == 0) {
        if (n_in != 19 || in_sizes[0] != TOK * DM || out_size != TOK * DM || ws_size < WS_END) {
            fprintf(stderr, "kernel_launch: unexpected shapes: n_in %d in0 %d out %d ws %zu (need %zu)\n", n_in, n_in > 0 ? in_sizes[0] : -1, out_size, ws_size, (size_t)WS_END); grid = -1; return; }
        int dev = 0, cus = 0, per_cu = 0;
        if (hipGetDevice(&dev) != hipSuccess || hipDeviceGetAttribute(&cus, hipDeviceAttributeMultiprocessorCount, dev) != hipSuccess) { grid = -1; return; }
        if (hipFuncSetAttribute((const void*)fwd, hipFuncAttributeMaxDynamicSharedMemorySize, LDS_BYTES) != hipSuccess) { fprintf(stderr, "kernel_launch: hipFuncSetAttribute failed\n"); grid = -1; return; }
        if (hipOccupancyMaxActiveBlocksPerMultiprocessor(&per_cu, (const void*)fwd, NTHR, LDS_BYTES) != hipSuccess || per_cu < 1) { fprintf(stderr, "kernel_launch: occupancy query says %d blocks/CU\n", per_cu); grid = -1; return; }
        grid = cus;
    }
    if (grid < 0) return;
    Args a{};
    for (int i = 0; i < 19; ++i) a.in[i] = (const float*)d_in[i];
    a.out = (float*)d_out; a.ws = (unsigned char*)d_ws;
    void* args[] = {&a};
    hipError_t e = hipLaunchCooperativeKernel((const void*)fwd, dim3(grid), dim3(NTHR), args, LDS_BYTES, stream);
    if (e != hipSuccess) fprintf(stderr, "cooperative launch failed: %s (grid %d)\n", hipGetErrorString(e), grid);
}
```

```cpp
#include <hip/hip_runtime.h>
#include <hip/hip_cooperative_groups.h>
#include <cstdio>
#include <cstdint>
namespace pg8 {
#define PG8_LAS __attribute__((address_space(3)))
typedef unsigned short bf16_t;
typedef short bf16x8 __attribute__((ext_vector_type(8)));
typedef float f32x4 __attribute__((ext_vector_type(4)));
typedef unsigned u32x4 __attribute__((ext_vector_type(4)));
constexpr int BM = 256, BK = 64, HALF = 128, HTB = HALF * BK * 2  , STAGE_BYTES = 8 * HTB, NXCD = 8, WGM = 8;

__host__ __device__ __forceinline__ int lds_byte(int r, int c) { const int st = (r >> 4) * 2 + (c >> 5), rr = r & 15, cc = c & 31, ob = rr * 64 + cc * 2; return st * 1024 + (ob ^ (((ob >> 9) & 1) << 5)); }
__host__ __device__ __forceinline__ void stage_rc(int b, int& R, int& C) { const int st = b / 1024, sb = b % 1024, swz = sb ^ (((sb >> 9) & 1) << 5); R = (st >> 1) * 16 + swz / 64; C = (st & 1) * 32 + (swz % 64) / 2; }
__host__ __device__ __forceinline__ int perm32(int rho) { const int n = rho >> 4, i = rho & 15; return 8 * (i >> 2) + 4 * n + (i & 3); }

struct Unit { int pm, pn; };
struct Gemm { const bf16_t* A; const bf16_t* Bt; int M, N, K; };

struct StaticOrder {
    int nM, nN, nwg, G, c;
    __host__ __device__ void init(int M, int N, int G_, int c_) { nM = M / BM; nN = N / BM; nwg = nM * nN; G = G_; c = c_; }
    __host__ __device__ bool next(int i, Unit& u) const {
        const long L = (long)i * G + c; if (L >= nwg) return false;
        int wgid = (int)L; { const int q = nwg / NXCD, r = nwg % NXCD, xcd = wgid % NXCD, off = wgid / NXCD; wgid = (xcd < r ? xcd * (q + 1) : r * (q + 1) + (xcd - r) * q) + off; }
        const int nig = WGM * nN, gid = wgid / nig, fm = gid * WGM, gsz = (nM - fm) < WGM ? (nM - fm) : WGM;
        u.pm = fm + ((wgid % nig) % gsz); u.pn = (wgid % nig) / gsz; return true;
    }
    __device__ __forceinline__ void a_ready(const Unit&) const {}
    __device__ __forceinline__ void done(const Unit&) const {}
};

__device__ __forceinline__ unsigned cvt_pk_bf16(float lo, float hi) { unsigned r; asm volatile("v_cvt_pk_bf16_f32 %0, %1, %2" : "=v"(r) : "v"(lo), "v"(hi)); return r; }
typedef float f32x2 __attribute__((ext_vector_type(2)));
__device__ __forceinline__ f32x2 gelu_pk(f32x2 v) {
    const f32x2 av = __builtin_elementwise_abs(v), d = av * 0.2316418882f + 1.0f;
    f32x2 t; t.x = __builtin_amdgcn_rcpf(d.x); t.y = __builtin_amdgcn_rcpf(d.y);
    f32x2 q = t * 0.5307027145f + (-0.7265760135f); q = q * t + 0.7107068705f; q = q * t + (-0.142248368f); q = q * t + 0.127414796f; q = q * t;
    const f32x2 s = (v * v) * (-0.72134752044f);
    f32x2 e; e.x = __builtin_amdgcn_exp2f(s.x); e.y = __builtin_amdgcn_exp2f(s.y);
    const f32x2 m = v * (q * e), r = v - m;
    f32x2 o; o.x = v.x < 0.f ? m.x : r.x; o.y = v.y < 0.f ? m.y : r.y; return o;
}

template <int ACT  > struct EpiBf16 {
    static constexpr bool PERM = true, AFTER_DRAIN = false; static_assert(ACT == 0 || ACT == 1, "EpiBf16: ACT is 0 (none) or 1 (gelu_pk)");
    bf16_t* O; int ldc; const float* bias; int split_cols; size_t split_stride; float scale0;
    __device__ __forceinline__ void operator()(const f32x4 (&acc)[2][2][4][2], const Unit& u, int wr, int wc, int fr, int fq) const {
        const int row0 = u.pm * BM + wr * 64 + fr; int colt = u.pn * BM; bf16_t* base = O;
        float sc = 1.f; if (split_cols) { const int t = colt / split_cols; base += (size_t)t * split_stride; colt -= t * split_cols; if (t == 0) sc = scale0; }
        const int col0 = colt + wc * 32 + 8 * fq, bcol0 = u.pn * BM + wc * 32 + 8 * fq;
        f32x4 bv[2][2];
#pragma unroll
        for (int bj = 0; bj < 2; ++bj)
#pragma unroll
            for (int n = 0; n < 2; ++n) bv[bj][n] = bias ? *(const f32x4*)(bias + bcol0 + bj * HALF + 4 * n) : (f32x4){0.f, 0.f, 0.f, 0.f};
#pragma unroll
        for (int ai = 0; ai < 2; ++ai)
#pragma unroll
            for (int m = 0; m < 4; ++m) { bf16_t* rowp = base + (size_t)(row0 + ai * HALF + m * 16) * ldc + col0;
#pragma unroll
                for (int bj = 0; bj < 2; ++bj) { f32x4 v0 = acc[ai][bj][m][0] + bv[bj][0], v1 = acc[ai][bj][m][1] + bv[bj][1];
                    if (ACT == 1) { f32x2 a = gelu_pk((f32x2){v0[0], v0[1]}), b = gelu_pk((f32x2){v0[2], v0[3]}), c = gelu_pk((f32x2){v1[0], v1[1]}), d = gelu_pk((f32x2){v1[2], v1[3]});
                        v0 = (f32x4){a.x, a.y, b.x, b.y}; v1 = (f32x4){c.x, c.y, d.x, d.y}; }
                    v0 = v0 * sc; v1 = v1 * sc; u32x4 w; w.x = cvt_pk_bf16(v0[0], v0[1]); w.y = cvt_pk_bf16(v0[2], v0[3]); w.z = cvt_pk_bf16(v1[0], v1[1]); w.w = cvt_pk_bf16(v1[2], v1[3]);
                    *(u32x4*)(rowp + bj * HALF) = w; } }
    }
};
template <class Epi, class Sched, bool ALIGN_EPI = false, bool SP2 = false>
__device__ __forceinline__ void gemm_phase(PG8_LAS unsigned char* lds, const Gemm g, const Sched& S, const Epi& E) {
    int tid_l = threadIdx.x; asm volatile("" : "+v"(tid_l));
    const int tid = tid_l, wid = __builtin_amdgcn_readfirstlane(tid >> 6), lane = tid & 63, wr = wid >> 2, wc = wid & 3, fr = lane & 15, fq = lane >> 4;
    const int K = g.K, nt = K / BK;
    unsigned voffA[2], voffB[2];
#pragma unroll
    for (int i = 0; i < 2; ++i) { int R, C; stage_rc(tid * 16 + i * 8192, R, C); const int Rb = Epi::PERM ? ((R & ~31) + perm32(R & 31)) : R;
        voffA[i] = (unsigned)(R * K + C) * 2u; voffB[i] = (unsigned)(Rb * K + C) * 2u; }
    const size_t kstep = (size_t)(BK * 2);
    const size_t hstep = (size_t)HALF * K * 2;
    const size_t tstep = 2 * hstep;
    const unsigned ldsw = (unsigned)wid * 1024u;
    const int aoff = lds_byte(wr * 64 + fr, fq * 8), boff = lds_byte(wc * 32 + fr, fq * 8);
#define PG8_SA(b, h) (((b) * 2 + (h)) * HTB)
#define PG8_SB(b, h) ((4 + (b) * 2 + (h)) * HTB)
#define PG8_STAGE(bufoff, gbase, voff) do { _Pragma("unroll") for (int _i = 0; _i < 2; ++_i) \
        __builtin_amdgcn_global_load_lds((const unsigned*)((const char*)(gbase) + (voff)[_i]), (PG8_LAS unsigned*)(lds + (bufoff) + ldsw + _i * 8192), 16, 0, 0); } while (0)
#define PG8_LDA(dst, b, h) do { _Pragma("unroll") for (int m = 0; m < 4; ++m) _Pragma("unroll") for (int k = 0; k < 2; ++k) dst[m][k] = *(const PG8_LAS bf16x8*)(lds + PG8_SA(b, h) + aoff + m * 2048 + k * 1024); } while (0)
#define PG8_LDB(dst, b, h) do { _Pragma("unroll") for (int n = 0; n < 2; ++n) _Pragma("unroll") for (int k = 0; k < 2; ++k) dst[n][k] = *(const PG8_LAS bf16x8*)(lds + PG8_SB(b, h) + boff + n * 2048 + k * 1024); } while (0)
#define PG8_MMA(ai, bj, At, Bt) do { __builtin_amdgcn_s_setprio(1); _Pragma("unroll") for (int m = 0; m < 4; ++m) _Pragma("unroll") for (int n = 0; n < 2; ++n) _Pragma("unroll") for (int k = 0; k < 2; ++k) \
        acc[ai][bj][m][n] = __builtin_amdgcn_mfma_f32_16x16x32_bf16(Bt[n][k], At[m][k], acc[ai][bj][m][n], 0, 0, 0); __builtin_amdgcn_s_setprio(0); } while (0)
#define PG8_WAIT_V(n) asm volatile("s_waitcnt vmcnt(" #n ")" ::: "memory")
#define PG8_WAIT_L(n) asm volatile("s_waitcnt lgkmcnt(" #n ")" ::: "memory")
#define PG8_BAR __builtin_amdgcn_s_barrier()
#define PG8_SCHED __builtin_amdgcn_sched_barrier(0)
    Unit cur, nxt; int ui = 0;
    if (!S.next(0, cur)) return;
    f32x4 acc[2][2][4][2];
#pragma unroll
    for (int a = 0; a < 2; ++a)
#pragma unroll
        for (int b = 0; b < 2; ++b)
#pragma unroll
            for (int m = 0; m < 4; ++m)
#pragma unroll
                for (int n = 0; n < 2; ++n) acc[a][b][m][n] = (f32x4){0.f, 0.f, 0.f, 0.f};
    bf16x8 At[4][2], B0[2][2], B1[2][2];
    const char* cA = (const char*)g.A + (size_t)cur.pm * tstep; const char* cB = (const char*)g.Bt + (size_t)cur.pn * tstep;
    S.a_ready(cur);
    if constexpr (SP2) {
        PG8_STAGE(PG8_SB(0, 0), cB, voffB); PG8_STAGE(PG8_SB(0, 1), cB + hstep, voffB); PG8_STAGE(PG8_SA(0, 0), cA, voffA); PG8_STAGE(PG8_SA(0, 1), cA + hstep, voffA);
        if (wr == 1) PG8_BAR;
        PG8_WAIT_V(2); PG8_BAR;
        PG8_STAGE(PG8_SB(1, 0), cB + kstep, voffB); PG8_STAGE(PG8_SA(1, 0), cA + kstep, voffA); PG8_STAGE(PG8_SB(1, 1), cB + hstep + kstep, voffB);
        PG8_WAIT_V(6); PG8_BAR;
    } else {
        PG8_STAGE(PG8_SB(0, 0), cB, voffB); PG8_STAGE(PG8_SA(0, 0), cA, voffA); PG8_STAGE(PG8_SB(0, 1), cB + hstep, voffB); PG8_STAGE(PG8_SA(0, 1), cA + hstep, voffA);
        if (wr == 1) PG8_BAR;
        PG8_WAIT_V(4); PG8_BAR;
        PG8_STAGE(PG8_SB(1, 0), cB + kstep, voffB); PG8_STAGE(PG8_SA(1, 0), cA + kstep, voffA); PG8_STAGE(PG8_SB(1, 1), cB + hstep + kstep, voffB);
        PG8_WAIT_V(6); PG8_BAR;
    }
    for (;;) {
        const bool has_next = S.next(ui + 1, nxt);
        const char* nA = has_next ? (const char*)g.A + (size_t)nxt.pm * tstep : cA; const char* nB = has_next ? (const char*)g.Bt + (size_t)nxt.pn * tstep : cB;
        for (int t = 0; t < nt; t += 2) {
            const bool last = (t == nt - 2);
            const char* a1 = cA + (size_t)(t + 1) * kstep;
            const char* a2 = last ? nA : cA + (size_t)(t + 2) * kstep; const char* b2 = last ? nB : cB + (size_t)(t + 2) * kstep;
            const char* a3 = a2 + kstep; const char* b3 = b2 + kstep;
            if (last && has_next) S.a_ready(nxt);
            if constexpr (SP2) {
            PG8_LDB(B0, 0, 0); PG8_LDB(B1, 0, 1); PG8_SCHED; PG8_LDA(At, 0, 0); PG8_STAGE(PG8_SA(1, 1), a1 + hstep, voffA);
            PG8_WAIT_V(8); PG8_WAIT_L(0); PG8_BAR; PG8_MMA(0, 0, At, B0); PG8_MMA(0, 1, At, B1); PG8_BAR; PG8_SCHED;
            PG8_LDA(At, 0, 1); PG8_STAGE(PG8_SB(0, 0), b2, voffB); PG8_STAGE(PG8_SB(0, 1), b2 + hstep, voffB); PG8_STAGE(PG8_SA(0, 0), a2, voffA);
            PG8_WAIT_V(8); PG8_WAIT_L(0); PG8_BAR; PG8_MMA(1, 0, At, B0); PG8_MMA(1, 1, At, B1); PG8_BAR; PG8_SCHED;
            PG8_LDB(B0, 1, 0); PG8_LDB(B1, 1, 1); PG8_SCHED; PG8_LDA(At, 1, 0); PG8_STAGE(PG8_SA(0, 1), a2 + hstep, voffA);
            PG8_WAIT_V(8); PG8_WAIT_L(0); PG8_BAR; PG8_MMA(0, 0, At, B0); PG8_MMA(0, 1, At, B1); PG8_BAR; PG8_SCHED;
            PG8_LDA(At, 1, 1); PG8_STAGE(PG8_SB(1, 0), b3, voffB); PG8_STAGE(PG8_SB(1, 1), b3 + hstep, voffB); PG8_STAGE(PG8_SA(1, 0), a3, voffA);
            PG8_WAIT_V(8); PG8_WAIT_L(0); PG8_BAR; PG8_MMA(1, 0, At, B0); PG8_MMA(1, 1, At, B1); PG8_BAR; PG8_SCHED;
            } else {
            PG8_LDB(B0, 0, 0); PG8_SCHED; PG8_LDA(At, 0, 0); PG8_STAGE(PG8_SA(1, 1), a1 + hstep, voffA);
            PG8_WAIT_L(8); PG8_BAR; PG8_WAIT_L(0); PG8_MMA(0, 0, At, B0); PG8_BAR; PG8_SCHED;
            PG8_LDB(B1, 0, 1); PG8_STAGE(PG8_SB(0, 0), b2, voffB);
            PG8_BAR; PG8_WAIT_L(0); PG8_MMA(0, 1, At, B1); PG8_BAR;
            PG8_LDA(At, 0, 1); PG8_STAGE(PG8_SA(0, 0), a2, voffA);
            PG8_BAR; PG8_WAIT_L(0); PG8_MMA(1, 0, At, B0); PG8_BAR; PG8_SCHED;
            PG8_STAGE(PG8_SB(0, 1), b2 + hstep, voffB);
            PG8_WAIT_V(6); PG8_BAR; PG8_MMA(1, 1, At, B1); PG8_BAR;
            PG8_LDB(B0, 1, 0); PG8_SCHED; PG8_LDA(At, 1, 0); PG8_STAGE(PG8_SA(0, 1), a2 + hstep, voffA);
            PG8_WAIT_L(8); PG8_BAR; PG8_WAIT_L(0); PG8_MMA(0, 0, At, B0); PG8_BAR; PG8_SCHED;
            PG8_LDB(B1, 1, 1); PG8_STAGE(PG8_SB(1, 0), b3, voffB);
            PG8_BAR; PG8_WAIT_L(0); PG8_MMA(0, 1, At, B1); PG8_BAR;
            PG8_LDA(At, 1, 1); PG8_STAGE(PG8_SA(1, 0), a3, voffA);
            PG8_BAR; PG8_WAIT_L(0); PG8_MMA(1, 0, At, B0); PG8_BAR; PG8_SCHED;
            PG8_STAGE(PG8_SB(1, 1), b3 + hstep, voffB);
            PG8_WAIT_V(6); PG8_BAR; PG8_MMA(1, 1, At, B1); PG8_BAR;
            }
        }
        if constexpr (ALIGN_EPI) { if (wr == 0) PG8_BAR; }
        if constexpr (!Epi::AFTER_DRAIN) { E(acc, cur, wr, wc, fr, fq); S.done(cur); }
        if (!has_next) break;
#pragma unroll
        for (int a = 0; a < 2; ++a)
#pragma unroll
            for (int b = 0; b < 2; ++b)
#pragma unroll
                for (int m = 0; m < 4; ++m)
#pragma unroll
                    for (int n = 0; n < 2; ++n) acc[a][b][m][n] = (f32x4){0.f, 0.f, 0.f, 0.f};
        cur = nxt; cA = nA; cB = nB; ++ui;
        if constexpr (ALIGN_EPI) { if (wr == 1) PG8_BAR; }
    }
    PG8_WAIT_V(0);
    if constexpr (!ALIGN_EPI) { if (wr == 0) PG8_BAR; }
    PG8_BAR;
    if constexpr (Epi::AFTER_DRAIN) { E.fused(acc, cur, wr, wc, fr, fq, lds, wid, lane); S.done(cur); }
#undef PG8_SA
#undef PG8_SB
#undef PG8_STAGE
#undef PG8_LDA
#undef PG8_LDB
#undef PG8_MMA
#undef PG8_WAIT_V
#undef PG8_WAIT_L
#undef PG8_BAR
#undef PG8_SCHED
}
}

#ifndef PG8_SP2
#define PG8_SP2 true
#endif
#ifndef PG8_ALIGN
#define PG8_ALIGN true
#endif

constexpr int NWAVES = 8, NTHR = 512;
constexpr int BATCH = 8, SEQ = 4096, DM = 1024, TOK = BATCH * SEQ;
constexpr int NQKVA = 4608, AW = 512, NKVQ = 3072, FF = 2816, NUP = 5632;
constexpr float LOG2E = 1.4426950408889634f;
constexpr float C2 = 0.125f * LOG2E;
constexpr float RMS_EPS = 1e-6f, SUBLN_EPS = 1e-5f;
constexpr float LAMBDA_INIT = 0.8f - 0.6f * 0.7408182206817179f;

constexpr size_t MiB = 1u << 20;
constexpr size_t WS_WIN = 1 * MiB, WS_WOA = 10 * MiB, WS_WKVQ = 11 * MiB, WS_WOB = 17 * MiB, WS_WUP0 = 19 * MiB, WS_WUP1 = 30 * MiB;
constexpr size_t WS_WDN0 = 41 * MiB, WS_WDN1 = WS_WDN0 + (size_t)DM * FF * 2;
constexpr size_t WS_TABB = 63 * MiB, WS_TABA = WS_TABB + 256 * 1024;
constexpr size_t WS_PAR = 62 * MiB;
constexpr int PAR_NORMG = 0, PAR_CONVW = 8 * 1024, PAR_CONVB = PAR_CONVW + 6 * 5632, PAR_LAM = PAR_CONVB + 2 * 5632, PAR_SUBG = PAR_LAM + 256, PAR_END = PAR_SUBG + 128;
constexpr size_t WS_XN = 64 * MiB;
constexpr size_t WS_BIG = 128 * MiB;
constexpr size_t WS_END = 512 * MiB;
constexpr int TABB_STRIDE = 64 + SEQ;

constexpr int LDS_BYTES = 147456;

#define GAS __attribute__((address_space(1)))
#define LAS __attribute__((address_space(3)))
typedef unsigned short bf16;
typedef unsigned v4u __attribute__((ext_vector_type(4)));
typedef unsigned v2u __attribute__((ext_vector_type(2)));
typedef float f32x4 __attribute__((ext_vector_type(4)));
#define LDS_WAIT() asm volatile("s_waitcnt lgkmcnt(0)" ::: "memory")
#define LAUNDER_V(x) asm volatile("" : "+v"(x))
#define LAUNDER_S(x) asm volatile("" : "+s"(x))
__device__ __forceinline__ unsigned f2bf(float f) { unsigned u = __builtin_bit_cast(unsigned, f); return (u + 0x7fffu + ((u >> 16) & 1u)) >> 16; }
__device__ __forceinline__ unsigned pk2(float lo, float hi) { return f2bf(lo) | (f2bf(hi) << 16); }
__device__ __forceinline__ float bflo(unsigned w) { return __uint_as_float(w << 16); }
__device__ __forceinline__ float bfhi(unsigned w) { return __uint_as_float(w & 0xffff0000u); }
__device__ __forceinline__ float wave_sum(float v) {
#pragma unroll
    for (int o = 1; o < 64; o <<= 1) v += __shfl_xor(v, o);
    return v;
}
__device__ __forceinline__ int t5_bucket(int n) {
    if (n < 16) return n;
    return 16 + (n >= 22) + (n >= 30) + (n >= 40) + (n >= 54) + (n >= 73) + (n >= 99) + (n >= 134) + (n >= 182) + (n >= 246) + (n >= 332) + (n >= 450) + (n >= 609) + (n >= 825) + (n >= 1117) + (n >= 1513);
}

#define PHASE_IDS \
    int tid_ = threadIdx.x; LAUNDER_V(tid_); const int lane = tid_ & 63, wave = __builtin_amdgcn_readfirstlane(tid_ >> 6); \
    const int G_ = gridDim.x, bx_ = blockIdx.x; const int vcu_ = (G_ % 8 == 0) ? (bx_ % 8) * (G_ / 8) + bx_ / 8 : bx_; \
    const int gw = vcu_ * NWAVES + wave, ngw = G_ * NWAVES, gtid = bx_ * NTHR + tid_, gstride = G_ * NTHR; \
    (void)lane; (void)wave; (void)gw; (void)ngw; (void)gtid; (void)gstride;

struct Args {
    const float* in[19]; float* out; unsigned char* ws; int ph_lo, ph_hi;
};

__device__ __forceinline__ void tr_item(const float* W, int K, int N, bf16* WT, int k0, int n0, int drow0, const float* gk, float cs, LAS float* scr, int lane) {
#pragma unroll 8
    for (int i = 0; i < 32; ++i) { const int kk = 2 * i + (lane >> 5); const float g = gk ? gk[k0 + kk] : 1.f;
        scr[kk * 33 + (lane & 31)] = W[(size_t)(k0 + kk) * N + n0 + (lane & 31)] * (g * cs); }
    LDS_WAIT(); asm volatile("" ::: "memory");
    const int c = lane & 7;
#pragma unroll
    for (int j = 0; j < 4; ++j) { const int n = (lane >> 3) + 8 * j; const LAS float* s = scr + (8 * c) * 33 + n;
        v4u o; o.x = pk2(s[0 * 33], s[1 * 33]); o.y = pk2(s[2 * 33], s[3 * 33]); o.z = pk2(s[4 * 33], s[5 * 33]); o.w = pk2(s[6 * 33], s[7 * 33]);
        *(v4u*)(WT + (size_t)(drow0 + n) * K + k0 + 8 * c) = o; }
    LDS_WAIT(); asm volatile("" ::: "memory");
}
__device__ __forceinline__ void tr_mat(int r, const float* W, int K, int N, bf16* WT, int rowoff, const float* gk, int kind, LAS float* scr, int lane) {
    const int nblk = N / 32, kb = r / nblk, nb = r % nblk, n0 = nb * 32; int dr = n0; float cs = 1.f;
    if (kind == 1) cs = ((n0 % 1536) < 512) ? C2 : 1.f;
    if (kind == 2) cs = C2;
    if (kind == 3) dr = (n0 < FF) ? 256 * (n0 / 128) + (n0 % 128) : 256 * ((n0 - FF) / 128) + 128 + ((n0 - FF) % 128);
    tr_item(W, K, N, WT, kb * 64, n0, dr + rowoff, gk, cs, scr, lane);
}

__device__ __forceinline__ void prologue(const Args& a, LAS unsigned char* lds) {
    PHASE_IDS
    LAS float* scr = (LAS float*)(lds + wave * 16384);
    unsigned char* ws = a.ws;
    const float* norm_g = a.in[2];
    constexpr int I_WIN = 16 * 144, I_WOA = 8 * 32, I_SQ = 16 * 32, I_UP = 16 * 176, I_DN = 44 * 32;
    constexpr int NITEMS = I_WIN + I_WOA + 4 * I_SQ + 2 * I_UP + 2 * I_DN;
    for (int it = gw; it < NITEMS; it += ngw) {
        int r = it;
        if (r < I_WIN) { tr_mat(r, a.in[3], DM, NQKVA, (bf16*)(ws + WS_WIN), 0, norm_g + 0 * DM, 1, scr, lane); continue; } r -= I_WIN;
        if (r < I_WOA) { tr_mat(r, a.in[4], AW, DM, (bf16*)(ws + WS_WOA), 0, nullptr, 0, scr, lane); continue; } r -= I_WOA;
        if (r < I_SQ) { tr_mat(r, a.in[6], DM, DM, (bf16*)(ws + WS_WKVQ), 0, a.in[5], 0, scr, lane); continue; } r -= I_SQ;
        if (r < I_SQ) { tr_mat(r, a.in[7], DM, DM, (bf16*)(ws + WS_WKVQ), 1024, a.in[5], 0, scr, lane); continue; } r -= I_SQ;
        if (r < I_SQ) { tr_mat(r, a.in[8], DM, DM, (bf16*)(ws + WS_WKVQ), 2048, norm_g + 4 * DM, 2, scr, lane); continue; } r -= I_SQ;
        if (r < I_SQ) { tr_mat(r, a.in[14], DM, DM, (bf16*)(ws + WS_WOB), 0, nullptr, 0, scr, lane); continue; } r -= I_SQ;
        if (r < I_UP) { tr_mat(r, a.in[15], DM, NUP, (bf16*)(ws + WS_WUP0), 0, norm_g + 2 * DM, 3, scr, lane); continue; } r -= I_UP;
        if (r < I_UP) { tr_mat(r, a.in[15] + (size_t)DM * NUP, DM, NUP, (bf16*)(ws + WS_WUP1), 0, norm_g + 6 * DM, 3, scr, lane); continue; } r -= I_UP;
        if (r < I_DN) { tr_mat(r, a.in[18], FF, DM, (bf16*)(ws + WS_WDN0), 0, nullptr, 0, scr, lane); continue; } r -= I_DN;
        tr_mat(r, a.in[18] + (size_t)FF * DM, FF, DM, (bf16*)(ws + WS_WDN1), 0, nullptr, 0, scr, lane);
    }
    { float* par = (float*)(ws + WS_PAR); const int gt0 = gw * 64 + lane, ngt0 = ngw * 64;
      for (int i = gt0; i < PAR_END; i += ngt0) { float v;
        if (i < PAR_CONVW) v = a.in[2][i]; else if (i < PAR_CONVB) v = a.in[16][i - PAR_CONVW]; else if (i < PAR_LAM) v = a.in[17][i - PAR_CONVB];
        else if (i < PAR_SUBG) { const int k = i - PAR_LAM; v = a.in[9 + (k >> 6)][k & 63]; } else v = a.in[13][i - PAR_SUBG];
        par[i] = v; } }
    const float* table = a.in[1];
    float* tabB = (float*)(ws + WS_TABB); float* tabA = (float*)(ws + WS_TABA);
    const int gt = gw * 64 + lane, ngt = ngw * 64;
    for (int i = gt; i < 8 * TABB_STRIDE; i += ngt) { const int h = i / TABB_STRIDE, d = i % TABB_STRIDE - 64; tabB[i] = d < 0 ? 0.f : table[h * 32 + t5_bucket(d)] * LOG2E; }
    for (int i = gt; i < 3 * 8 * 132; i += ngt) { const int g = i / (8 * 132), h = (i / 132) % 8, du = i % 132; const int r = 1 << (2 * g);
        tabA[i] = du <= 128 ? table[h * 32 + t5_bucket(du * r)] * LOG2E : 0.f; }
    const float* x = a.in[0]; bf16* XN = (bf16*)(ws + WS_XN);
    for (int m = gw; m < TOK; m += ngw) {
        const f32x4* xr = (const f32x4*)(x + (size_t)m * DM) + lane; f32x4 v[4]; float s = 0.f;
#pragma unroll
        for (int j = 0; j < 4; ++j) { v[j] = xr[64 * j]; s += (v[j].x * v[j].x + v[j].y * v[j].y) + (v[j].z * v[j].z + v[j].w * v[j].w); }
        const float rs = 1.f / sqrtf(wave_sum(s) * (1.f / DM) + RMS_EPS);
        v2u* o8 = (v2u*)(XN + (size_t)m * DM) + lane;
#pragma unroll
        for (int j = 0; j < 4; ++j) { v2u w; w.x = pk2(v[j].x * rs, v[j].y * rs); w.y = pk2(v[j].z * rs, v[j].w * rs); o8[64 * j] = w; }
    }
}

__device__ __forceinline__ void rowpass(const bf16* mix, const float* g, const float* hin, float* hout, bf16* xn) {
    PHASE_IDS
    for (int m = gw; m < TOK; m += ngw) {
        const v2u* mr = (const v2u*)(mix + (size_t)m * DM) + lane; f32x4 v[4]; float s = 0.f;
#pragma unroll
        for (int j = 0; j < 4; ++j) { const v2u w = mr[64 * j]; v[j] = (f32x4){bflo(w.x), bfhi(w.x), bflo(w.y), bfhi(w.y)};
            s += (v[j].x * v[j].x + v[j].y * v[j].y) + (v[j].z * v[j].z + v[j].w * v[j].w); }
        const float rs = 1.f / sqrtf(wave_sum(s) * (1.f / DM) + RMS_EPS);
        const f32x4* gr = (const f32x4*)g + lane; const f32x4* hr = (const f32x4*)(hin + (size_t)m * DM) + lane; f32x4* ho = (f32x4*)(hout + (size_t)m * DM) + lane;
        float s2 = 0.f;
#pragma unroll
        for (int j = 0; j < 4; ++j) { const f32x4 gv = gr[64 * j], hv = hr[64 * j]; v[j] = hv + v[j] * rs * gv; ho[64 * j] = v[j];
            s2 += (v[j].x * v[j].x + v[j].y * v[j].y) + (v[j].z * v[j].z + v[j].w * v[j].w); }
        if (xn) {
            const float rs2 = 1.f / sqrtf(wave_sum(s2) * (1.f / DM) + RMS_EPS);
            v2u* o8 = (v2u*)(xn + (size_t)m * DM) + lane;
#pragma unroll
            for (int j = 0; j < 4; ++j) { v2u w; w.x = pk2(v[j].x * rs2, v[j].y * rs2); w.y = pk2(v[j].z * rs2, v[j].w * rs2); o8[64 * j] = w; }
        }
    }
}

__device__ __forceinline__ void ld8(const bf16* p, float* f) { const v4u w = *(const v4u*)p; f[0] = bflo(w.x); f[1] = bfhi(w.x); f[2] = bflo(w.y); f[3] = bfhi(w.y); f[4] = bflo(w.z); f[5] = bfhi(w.z); f[6] = bflo(w.w); f[7] = bfhi(w.w); }

__device__ __forceinline__ void dilated_naive(const bf16* qkv, const float* tabA, bf16* Oa) {
    PHASE_IDS
    for (int idx = gtid; idx < TOK * 8; idx += gstride) {
        const int h = idx & 7, t = idx >> 3, s = t & (SEQ - 1);
        float m = -INFINITY, l = 0.f; float o[64];
#pragma unroll
        for (int d = 0; d < 64; ++d) o[d] = 0.f;
        for (int g = 0; g < 3; ++g) {
            const int r = 1 << (2 * g); const int mu = s >> (2 * g); const int jmax = mu < 128 ? mu : 128;
            const bf16* qp = qkv + (size_t)t * NQKVA + g * 1536 + h * 64; float q[64];
#pragma unroll
            for (int c = 0; c < 8; ++c) ld8(qp + 8 * c, q + 8 * c);
            const float* tb = tabA + (g * 8 + h) * 132;
#pragma unroll 1
            for (int j = 0; j <= jmax; ++j) {
                const bf16* kp = qkv + (size_t)(t - j * r) * NQKVA + g * 1536 + 512 + h * 64; const bf16* vp = kp + 512;
                float dot = 0.f;
#pragma unroll
                for (int c = 0; c < 8; ++c) { float kf[8]; ld8(kp + 8 * c, kf);
#pragma unroll
                    for (int e = 0; e < 8; ++e) dot += q[8 * c + e] * kf[e]; }
                const float tt = dot + tb[j]; const float mn = fmaxf(m, tt); const float al = exp2f(m - mn), p = exp2f(tt - mn);
                l = l * al + p; m = mn;
#pragma unroll
                for (int c = 0; c < 8; ++c) { float vf[8]; ld8(vp + 8 * c, vf);
#pragma unroll
                    for (int e = 0; e < 8; ++e) o[8 * c + e] = o[8 * c + e] * al + p * vf[e]; }
            }
        }
        const float il = 1.f / l; bf16* op = Oa + (size_t)t * AW + h * 64;
#pragma unroll
        for (int c = 0; c < 8; ++c) { v4u w; w.x = pk2(o[8 * c] * il, o[8 * c + 1] * il); w.y = pk2(o[8 * c + 2] * il, o[8 * c + 3] * il); w.z = pk2(o[8 * c + 4] * il, o[8 * c + 5] * il); w.w = pk2(o[8 * c + 6] * il, o[8 * c + 7] * il);
            *(v4u*)(op + 8 * c) = w; }
    }
}

__device__ __forceinline__ void diff_naive(const bf16* kvq, const float* tabB, const float* par, bf16* Ob) {
    PHASE_IDS
    float lam;
    { const float* lp = par + PAR_LAM; const float p1 = lp[lane] * lp[64 + lane], p2 = lp[128 + lane] * lp[192 + lane]; lam = expf(wave_sum(p1)) - expf(wave_sum(p2)) + LAMBDA_INIT; }
    const float* subg = par + PAR_SUBG;
#pragma unroll 1
    for (int w = gw; w < 8 * 8 * 512; w += ngw) {
        const int qg = 511 - (w >> 6), h = w & 7, b = (w >> 3) & 7;
        const int ql = lane >> 3, c = (lane >> 2) & 1, eq = lane & 3; const int q = qg * 8 + ql;
        const size_t row = (size_t)b * SEQ + q;
        v4u qw[8]; { const bf16* qp = kvq + row * NKVQ + 2048 + h * 128 + c * 64;
#pragma unroll
            for (int cc = 0; cc < 8; ++cc) qw[cc] = *(const v4u*)(qp + 8 * cc); }
        float o[32]; float m = -INFINITY, l = 0.f;
#pragma unroll
        for (int d = 0; d < 32; ++d) o[d] = 0.f;
        const float* tb = tabB + h * TABB_STRIDE + 64;
        const int kmax = qg * 8 + 7;
#pragma unroll 1
        for (int k = 0; k <= kmax; ++k) {
            const bf16* kp = kvq + ((size_t)b * SEQ + k) * NKVQ + h * 128 + c * 64; const bf16* vp = kvq + ((size_t)b * SEQ + k) * NKVQ + 1024 + h * 128 + eq * 32;
            float dot = 0.f;
#pragma unroll
            for (int cc = 0; cc < 8; ++cc) { float kf[8]; ld8(kp + 8 * cc, kf); const v4u qq = qw[cc];
                dot += bflo(qq.x) * kf[0] + bfhi(qq.x) * kf[1] + bflo(qq.y) * kf[2] + bfhi(qq.y) * kf[3] + bflo(qq.z) * kf[4] + bfhi(qq.z) * kf[5] + bflo(qq.w) * kf[6] + bfhi(qq.w) * kf[7]; }
            if (k <= q) {
                const float tt = dot + tb[q - k]; const float mn = fmaxf(m, tt); const float al = exp2f(m - mn), p = exp2f(tt - mn);
                l = l * al + p; m = mn;
#pragma unroll
                for (int cc = 0; cc < 4; ++cc) { float vf[8]; ld8(vp + 8 * cc, vf);
#pragma unroll
                    for (int e = 0; e < 8; ++e) o[8 * cc + e] = o[8 * cc + e] * al + p * vf[e]; }
            }
        }
        const float il = 1.f / l; float ss = 0.f;
#pragma unroll
        for (int d = 0; d < 32; ++d) { const float on = o[d] * il; const float other = __shfl_xor(on, 4); o[d] = on - lam * other; ss += o[d] * o[d]; }
        ss += __shfl_xor(ss, 1); ss += __shfl_xor(ss, 2);
        const float rs = 1.f / sqrtf(ss * (1.f / 128.f) + SUBLN_EPS) * (1.f - LAMBDA_INIT);
        if (c == 0) { bf16* op = Ob + row * DM + h * 128 + eq * 32; const float* sg = subg + eq * 32;
#pragma unroll
            for (int cc = 0; cc < 4; ++cc) { v4u wv; wv.x = pk2(o[8 * cc] * rs * sg[8 * cc], o[8 * cc + 1] * rs * sg[8 * cc + 1]); wv.y = pk2(o[8 * cc + 2] * rs * sg[8 * cc + 2], o[8 * cc + 3] * rs * sg[8 * cc + 3]);
                wv.z = pk2(o[8 * cc + 4] * rs * sg[8 * cc + 4], o[8 * cc + 5] * rs * sg[8 * cc + 5]); wv.w = pk2(o[8 * cc + 6] * rs * sg[8 * cc + 6], o[8 * cc + 7] * rs * sg[8 * cc + 7]);
                *(v4u*)(op + 8 * cc) = wv; } }
    }
}

namespace da {
typedef short bf16x8 __attribute__((ext_vector_type(8)));
typedef short s16x4 __attribute__((ext_vector_type(4)));
typedef short v4i16_t __attribute__((ext_vector_type(4)));
typedef float f32x16 __attribute__((ext_vector_type(16)));
typedef float f32x2_t __attribute__((ext_vector_type(2))); typedef __bf16 bf16x2_t __attribute__((ext_vector_type(2)));
constexpr int KBUF = 0, VBUF = 32768, TABL = 65536, TABL_FLOATS = 128 + SEQ, XCH = 0;
__device__ __forceinline__ unsigned cvtpk(float lo, float hi) { f32x2_t v = {lo, hi}; bf16x2_t b = __builtin_convertvector(v, bf16x2_t); return __builtin_bit_cast(unsigned, b); }
__device__ __forceinline__ s16x4 vtr(const LAS unsigned char* p) { return __builtin_bit_cast(s16x4, __builtin_amdgcn_ds_read_tr16_b64_v4i16((LAS v4i16_t*)p)); }
__device__ __forceinline__ float swapmax(float v) { auto rr = __builtin_amdgcn_permlane32_swap(__float_as_uint(v), __float_as_uint(v), false, false); return fmaxf(__uint_as_float(rr[0]), __uint_as_float(rr[1])); }
__device__ __forceinline__ float swapsum(float v) { auto rr = __builtin_amdgcn_permlane32_swap(__float_as_uint(v), __float_as_uint(v), false, false); return __uint_as_float(rr[0]) + __uint_as_float(rr[1]); }
#define DA_CST0(r) (((r) & 3) + 8 * ((r) >> 2))

__device__ __forceinline__ void diff_unit(int b, int h, int qblk, const bf16* kvq, float lam, const float* subg, bf16* Ob, LAS unsigned char* lds, int wave, int lane) {
    const int r32 = lane & 31, hi = lane >> 5, qt = wave >> 1, c = wave & 1;
    const int q0 = qblk * 128 + qt * 32, NT = 2 * qblk + 2;
    const size_t rowb = (size_t)b * SEQ;
    const LAS float* tabL = (const LAS float*)(lds + TABL);
    bf16x8 qf[4];
    { const bf16* qp = kvq + (rowb + q0 + r32) * NKVQ + 2048 + h * 128 + c * 64 + hi * 8;
#pragma unroll
      for (int d0 = 0; d0 < 4; ++d0) qf[d0] = *(const bf16x8*)(qp + 16 * d0); }
    const bf16* ksrc = kvq + (rowb + lane) * NKVQ + h * 128 + wave * 8;
    const bf16* vsrc = kvq + (rowb + 16 * (wave & 3) + (lane >> 2)) * NKVQ + 1024 + h * 128 + (wave >> 2) * 32 + (lane & 3) * 8;
    const int sdst = wave * 1024 + lane * 16;
    const LAS unsigned char* vb0 = lds + VBUF + ((lane >> 4) & 1) * 32 + (lane & 3) * 8 + (4 * hi + ((lane & 15) >> 2)) * 64;
    f32x16 o[4];
#pragma unroll
    for (int i = 0; i < 4; ++i)
#pragma unroll
        for (int r = 0; r < 16; ++r) o[i][r] = 0.f;
    float m = -INFINITY, l = 0.f;
    v4u kr0, kr1, vr0, vr1;
    kr0 = *(const v4u*)ksrc; kr1 = *(const v4u*)(ksrc + 64); vr0 = *(const v4u*)vsrc; vr1 = *(const v4u*)(vsrc + 64);
    *(LAS v4u*)(lds + KBUF + sdst) = kr0; *(LAS v4u*)(lds + KBUF + 8192 + sdst) = kr1; *(LAS v4u*)(lds + VBUF + sdst) = vr0; *(LAS v4u*)(lds + VBUF + 8192 + sdst) = vr1;
    __syncthreads();
#pragma unroll 1
    for (int kt = 0; kt < NT; ++kt) {
        const int buf = kt & 1; const bool more = kt + 1 < NT;
        if (more) { const size_t off = (size_t)(kt + 1) * 64 * NKVQ; kr0 = *(const v4u*)(ksrc + off); kr1 = *(const v4u*)(ksrc + off + 64); vr0 = *(const v4u*)(vsrc + off); vr1 = *(const v4u*)(vsrc + off + 64); }
        if (64 * kt <= q0 + 31) {
            f32x16 p0, p1;
#pragma unroll
            for (int r = 0; r < 16; ++r) { p0[r] = 0.f; p1[r] = 0.f; }
            const LAS unsigned char* kb = lds + KBUF + buf * 16384 + (8 * c + hi) * 1024 + r32 * 16;
#pragma unroll
            for (int d0 = 0; d0 < 4; ++d0) { const bf16x8 a0 = *(const LAS bf16x8*)(kb + d0 * 2048), a1 = *(const LAS bf16x8*)(kb + d0 * 2048 + 512);
                p0 = __builtin_amdgcn_mfma_f32_32x32x16_bf16(a0, qf[d0], p0, 0, 0, 0); p1 = __builtin_amdgcn_mfma_f32_32x32x16_bf16(a1, qf[d0], p1, 0, 0, 0); }
            const int idx0 = q0 + r32 - 64 * kt - 4 * hi;
            const LAS float* tb = tabL + (128 - 59) + idx0;
#pragma unroll
            for (int r = 0; r < 16; ++r) { p0[r] += tb[59 - DA_CST0(r)]; p1[r] += tb[27 - DA_CST0(r)]; }
            if (64 * kt + 63 > q0) {
#pragma unroll
                for (int r = 0; r < 16; ++r) { if (DA_CST0(r) > idx0) p0[r] = -INFINITY; if (32 + DA_CST0(r) > idx0) p1[r] = -INFINITY; }
            }
            float rm = fmaxf(p0[0], p1[0]);
#pragma unroll
            for (int r = 1; r < 16; ++r) rm = fmaxf(rm, fmaxf(p0[r], p1[r]));
            rm = swapmax(rm);
            const float mn = fmaxf(m, rm); const float al = __builtin_amdgcn_exp2f(m - mn); m = mn;
            float ls = 0.f;
#pragma unroll
            for (int r = 0; r < 16; ++r) { p0[r] = __builtin_amdgcn_exp2f(p0[r] - mn); p1[r] = __builtin_amdgcn_exp2f(p1[r] - mn); ls += p0[r] + p1[r]; }
            l = l * al + ls;
#pragma unroll
            for (int i = 0; i < 4; ++i)
#pragma unroll
                for (int r = 0; r < 16; ++r) o[i][r] *= al;
            v4u pw[4];
#pragma unroll
            for (int x = 0; x < 4; ++x) { pw[0][x] = cvtpk(p0[2 * x], p0[2 * x + 1]); pw[1][x] = cvtpk(p0[8 + 2 * x], p0[9 + 2 * x]); pw[2][x] = cvtpk(p1[2 * x], p1[2 * x + 1]); pw[3][x] = cvtpk(p1[8 + 2 * x], p1[9 + 2 * x]); }
            const LAS unsigned char* vb = vb0 + buf * 16384;
#pragma unroll
            for (int db = 0; db < 4; ++db)
#pragma unroll
                for (int ks = 0; ks < 4; ++ks) { const s16x4 lo = vtr(vb + db * 4096 + ks * 1024), hh = vtr(vb + db * 4096 + ks * 1024 + 512);
                    const bf16x8 vf = (bf16x8){lo[0], lo[1], lo[2], lo[3], hh[0], hh[1], hh[2], hh[3]};
                    o[db] = __builtin_amdgcn_mfma_f32_32x32x16_bf16(vf, __builtin_bit_cast(bf16x8, pw[ks]), o[db], 0, 0, 0); }
        }
        if (more) { const int nb = (buf ^ 1) * 16384; *(LAS v4u*)(lds + KBUF + nb + sdst) = kr0; *(LAS v4u*)(lds + KBUF + nb + 8192 + sdst) = kr1; *(LAS v4u*)(lds + VBUF + nb + sdst) = vr0; *(LAS v4u*)(lds + VBUF + nb + 8192 + sdst) = vr1; }
        __syncthreads();
    }
    const float il = 1.f / swapsum(l);
    LAS float* xch = (LAS float*)(lds + XCH) + (qt * 64) * 64 + lane;
    if (c == 1) {
#pragma unroll
        for (int i = 0; i < 4; ++i)
#pragma unroll
            for (int r = 0; r < 16; ++r) xch[(i * 16 + r) * 64] = o[i][r] * il;
    }
    __syncthreads();
    if (c == 0) {
        float ss = 0.f;
#pragma unroll
        for (int i = 0; i < 4; ++i)
#pragma unroll
            for (int r = 0; r < 16; ++r) { const float v = o[i][r] * il - lam * xch[(i * 16 + r) * 64]; o[i][r] = v; ss += v * v; }
        ss = swapsum(ss);
        const float rs = 1.f / sqrtf(ss * (1.f / 128.f) + SUBLN_EPS) * (1.f - LAMBDA_INIT);
        bf16* op = Ob + (rowb + q0 + r32) * DM + h * 128 + 4 * hi;
#pragma unroll
        for (int i = 0; i < 4; ++i)
#pragma unroll
            for (int rr = 0; rr < 4; ++rr) { const f32x4 sg = *(const f32x4*)(subg + 32 * i + 8 * rr + 4 * hi);
                v2u w; w.x = cvtpk(o[i][4 * rr] * rs * sg.x, o[i][4 * rr + 1] * rs * sg.y); w.y = cvtpk(o[i][4 * rr + 2] * rs * sg.z, o[i][4 * rr + 3] * rs * sg.w);
                *(v2u*)(op + 32 * i + 8 * rr) = w; }
    }
    __syncthreads();
}
}

__device__ __forceinline__ void diff_attn_phase(const bf16* kvq, const float* tabB, const float* par, bf16* Ob, LAS unsigned char* lds) {
    PHASE_IDS
    float lam;
    { const float* lp = par + PAR_LAM; const float p1 = lp[lane] * lp[64 + lane], p2 = lp[128 + lane] * lp[192 + lane]; lam = expf(wave_sum(p1)) - expf(wave_sum(p2)) + LAMBDA_INIT; }
    const float* subg = par + PAR_SUBG;
    const int bh = vcu_ >> 2, j = vcu_ & 3, b = bh >> 3, h = bh & 7;
    { LAS float* tabL = (LAS float*)(lds + da::TABL); const float* src = tabB + h * TABB_STRIDE;
      for (int i = tid_; i < da::TABL_FLOATS; i += NTHR) tabL[i] = i < 64 ? 0.f : src[i - 64]; }
    __syncthreads();
#pragma unroll 1
    for (int u = 0; u < 8; ++u) {
        const int base = 4 * (u >> 1) + j; const int qblk = (u & 1) ? 31 - base : base;
        da::diff_unit(b, h, qblk, kvq, lam, subg, Ob, lds, wave, lane);
    }
}

__device__ __forceinline__ void conv_naive(const bf16* u, int half, const float* cw, const float* cb, bf16* gated) {
    PHASE_IDS
    for (int it = gtid; it < 16384 * 352; it += gstride) {
        const int j8 = it % 352, rl = it / 352; const int t = half * 16384 + rl; const int s = t & (SEQ - 1); const int j = j8 * 8;
        const int ucol = 256 * (j / 128) + (j % 128);
        float cg[8], cv[8];
#pragma unroll
        for (int i = 0; i < 8; ++i) { cg[i] = cb[j + i]; cv[i] = cb[FF + j + i]; }
#pragma unroll
        for (int jj = 0; jj < 3; ++jj) { const int ds = 2 - jj;
            if (s - ds >= 0) { const bf16* up = u + (size_t)(rl - ds) * NUP + ucol; float ug[8], uv[8]; ld8(up, ug); ld8(up + 128, uv);
#pragma unroll
                for (int i = 0; i < 8; ++i) { cg[i] += cw[jj * NUP + j + i] * ug[i]; cv[i] += cw[jj * NUP + FF + j + i] * uv[i]; } } }
        float r[8];
#pragma unroll
        for (int i = 0; i < 8; ++i) r[i] = 0.5f * cg[i] * (1.f + erff(cg[i] * 0.70710678118654752f)) * cv[i];
        v4u w; w.x = pk2(r[0], r[1]); w.y = pk2(r[2], r[3]); w.z = pk2(r[4], r[5]); w.w = pk2(r[6], r[7]);
        *(v4u*)(gated + (size_t)t * FF + j) = w;
    }
}


namespace cg = cooperative_groups;
#define GEMM_PHASE(A_, B_, M_, N_, K_, O_, LDC_) do { pg8::Gemm g{(const bf16*)(A_), (const bf16*)(B_), M_, N_, K_}; pg8::StaticOrder S; S.init(M_, N_, (int)gridDim.x, (int)blockIdx.x); \
    pg8::EpiBf16<0> E{(bf16*)(O_), LDC_, nullptr, 0, 0, 1.f}; pg8::gemm_phase<pg8::EpiBf16<0>, pg8::StaticOrder, PG8_ALIGN, PG8_SP2>(lds, g, S, E); } while (0)
__global__ void __launch_bounds__(NTHR, 2) fwd(Args a) {
    extern __shared__ __attribute__((aligned(16))) unsigned char lds_raw[];
    LAS unsigned char* lds = (LAS unsigned char*)lds_raw;
    cg::grid_group grid = cg::this_grid();
    unsigned char* ws = a.ws;
    prologue(a, lds); grid.sync();
    const float* xin = a.in[0]; float* out = a.out;
#define WSP(T, off) ((T*)(ws + (off)))
#define PARP(off) (WSP(const float, WS_PAR) + (off))
    GEMM_PHASE(WSP(bf16, WS_XN), ws + WS_WIN, TOK, NQKVA, DM, WSP(bf16, WS_BIG), NQKVA); grid.sync();
    dilated_naive(WSP(const bf16, WS_BIG), WSP(const float, WS_TABA), WSP(bf16, 416 * MiB)); grid.sync();
    GEMM_PHASE(WSP(bf16, 416 * MiB), ws + WS_WOA, TOK, DM, AW, WSP(bf16, 448 * MiB), DM); grid.sync();
    rowpass(WSP(const bf16, 448 * MiB), PARP(PAR_NORMG + 1 * DM), xin, out, WSP(bf16, WS_XN)); grid.sync();
#pragma unroll 1
    for (int lay = 0; lay < 2; ++lay) {
        if (lay == 1) {
            GEMM_PHASE(WSP(bf16, WS_XN), ws + WS_WKVQ, TOK, NKVQ, DM, WSP(bf16, WS_BIG), NKVQ); grid.sync();
            diff_attn_phase(WSP(const bf16, WS_BIG), WSP(const float, WS_TABB), PARP(0), WSP(bf16, 320 * MiB), lds); grid.sync();
            GEMM_PHASE(WSP(bf16, 320 * MiB), ws + WS_WOB, TOK, DM, DM, WSP(bf16, 448 * MiB), DM); grid.sync();
            rowpass(WSP(const bf16, 448 * MiB), PARP(PAR_NORMG + 5 * DM), out, out, WSP(bf16, WS_XN)); grid.sync();
        }
#pragma unroll 1
        for (int half = 0; half < 2; ++half) {
            GEMM_PHASE(WSP(bf16, WS_XN) + (size_t)half * (TOK / 2) * DM, ws + (lay ? WS_WUP1 : WS_WUP0), TOK / 2, NUP, DM, WSP(bf16, WS_BIG), NUP); grid.sync();
            conv_naive(WSP(const bf16, WS_BIG), half, PARP(PAR_CONVW + lay * 3 * NUP), PARP(PAR_CONVB + lay * NUP), WSP(bf16, 304 * MiB)); grid.sync();
        }
        GEMM_PHASE(WSP(bf16, 304 * MiB), ws + (lay ? WS_WDN1 : WS_WDN0), TOK, DM, FF, WSP(bf16, WS_BIG), DM); grid.sync();
        rowpass(WSP(const bf16, WS_BIG), PARP(PAR_NORMG + (lay * 4 + 3) * DM), out, out, lay == 0 ? WSP(bf16, WS_XN) : (bf16*)nullptr);
        if (lay == 0) grid.sync();
    }
}

extern "C" void kernel_launch(void* const* d_in, const int* in_sizes, int n_in, void* d_out, int out_size, void* d_ws, size_t ws_size, hipStream_t stream) {
    static int grid = 0;
    if (grid == 0) {
        if (n_in != 19 || in_sizes[0] != TOK * DM || out_size != TOK * DM || ws_size < WS_END) {
            fprintf(stderr, "kernel_launch: unexpected shapes: n_in %d in0 %d out %d ws %zu (need %zu)\n", n_in, n_in > 0 ? in_sizes[0] : -1, out_size, ws_size, (size_t)WS_END); grid = -1; return; }
        int dev = 0, cus = 0, per_cu = 0;
        if (hipGetDevice(&dev) != hipSuccess || hipDeviceGetAttribute(&cus, hipDeviceAttributeMultiprocessorCount, dev) != hipSuccess) { grid = -1; return; }
        if (hipFuncSetAttribute((const void*)fwd, hipFuncAttributeMaxDynamicSharedMemorySize, LDS_BYTES) != hipSuccess) { fprintf(stderr, "kernel_launch: hipFuncSetAttribute failed\n"); grid = -1; return; }
        if (hipOccupancyMaxActiveBlocksPerMultiprocessor(&per_cu, (const void*)fwd, NTHR, LDS_BYTES) != hipSuccess || per_cu < 1) { fprintf(stderr, "kernel_launch: occupancy query says %d blocks/CU\n", per_cu); grid = -1; return; }
        grid = cus;
    }
    if (grid < 0) return;
    Args a{};
    for (int i = 0; i < 19; ++i) a.in[i] = (const float*)d_in[i];
    a.out = (float*)d_out; a.ws = (unsigned char*)d_ws;
    void* args[] = {&a};
    hipError_t e = hipLaunchCooperativeKernel((const void*)fwd, dim3(grid), dim3(NTHR), args, LDS_BYTES, stream);
    if (e != hipSuccess) fprintf(stderr, "cooperative launch failed: %s (grid %d)\n", hipGetErrorString(e), grid);
}
```

```cpp
#include <hip/hip_runtime.h>
#include <hip/hip_cooperative_groups.h>
#include <cstdio>
#include <cstdint>
namespace pg8 {
#define PG8_LAS __attribute__((address_space(3)))
typedef unsigned short bf16_t;
typedef short bf16x8 __attribute__((ext_vector_type(8)));
typedef float f32x4 __attribute__((ext_vector_type(4)));
typedef unsigned u32x4 __attribute__((ext_vector_type(4)));
constexpr int BM = 256, BK = 64, HALF = 128, HTB = HALF * BK * 2  , STAGE_BYTES = 8 * HTB, NXCD = 8, WGM = 8;

__host__ __device__ __forceinline__ int lds_byte(int r, int c) { const int st = (r >> 4) * 2 + (c >> 5), rr = r & 15, cc = c & 31, ob = rr * 64 + cc * 2; return st * 1024 + (ob ^ (((ob >> 9) & 1) << 5)); }
__host__ __device__ __forceinline__ void stage_rc(int b, int& R, int& C) { const int st = b / 1024, sb = b % 1024, swz = sb ^ (((sb >> 9) & 1) << 5); R = (st >> 1) * 16 + swz / 64; C = (st & 1) * 32 + (swz % 64) / 2; }
__host__ __device__ __forceinline__ int perm32(int rho) { const int n = rho >> 4, i = rho & 15; return 8 * (i >> 2) + 4 * n + (i & 3); }

struct Unit { int pm, pn; };
struct Gemm { const bf16_t* A; const bf16_t* Bt; int M, N, K; };

struct StaticOrder {
    int nM, nN, nwg, G, c;
    __host__ __device__ void init(int M, int N, int G_, int c_) { nM = M / BM; nN = N / BM; nwg = nM * nN; G = G_; c = c_; }
    __host__ __device__ bool next(int i, Unit& u) const {
        const long L = (long)i * G + c; if (L >= nwg) return false;
        int wgid = (int)L; { const int q = nwg / NXCD, r = nwg % NXCD, xcd = wgid % NXCD, off = wgid / NXCD; wgid = (xcd < r ? xcd * (q + 1) : r * (q + 1) + (xcd - r) * q) + off; }
        const int nig = WGM * nN, gid = wgid / nig, fm = gid * WGM, gsz = (nM - fm) < WGM ? (nM - fm) : WGM;
        u.pm = fm + ((wgid % nig) % gsz); u.pn = (wgid % nig) / gsz; return true;
    }
    __device__ __forceinline__ void a_ready(const Unit&) const {}
    __device__ __forceinline__ void done(const Unit&) const {}
};

__device__ __forceinline__ unsigned cvt_pk_bf16(float lo, float hi) { unsigned r; asm volatile("v_cvt_pk_bf16_f32 %0, %1, %2" : "=v"(r) : "v"(lo), "v"(hi)); return r; }
typedef float f32x2 __attribute__((ext_vector_type(2)));
__device__ __forceinline__ f32x2 gelu_pk(f32x2 v) {
    const f32x2 av = __builtin_elementwise_abs(v), d = av * 0.2316418882f + 1.0f;
    f32x2 t; t.x = __builtin_amdgcn_rcpf(d.x); t.y = __builtin_amdgcn_rcpf(d.y);
    f32x2 q = t * 0.5307027145f + (-0.7265760135f); q = q * t + 0.7107068705f; q = q * t + (-0.142248368f); q = q * t + 0.127414796f; q = q * t;
    const f32x2 s = (v * v) * (-0.72134752044f);
    f32x2 e; e.x = __builtin_amdgcn_exp2f(s.x); e.y = __builtin_amdgcn_exp2f(s.y);
    const f32x2 m = v * (q * e), r = v - m;
    f32x2 o; o.x = v.x < 0.f ? m.x : r.x; o.y = v.y < 0.f ? m.y : r.y; return o;
}

template <int ACT  > struct EpiBf16 {
    static constexpr bool PERM = true, AFTER_DRAIN = false; static_assert(ACT == 0 || ACT == 1, "EpiBf16: ACT is 0 (none) or 1 (gelu_pk)");
    bf16_t* O; int ldc; const float* bias; int split_cols; size_t split_stride; float scale0;
    __device__ __forceinline__ void operator()(const f32x4 (&acc)[2][2][4][2], const Unit& u, int wr, int wc, int fr, int fq) const {
        const int row0 = u.pm * BM + wr * 64 + fr; int colt = u.pn * BM; bf16_t* base = O;
        float sc = 1.f; if (split_cols) { const int t = colt / split_cols; base += (size_t)t * split_stride; colt -= t * split_cols; if (t == 0) sc = scale0; }
        const int col0 = colt + wc * 32 + 8 * fq, bcol0 = u.pn * BM + wc * 32 + 8 * fq;
        f32x4 bv[2][2];
#pragma unroll
        for (int bj = 0; bj < 2; ++bj)
#pragma unroll
            for (int n = 0; n < 2; ++n) bv[bj][n] = bias ? *(const f32x4*)(bias + bcol0 + bj * HALF + 4 * n) : (f32x4){0.f, 0.f, 0.f, 0.f};
#pragma unroll
        for (int ai = 0; ai < 2; ++ai)
#pragma unroll
            for (int m = 0; m < 4; ++m) { bf16_t* rowp = base + (size_t)(row0 + ai * HALF + m * 16) * ldc + col0;
#pragma unroll
                for (int bj = 0; bj < 2; ++bj) { f32x4 v0 = acc[ai][bj][m][0] + bv[bj][0], v1 = acc[ai][bj][m][1] + bv[bj][1];
                    if (ACT == 1) { f32x2 a = gelu_pk((f32x2){v0[0], v0[1]}), b = gelu_pk((f32x2){v0[2], v0[3]}), c = gelu_pk((f32x2){v1[0], v1[1]}), d = gelu_pk((f32x2){v1[2], v1[3]});
                        v0 = (f32x4){a.x, a.y, b.x, b.y}; v1 = (f32x4){c.x, c.y, d.x, d.y}; }
                    v0 = v0 * sc; v1 = v1 * sc; u32x4 w; w.x = cvt_pk_bf16(v0[0], v0[1]); w.y = cvt_pk_bf16(v0[2], v0[3]); w.z = cvt_pk_bf16(v1[0], v1[1]); w.w = cvt_pk_bf16(v1[2], v1[3]);
                    *(u32x4*)(rowp + bj * HALF) = w; } }
    }
};
template <class Epi, class Sched, bool ALIGN_EPI = false, bool SP2 = false>
__device__ __forceinline__ void gemm_phase(PG8_LAS unsigned char* lds, const Gemm g, const Sched& S, const Epi& E) {
    int tid_l = threadIdx.x; asm volatile("" : "+v"(tid_l));
    const int tid = tid_l, wid = __builtin_amdgcn_readfirstlane(tid >> 6), lane = tid & 63, wr = wid >> 2, wc = wid & 3, fr = lane & 15, fq = lane >> 4;
    const int K = g.K, nt = K / BK;
    unsigned voffA[2], voffB[2];
#pragma unroll
    for (int i = 0; i < 2; ++i) { int R, C; stage_rc(tid * 16 + i * 8192, R, C); const int Rb = Epi::PERM ? ((R & ~31) + perm32(R & 31)) : R;
        voffA[i] = (unsigned)(R * K + C) * 2u; voffB[i] = (unsigned)(Rb * K + C) * 2u; }
    const size_t kstep = (size_t)(BK * 2);
    const size_t hstep = (size_t)HALF * K * 2;
    const size_t tstep = 2 * hstep;
    const unsigned ldsw = (unsigned)wid * 1024u;
    const int aoff = lds_byte(wr * 64 + fr, fq * 8), boff = lds_byte(wc * 32 + fr, fq * 8);
#define PG8_SA(b, h) (((b) * 2 + (h)) * HTB)
#define PG8_SB(b, h) ((4 + (b) * 2 + (h)) * HTB)
#define PG8_STAGE(bufoff, gbase, voff) do { _Pragma("unroll") for (int _i = 0; _i < 2; ++_i) \
        __builtin_amdgcn_global_load_lds((const unsigned*)((const char*)(gbase) + (voff)[_i]), (PG8_LAS unsigned*)(lds + (bufoff) + ldsw + _i * 8192), 16, 0, 0); } while (0)
#define PG8_LDA(dst, b, h) do { _Pragma("unroll") for (int m = 0; m < 4; ++m) _Pragma("unroll") for (int k = 0; k < 2; ++k) dst[m][k] = *(const PG8_LAS bf16x8*)(lds + PG8_SA(b, h) + aoff + m * 2048 + k * 1024); } while (0)
#define PG8_LDB(dst, b, h) do { _Pragma("unroll") for (int n = 0; n < 2; ++n) _Pragma("unroll") for (int k = 0; k < 2; ++k) dst[n][k] = *(const PG8_LAS bf16x8*)(lds + PG8_SB(b, h) + boff + n * 2048 + k * 1024); } while (0)
#define PG8_MMA(ai, bj, At, Bt) do { __builtin_amdgcn_s_setprio(1); _Pragma("unroll") for (int m = 0; m < 4; ++m) _Pragma("unroll") for (int n = 0; n < 2; ++n) _Pragma("unroll") for (int k = 0; k < 2; ++k) \
        acc[ai][bj][m][n] = __builtin_amdgcn_mfma_f32_16x16x32_bf16(Bt[n][k], At[m][k], acc[ai][bj][m][n], 0, 0, 0); __builtin_amdgcn_s_setprio(0); } while (0)
#define PG8_WAIT_V(n) asm volatile("s_waitcnt vmcnt(" #n ")" ::: "memory")
#define PG8_WAIT_L(n) asm volatile("s_waitcnt lgkmcnt(" #n ")" ::: "memory")
#define PG8_BAR __builtin_amdgcn_s_barrier()
#define PG8_SCHED __builtin_amdgcn_sched_barrier(0)
    Unit cur, nxt; int ui = 0;
    if (!S.next(0, cur)) return;
    f32x4 acc[2][2][4][2];
#pragma unroll
    for (int a = 0; a < 2; ++a)
#pragma unroll
        for (int b = 0; b < 2; ++b)
#pragma unroll
            for (int m = 0; m < 4; ++m)
#pragma unroll
                for (int n = 0; n < 2; ++n) acc[a][b][m][n] = (f32x4){0.f, 0.f, 0.f, 0.f};
    bf16x8 At[4][2], B0[2][2], B1[2][2];
    const char* cA = (const char*)g.A + (size_t)cur.pm * tstep; const char* cB = (const char*)g.Bt + (size_t)cur.pn * tstep;
    S.a_ready(cur);
    if constexpr (SP2) {
        PG8_STAGE(PG8_SB(0, 0), cB, voffB); PG8_STAGE(PG8_SB(0, 1), cB + hstep, voffB); PG8_STAGE(PG8_SA(0, 0), cA, voffA); PG8_STAGE(PG8_SA(0, 1), cA + hstep, voffA);
        if (wr == 1) PG8_BAR;
        PG8_WAIT_V(2); PG8_BAR;
        PG8_STAGE(PG8_SB(1, 0), cB + kstep, voffB); PG8_STAGE(PG8_SA(1, 0), cA + kstep, voffA); PG8_STAGE(PG8_SB(1, 1), cB + hstep + kstep, voffB);
        PG8_WAIT_V(6); PG8_BAR;
    } else {
        PG8_STAGE(PG8_SB(0, 0), cB, voffB); PG8_STAGE(PG8_SA(0, 0), cA, voffA); PG8_STAGE(PG8_SB(0, 1), cB + hstep, voffB); PG8_STAGE(PG8_SA(0, 1), cA + hstep, voffA);
        if (wr == 1) PG8_BAR;
        PG8_WAIT_V(4); PG8_BAR;
        PG8_STAGE(PG8_SB(1, 0), cB + kstep, voffB); PG8_STAGE(PG8_SA(1, 0), cA + kstep, voffA); PG8_STAGE(PG8_SB(1, 1), cB + hstep + kstep, voffB);
        PG8_WAIT_V(6); PG8_BAR;
    }
    for (;;) {
        const bool has_next = S.next(ui + 1, nxt);
        const char* nA = has_next ? (const char*)g.A + (size_t)nxt.pm * tstep : cA; const char* nB = has_next ? (const char*)g.Bt + (size_t)nxt.pn * tstep : cB;
        for (int t = 0; t < nt; t += 2) {
            const bool last = (t == nt - 2);
            const char* a1 = cA + (size_t)(t + 1) * kstep;
            const char* a2 = last ? nA : cA + (size_t)(t + 2) * kstep; const char* b2 = last ? nB : cB + (size_t)(t + 2) * kstep;
            const char* a3 = a2 + kstep; const char* b3 = b2 + kstep;
            if (last && has_next) S.a_ready(nxt);
            if constexpr (SP2) {
            PG8_LDB(B0, 0, 0); PG8_LDB(B1, 0, 1); PG8_SCHED; PG8_LDA(At, 0, 0); PG8_STAGE(PG8_SA(1, 1), a1 + hstep, voffA);
            PG8_WAIT_V(8); PG8_WAIT_L(0); PG8_BAR; PG8_MMA(0, 0, At, B0); PG8_MMA(0, 1, At, B1); PG8_BAR; PG8_SCHED;
            PG8_LDA(At, 0, 1); PG8_STAGE(PG8_SB(0, 0), b2, voffB); PG8_STAGE(PG8_SB(0, 1), b2 + hstep, voffB); PG8_STAGE(PG8_SA(0, 0), a2, voffA);
            PG8_WAIT_V(8); PG8_WAIT_L(0); PG8_BAR; PG8_MMA(1, 0, At, B0); PG8_MMA(1, 1, At, B1); PG8_BAR; PG8_SCHED;
            PG8_LDB(B0, 1, 0); PG8_LDB(B1, 1, 1); PG8_SCHED; PG8_LDA(At, 1, 0); PG8_STAGE(PG8_SA(0, 1), a2 + hstep, voffA);
            PG8_WAIT_V(8); PG8_WAIT_L(0); PG8_BAR; PG8_MMA(0, 0, At, B0); PG8_MMA(0, 1, At, B1); PG8_BAR; PG8_SCHED;
            PG8_LDA(At, 1, 1); PG8_STAGE(PG8_SB(1, 0), b3, voffB); PG8_STAGE(PG8_SB(1, 1), b3 + hstep, voffB); PG8_STAGE(PG8_SA(1, 0), a3, voffA);
            PG8_WAIT_V(8); PG8_WAIT_L(0); PG8_BAR; PG8_MMA(1, 0, At, B0); PG8_MMA(1, 1, At, B1); PG8_BAR; PG8_SCHED;
            } else {
            PG8_LDB(B0, 0, 0); PG8_SCHED; PG8_LDA(At, 0, 0); PG8_STAGE(PG8_SA(1, 1), a1 + hstep, voffA);
            PG8_WAIT_L(8); PG8_BAR; PG8_WAIT_L(0); PG8_MMA(0, 0, At, B0); PG8_BAR; PG8_SCHED;
            PG8_LDB(B1, 0, 1); PG8_STAGE(PG8_SB(0, 0), b2, voffB);
            PG8_BAR; PG8_WAIT_L(0); PG8_MMA(0, 1, At, B1); PG8_BAR;
            PG8_LDA(At, 0, 1); PG8_STAGE(PG8_SA(0, 0), a2, voffA);
            PG8_BAR; PG8_WAIT_L(0); PG8_MMA(1, 0, At, B0); PG8_BAR; PG8_SCHED;
            PG8_STAGE(PG8_SB(0, 1), b2 + hstep, voffB);
            PG8_WAIT_V(6); PG8_BAR; PG8_MMA(1, 1, At, B1); PG8_BAR;
            PG8_LDB(B0, 1, 0); PG8_SCHED; PG8_LDA(At, 1, 0); PG8_STAGE(PG8_SA(0, 1), a2 + hstep, voffA);
            PG8_WAIT_L(8); PG8_BAR; PG8_WAIT_L(0); PG8_MMA(0, 0, At, B0); PG8_BAR; PG8_SCHED;
            PG8_LDB(B1, 1, 1); PG8_STAGE(PG8_SB(1, 0), b3, voffB);
            PG8_BAR; PG8_WAIT_L(0); PG8_MMA(0, 1, At, B1); PG8_BAR;
            PG8_LDA(At, 1, 1); PG8_STAGE(PG8_SA(1, 0), a3, voffA);
            PG8_BAR; PG8_WAIT_L(0); PG8_MMA(1, 0, At, B0); PG8_BAR; PG8_SCHED;
            PG8_STAGE(PG8_SB(1, 1), b3 + hstep, voffB);
            PG8_WAIT_V(6); PG8_BAR; PG8_MMA(1, 1, At, B1); PG8_BAR;
            }
        }
        if constexpr (ALIGN_EPI) { if (wr == 0) PG8_BAR; }
        if constexpr (!Epi::AFTER_DRAIN) { E(acc, cur, wr, wc, fr, fq); S.done(cur); }
        if (!has_next) break;
#pragma unroll
        for (int a = 0; a < 2; ++a)
#pragma unroll
            for (int b = 0; b < 2; ++b)
#pragma unroll
                for (int m = 0; m < 4; ++m)
#pragma unroll
                    for (int n = 0; n < 2; ++n) acc[a][b][m][n] = (f32x4){0.f, 0.f, 0.f, 0.f};
        cur = nxt; cA = nA; cB = nB; ++ui;
        if constexpr (ALIGN_EPI) { if (wr == 1) PG8_BAR; }
    }
    PG8_WAIT_V(0);
    if constexpr (!ALIGN_EPI) { if (wr == 0) PG8_BAR; }
    PG8_BAR;
    if constexpr (Epi::AFTER_DRAIN) { E.fused(acc, cur, wr, wc, fr, fq, lds, wid, lane); S.done(cur); }
#undef PG8_SA
#undef PG8_SB
#undef PG8_STAGE
#undef PG8_LDA
#undef PG8_LDB
#undef PG8_MMA
#undef PG8_WAIT_V
#undef PG8_WAIT_L
#undef PG8_BAR
#undef PG8_SCHED
}
}

#ifndef PG8_SP2
#define PG8_SP2 true
#endif
#ifndef PG8_ALIGN
#define PG8_ALIGN true
#endif

constexpr int NWAVES = 8, NTHR = 512;
constexpr int BATCH = 8, SEQ = 4096, DM = 1024, TOK = BATCH * SEQ;
constexpr int NQKVA = 4608, AW = 512, NKVQ = 3072, FF = 2816, NUP = 5632;
constexpr float LOG2E = 1.4426950408889634f;
constexpr float C2 = 0.125f * LOG2E;
constexpr float RMS_EPS = 1e-6f, SUBLN_EPS = 1e-5f;
constexpr float LAMBDA_INIT = 0.8f - 0.6f * 0.7408182206817179f;

constexpr size_t MiB = 1u << 20;
constexpr size_t WS_WIN = 1 * MiB, WS_WOA = 10 * MiB, WS_WKVQ = 11 * MiB, WS_WOB = 17 * MiB, WS_WUP0 = 19 * MiB, WS_WUP1 = 30 * MiB;
constexpr size_t WS_WDN0 = 41 * MiB, WS_WDN1 = WS_WDN0 + (size_t)DM * FF * 2;
constexpr size_t WS_TABB = 63 * MiB, WS_TABA = WS_TABB + 256 * 1024;
constexpr size_t WS_PAR = 62 * MiB;
constexpr int PAR_NORMG = 0, PAR_CONVW = 8 * 1024, PAR_CONVB = PAR_CONVW + 6 * 5632, PAR_LAM = PAR_CONVB + 2 * 5632, PAR_SUBG = PAR_LAM + 256, PAR_END = PAR_SUBG + 128;
constexpr size_t WS_XN = 64 * MiB;
constexpr size_t WS_BIG = 128 * MiB;
constexpr size_t WS_END = 512 * MiB;
constexpr int TABB_STRIDE = 64 + SEQ;

constexpr int LDS_BYTES = 147456;

#define GAS __attribute__((address_space(1)))
#define LAS __attribute__((address_space(3)))
typedef unsigned short bf16;
typedef unsigned v4u __attribute__((ext_vector_type(4)));
typedef unsigned v2u __attribute__((ext_vector_type(2)));
typedef float f32x4 __attribute__((ext_vector_type(4)));
#define LDS_WAIT() asm volatile("s_waitcnt lgkmcnt(0)" ::: "memory")
#define LAUNDER_V(x) asm volatile("" : "+v"(x))
#define LAUNDER_S(x) asm volatile("" : "+s"(x))
__device__ __forceinline__ unsigned f2bf(float f) { unsigned u = __builtin_bit_cast(unsigned, f); return (u + 0x7fffu + ((u >> 16) & 1u)) >> 16; }
__device__ __forceinline__ unsigned pk2(float lo, float hi) { return f2bf(lo) | (f2bf(hi) << 16); }
__device__ __forceinline__ float bflo(unsigned w) { return __uint_as_float(w << 16); }
__device__ __forceinline__ float bfhi(unsigned w) { return __uint_as_float(w & 0xffff0000u); }
__device__ __forceinline__ float wave_sum(float v) {
#pragma unroll
    for (int o = 1; o < 64; o <<= 1) v += __shfl_xor(v, o);
    return v;
}
__device__ __forceinline__ int t5_bucket(int n) {
    if (n < 16) return n;
    return 16 + (n >= 22) + (n >= 30) + (n >= 40) + (n >= 54) + (n >= 73) + (n >= 99) + (n >= 134) + (n >= 182) + (n >= 246) + (n >= 332) + (n >= 450) + (n >= 609) + (n >= 825) + (n >= 1117) + (n >= 1513);
}

#define PHASE_IDS \
    int tid_ = threadIdx.x; LAUNDER_V(tid_); const int lane = tid_ & 63, wave = __builtin_amdgcn_readfirstlane(tid_ >> 6); \
    const int G_ = gridDim.x, bx_ = blockIdx.x; const int vcu_ = (G_ % 8 == 0) ? (bx_ % 8) * (G_ / 8) + bx_ / 8 : bx_; \
    const int gw = vcu_ * NWAVES + wave, ngw = G_ * NWAVES, gtid = bx_ * NTHR + tid_, gstride = G_ * NTHR; \
    (void)lane; (void)wave; (void)gw; (void)ngw; (void)gtid; (void)gstride;

struct Args {
    const float* in[19]; float* out; unsigned char* ws; int ph_lo, ph_hi;
};

__device__ __forceinline__ void tr_item(const float* W, int K, int N, bf16* WT, int k0, int n0, int drow0, const float* gk, float cs, LAS float* scr, int lane) {
#pragma unroll 8
    for (int i = 0; i < 32; ++i) { const int kk = 2 * i + (lane >> 5); const float g = gk ? gk[k0 + kk] : 1.f;
        scr[kk * 33 + (lane & 31)] = W[(size_t)(k0 + kk) * N + n0 + (lane & 31)] * (g * cs); }
    LDS_WAIT(); asm volatile("" ::: "memory");
    const int c = lane & 7;
#pragma unroll
    for (int j = 0; j < 4; ++j) { const int n = (lane >> 3) + 8 * j; const LAS float* s = scr + (8 * c) * 33 + n;
        v4u o; o.x = pk2(s[0 * 33], s[1 * 33]); o.y = pk2(s[2 * 33], s[3 * 33]); o.z = pk2(s[4 * 33], s[5 * 33]); o.w = pk2(s[6 * 33], s[7 * 33]);
        *(v4u*)(WT + (size_t)(drow0 + n) * K + k0 + 8 * c) = o; }
    LDS_WAIT(); asm volatile("" ::: "memory");
}
__device__ __forceinline__ void tr_mat(int r, const float* W, int K, int N, bf16* WT, int rowoff, const float* gk, int kind, LAS float* scr, int lane) {
    const int nblk = N / 32, kb = r / nblk, nb = r % nblk, n0 = nb * 32; int dr = n0; float cs = 1.f;
    if (kind == 1) cs = ((n0 % 1536) < 512) ? C2 : 1.f;
    if (kind == 2) cs = C2;
    if (kind == 3) dr = (n0 < FF) ? 256 * (n0 / 128) + (n0 % 128) : 256 * ((n0 - FF) / 128) + 128 + ((n0 - FF) % 128);
    tr_item(W, K, N, WT, kb * 64, n0, dr + rowoff, gk, cs, scr, lane);
}

__device__ __forceinline__ void prologue(const Args& a, LAS unsigned char* lds) {
    PHASE_IDS
    LAS float* scr = (LAS float*)(lds + wave * 16384);
    unsigned char* ws = a.ws;
    const float* norm_g = a.in[2];
    constexpr int I_WIN = 16 * 144, I_WOA = 8 * 32, I_SQ = 16 * 32, I_UP = 16 * 176, I_DN = 44 * 32;
    constexpr int NITEMS = I_WIN + I_WOA + 4 * I_SQ + 2 * I_UP + 2 * I_DN;
    for (int it = gw; it < NITEMS; it += ngw) {
        int r = it;
        if (r < I_WIN) { tr_mat(r, a.in[3], DM, NQKVA, (bf16*)(ws + WS_WIN), 0, norm_g + 0 * DM, 1, scr, lane); continue; } r -= I_WIN;
        if (r < I_WOA) { tr_mat(r, a.in[4], AW, DM, (bf16*)(ws + WS_WOA), 0, nullptr, 0, scr, lane); continue; } r -= I_WOA;
        if (r < I_SQ) { tr_mat(r, a.in[6], DM, DM, (bf16*)(ws + WS_WKVQ), 0, a.in[5], 0, scr, lane); continue; } r -= I_SQ;
        if (r < I_SQ) { tr_mat(r, a.in[7], DM, DM, (bf16*)(ws + WS_WKVQ), 1024, a.in[5], 0, scr, lane); continue; } r -= I_SQ;
        if (r < I_SQ) { tr_mat(r, a.in[8], DM, DM, (bf16*)(ws + WS_WKVQ), 2048, norm_g + 4 * DM, 2, scr, lane); continue; } r -= I_SQ;
        if (r < I_SQ) { tr_mat(r, a.in[14], DM, DM, (bf16*)(ws + WS_WOB), 0, nullptr, 0, scr, lane); continue; } r -= I_SQ;
        if (r < I_UP) { tr_mat(r, a.in[15], DM, NUP, (bf16*)(ws + WS_WUP0), 0, norm_g + 2 * DM, 3, scr, lane); continue; } r -= I_UP;
        if (r < I_UP) { tr_mat(r, a.in[15] + (size_t)DM * NUP, DM, NUP, (bf16*)(ws + WS_WUP1), 0, norm_g + 6 * DM, 3, scr, lane); continue; } r -= I_UP;
        if (r < I_DN) { tr_mat(r, a.in[18], FF, DM, (bf16*)(ws + WS_WDN0), 0, nullptr, 0, scr, lane); continue; } r -= I_DN;
        tr_mat(r, a.in[18] + (size_t)FF * DM, FF, DM, (bf16*)(ws + WS_WDN1), 0, nullptr, 0, scr, lane);
    }
    { float* par = (float*)(ws + WS_PAR); const int gt0 = gw * 64 + lane, ngt0 = ngw * 64;
      for (int i = gt0; i < PAR_END; i += ngt0) { float v;
        if (i < PAR_CONVW) v = a.in[2][i]; else if (i < PAR_CONVB) v = a.in[16][i - PAR_CONVW]; else if (i < PAR_LAM) v = a.in[17][i - PAR_CONVB];
        else if (i < PAR_SUBG) { const int k = i - PAR_LAM; v = a.in[9 + (k >> 6)][k & 63]; } else v = a.in[13][i - PAR_SUBG];
        par[i] = v; } }
    const float* table = a.in[1];
    float* tabB = (float*)(ws + WS_TABB); float* tabA = (float*)(ws + WS_TABA);
    const int gt = gw * 64 + lane, ngt = ngw * 64;
    for (int i = gt; i < 8 * TABB_STRIDE; i += ngt) { const int h = i / TABB_STRIDE, d = i % TABB_STRIDE - 64; tabB[i] = d < 0 ? 0.f : table[h * 32 + t5_bucket(d)] * LOG2E; }
    for (int i = gt; i < 3 * 8 * 132; i += ngt) { const int g = i / (8 * 132), h = (i / 132) % 8, du = i % 132; const int r = 1 << (2 * g);
        tabA[i] = du <= 128 ? table[h * 32 + t5_bucket(du * r)] * LOG2E : 0.f; }
    const float* x = a.in[0]; bf16* XN = (bf16*)(ws + WS_XN);
    for (int m = gw; m < TOK; m += ngw) {
        const f32x4* xr = (const f32x4*)(x + (size_t)m * DM) + lane; f32x4 v[4]; float s = 0.f;
#pragma unroll
        for (int j = 0; j < 4; ++j) { v[j] = xr[64 * j]; s += (v[j].x * v[j].x + v[j].y * v[j].y) + (v[j].z * v[j].z + v[j].w * v[j].w); }
        const float rs = 1.f / sqrtf(wave_sum(s) * (1.f / DM) + RMS_EPS);
        v2u* o8 = (v2u*)(XN + (size_t)m * DM) + lane;
#pragma unroll
        for (int j = 0; j < 4; ++j) { v2u w; w.x = pk2(v[j].x * rs, v[j].y * rs); w.y = pk2(v[j].z * rs, v[j].w * rs); o8[64 * j] = w; }
    }
}

__device__ __forceinline__ void rowpass(const bf16* mix, const float* g, const float* hin, float* hout, bf16* xn) {
    PHASE_IDS
    for (int m = gw; m < TOK; m += ngw) {
        const v2u* mr = (const v2u*)(mix + (size_t)m * DM) + lane; f32x4 v[4]; float s = 0.f;
#pragma unroll
        for (int j = 0; j < 4; ++j) { const v2u w = mr[64 * j]; v[j] = (f32x4){bflo(w.x), bfhi(w.x), bflo(w.y), bfhi(w.y)};
            s += (v[j].x * v[j].x + v[j].y * v[j].y) + (v[j].z * v[j].z + v[j].w * v[j].w); }
        const float rs = 1.f / sqrtf(wave_sum(s) * (1.f / DM) + RMS_EPS);
        const f32x4* gr = (const f32x4*)g + lane; const f32x4* hr = (const f32x4*)(hin + (size_t)m * DM) + lane; f32x4* ho = (f32x4*)(hout + (size_t)m * DM) + lane;
        float s2 = 0.f;
#pragma unroll
        for (int j = 0; j < 4; ++j) { const f32x4 gv = gr[64 * j], hv = hr[64 * j]; v[j] = hv + v[j] * rs * gv; ho[64 * j] = v[j];
            s2 += (v[j].x * v[j].x + v[j].y * v[j].y) + (v[j].z * v[j].z + v[j].w * v[j].w); }
        if (xn) {
            const float rs2 = 1.f / sqrtf(wave_sum(s2) * (1.f / DM) + RMS_EPS);
            v2u* o8 = (v2u*)(xn + (size_t)m * DM) + lane;
#pragma unroll
            for (int j = 0; j < 4; ++j) { v2u w; w.x = pk2(v[j].x * rs2, v[j].y * rs2); w.y = pk2(v[j].z * rs2, v[j].w * rs2); o8[64 * j] = w; }
        }
    }
}

__device__ __forceinline__ void ld8(const bf16* p, float* f) { const v4u w = *(const v4u*)p; f[0] = bflo(w.x); f[1] = bfhi(w.x); f[2] = bflo(w.y); f[3] = bfhi(w.y); f[4] = bflo(w.z); f[5] = bfhi(w.z); f[6] = bflo(w.w); f[7] = bfhi(w.w); }

__device__ __forceinline__ void dilated_naive(const bf16* qkv, const float* tabA, bf16* Oa) {
    PHASE_IDS
    for (int idx = gtid; idx < TOK * 8; idx += gstride) {
        const int h = idx & 7, t = idx >> 3, s = t & (SEQ - 1);
        float m = -INFINITY, l = 0.f; float o[64];
#pragma unroll
        for (int d = 0; d < 64; ++d) o[d] = 0.f;
        for (int g = 0; g < 3; ++g) {
            const int r = 1 << (2 * g); const int mu = s >> (2 * g); const int jmax = mu < 128 ? mu : 128;
            const bf16* qp = qkv + (size_t)t * NQKVA + g * 1536 + h * 64; float q[64];
#pragma unroll
            for (int c = 0; c < 8; ++c) ld8(qp + 8 * c, q + 8 * c);
            const float* tb = tabA + (g * 8 + h) * 132;
#pragma unroll 1
            for (int j = 0; j <= jmax; ++j) {
                const bf16* kp = qkv + (size_t)(t - j * r) * NQKVA + g * 1536 + 512 + h * 64; const bf16* vp = kp + 512;
                float dot = 0.f;
#pragma unroll
                for (int c = 0; c < 8; ++c) { float kf[8]; ld8(kp + 8 * c, kf);
#pragma unroll
                    for (int e = 0; e < 8; ++e) dot += q[8 * c + e] * kf[e]; }
                const float tt = dot + tb[j]; const float mn = fmaxf(m, tt); const float al = exp2f(m - mn), p = exp2f(tt - mn);
                l = l * al + p; m = mn;
#pragma unroll
                for (int c = 0; c < 8; ++c) { float vf[8]; ld8(vp + 8 * c, vf);
#pragma unroll
                    for (int e = 0; e < 8; ++e) o[8 * c + e] = o[8 * c + e] * al + p * vf[e]; }
            }
        }
        const float il = 1.f / l; bf16* op = Oa + (size_t)t * AW + h * 64;
#pragma unroll
        for (int c = 0; c < 8; ++c) { v4u w; w.x = pk2(o[8 * c] * il, o[8 * c + 1] * il); w.y = pk2(o[8 * c + 2] * il, o[8 * c + 3] * il); w.z = pk2(o[8 * c + 4] * il, o[8 * c + 5] * il); w.w = pk2(o[8 * c + 6] * il, o[8 * c + 7] * il);
            *(v4u*)(op + 8 * c) = w; }
    }
}

__device__ __forceinline__ void diff_naive(const bf16* kvq, const float* tabB, const float* par, bf16* Ob) {
    PHASE_IDS
    float lam;
    { const float* lp = par + PAR_LAM; const float p1 = lp[lane] * lp[64 + lane], p2 = lp[128 + lane] * lp[192 + lane]; lam = expf(wave_sum(p1)) - expf(wave_sum(p2)) + LAMBDA_INIT; }
    const float* subg = par + PAR_SUBG;
#pragma unroll 1
    for (int w = gw; w < 8 * 8 * 512; w += ngw) {
        const int qg = 511 - (w >> 6), h = w & 7, b = (w >> 3) & 7;
        const int ql = lane >> 3, c = (lane >> 2) & 1, eq = lane & 3; const int q = qg * 8 + ql;
        const size_t row = (size_t)b * SEQ + q;
        v4u qw[8]; { const bf16* qp = kvq + row * NKVQ + 2048 + h * 128 + c * 64;
#pragma unroll
            for (int cc = 0; cc < 8; ++cc) qw[cc] = *(const v4u*)(qp + 8 * cc); }
        float o[32]; float m = -INFINITY, l = 0.f;
#pragma unroll
        for (int d = 0; d < 32; ++d) o[d] = 0.f;
        const float* tb = tabB + h * TABB_STRIDE + 64;
        const int kmax = qg * 8 + 7;
#pragma unroll 1
        for (int k = 0; k <= kmax; ++k) {
            const bf16* kp = kvq + ((size_t)b * SEQ + k) * NKVQ + h * 128 + c * 64; const bf16* vp = kvq + ((size_t)b * SEQ + k) * NKVQ + 1024 + h * 128 + eq * 32;
            float dot = 0.f;
#pragma unroll
            for (int cc = 0; cc < 8; ++cc) { float kf[8]; ld8(kp + 8 * cc, kf); const v4u qq = qw[cc];
                dot += bflo(qq.x) * kf[0] + bfhi(qq.x) * kf[1] + bflo(qq.y) * kf[2] + bfhi(qq.y) * kf[3] + bflo(qq.z) * kf[4] + bfhi(qq.z) * kf[5] + bflo(qq.w) * kf[6] + bfhi(qq.w) * kf[7]; }
            if (k <= q) {
                const float tt = dot + tb[q - k]; const float mn = fmaxf(m, tt); const float al = exp2f(m - mn), p = exp2f(tt - mn);
                l = l * al + p; m = mn;
#pragma unroll
                for (int cc = 0; cc < 4; ++cc) { float vf[8]; ld8(vp + 8 * cc, vf);
#pragma unroll
                    for (int e = 0; e < 8; ++e) o[8 * cc + e] = o[8 * cc + e] * al + p * vf[e]; }
            }
        }
        const float il = 1.f / l; float ss = 0.f;
#pragma unroll
        for (int d = 0; d < 32; ++d) { const float on = o[d] * il; const float other = __shfl_xor(on, 4); o[d] = on - lam * other; ss += o[d] * o[d]; }
        ss += __shfl_xor(ss, 1); ss += __shfl_xor(ss, 2);
        const float rs = 1.f / sqrtf(ss * (1.f / 128.f) + SUBLN_EPS) * (1.f - LAMBDA_INIT);
        if (c == 0) { bf16* op = Ob + row * DM + h * 128 + eq * 32; const float* sg = subg + eq * 32;
#pragma unroll
            for (int cc = 0; cc < 4; ++cc) { v4u wv; wv.x = pk2(o[8 * cc] * rs * sg[8 * cc], o[8 * cc + 1] * rs * sg[8 * cc + 1]); wv.y = pk2(o[8 * cc + 2] * rs * sg[8 * cc + 2], o[8 * cc + 3] * rs * sg[8 * cc + 3]);
                wv.z = pk2(o[8 * cc + 4] * rs * sg[8 * cc + 4], o[8 * cc + 5] * rs * sg[8 * cc + 5]); wv.w = pk2(o[8 * cc + 6] * rs * sg[8 * cc + 6], o[8 * cc + 7] * rs * sg[8 * cc + 7]);
                *(v4u*)(op + 8 * cc) = wv; } }
    }
}

namespace da {
typedef short bf16x8 __attribute__((ext_vector_type(8)));
typedef short s16x4 __attribute__((ext_vector_type(4)));
typedef short v4i16_t __attribute__((ext_vector_type(4)));
typedef float f32x16 __attribute__((ext_vector_type(16)));
typedef float f32x2_t __attribute__((ext_vector_type(2))); typedef __bf16 bf16x2_t __attribute__((ext_vector_type(2)));
constexpr int KBUF = 0, VBUF = 32768, TABL = 65536, TABL_FLOATS = 128 + SEQ, XCH = 0;
__device__ __forceinline__ unsigned cvtpk(float lo, float hi) { f32x2_t v = {lo, hi}; bf16x2_t b = __builtin_convertvector(v, bf16x2_t); return __builtin_bit_cast(unsigned, b); }
__device__ __forceinline__ s16x4 vtr(const LAS unsigned char* p) { return __builtin_bit_cast(s16x4, __builtin_amdgcn_ds_read_tr16_b64_v4i16((LAS v4i16_t*)p)); }
__device__ __forceinline__ float swapmax(float v) { auto rr = __builtin_amdgcn_permlane32_swap(__float_as_uint(v), __float_as_uint(v), false, false); return fmaxf(__uint_as_float(rr[0]), __uint_as_float(rr[1])); }
__device__ __forceinline__ float swapsum(float v) { auto rr = __builtin_amdgcn_permlane32_swap(__float_as_uint(v), __float_as_uint(v), false, false); return __uint_as_float(rr[0]) + __uint_as_float(rr[1]); }
#define DA_CST0(r) (((r) & 3) + 8 * ((r) >> 2))

__device__ __forceinline__ void diff_unit(int b, int h, int qblk, const bf16* kvq, float lam, const float* subg, bf16* Ob, LAS unsigned char* lds, int wave, int lane) {
    const int r32 = lane & 31, hi = lane >> 5, qt = wave >> 1, c = wave & 1;
    const int q0 = qblk * 128 + qt * 32, NT = 2 * qblk + 2;
    const size_t rowb = (size_t)b * SEQ;
    const LAS float* tabL = (const LAS float*)(lds + TABL);
    bf16x8 qf[4];
    { const bf16* qp = kvq + (rowb + q0 + r32) * NKVQ + 2048 + h * 128 + c * 64 + hi * 8;
#pragma unroll
      for (int d0 = 0; d0 < 4; ++d0) qf[d0] = *(const bf16x8*)(qp + 16 * d0); }
    const bf16* ksrc = kvq + (rowb + lane) * NKVQ + h * 128 + wave * 8;
    const bf16* vsrc = kvq + (rowb + 16 * (wave & 3) + (lane >> 2)) * NKVQ + 1024 + h * 128 + (wave >> 2) * 32 + (lane & 3) * 8;
    const int sdst = wave * 1024 + lane * 16;
    const LAS unsigned char* vb0 = lds + VBUF + ((lane >> 4) & 1) * 32 + (lane & 3) * 8 + (4 * hi + ((lane & 15) >> 2)) * 64;
    f32x16 o[4];
#pragma unroll
    for (int i = 0; i < 4; ++i)
#pragma unroll
        for (int r = 0; r < 16; ++r) o[i][r] = 0.f;
    float m = -INFINITY, l = 0.f;
    v4u kr0, kr1, vr0, vr1;
    kr0 = *(const v4u*)ksrc; kr1 = *(const v4u*)(ksrc + 64); vr0 = *(const v4u*)vsrc; vr1 = *(const v4u*)(vsrc + 64);
    *(LAS v4u*)(lds + KBUF + sdst) = kr0; *(LAS v4u*)(lds + KBUF + 8192 + sdst) = kr1; *(LAS v4u*)(lds + VBUF + sdst) = vr0; *(LAS v4u*)(lds + VBUF + 8192 + sdst) = vr1;
    __syncthreads();
#pragma unroll 1
    for (int kt = 0; kt < NT; ++kt) {
        const int buf = kt & 1; const bool more = kt + 1 < NT;
        if (more) { const size_t off = (size_t)(kt + 1) * 64 * NKVQ; kr0 = *(const v4u*)(ksrc + off); kr1 = *(const v4u*)(ksrc + off + 64); vr0 = *(const v4u*)(vsrc + off); vr1 = *(const v4u*)(vsrc + off + 64); }
        if (64 * kt <= q0 + 31) {
            f32x16 p0, p1;
#pragma unroll
            for (int r = 0; r < 16; ++r) { p0[r] = 0.f; p1[r] = 0.f; }
            const LAS unsigned char* kb = lds + KBUF + buf * 16384 + (8 * c + hi) * 1024 + r32 * 16;
#pragma unroll
            for (int d0 = 0; d0 < 4; ++d0) { const bf16x8 a0 = *(const LAS bf16x8*)(kb + d0 * 2048), a1 = *(const LAS bf16x8*)(kb + d0 * 2048 + 512);
                p0 = __builtin_amdgcn_mfma_f32_32x32x16_bf16(a0, qf[d0], p0, 0, 0, 0); p1 = __builtin_amdgcn_mfma_f32_32x32x16_bf16(a1, qf[d0], p1, 0, 0, 0); }
            const int idx0 = q0 + r32 - 64 * kt - 4 * hi;
            const LAS float* tb = tabL + (128 - 59) + idx0;
#pragma unroll
            for (int r = 0; r < 16; ++r) { p0[r] += tb[59 - DA_CST0(r)]; p1[r] += tb[27 - DA_CST0(r)]; }
            if (64 * kt + 63 > q0) {
#pragma unroll
                for (int r = 0; r < 16; ++r) { if (DA_CST0(r) > idx0) p0[r] = -INFINITY; if (32 + DA_CST0(r) > idx0) p1[r] = -INFINITY; }
            }
            float rm = fmaxf(p0[0], p1[0]);
#pragma unroll
            for (int r = 1; r < 16; ++r) rm = fmaxf(rm, fmaxf(p0[r], p1[r]));
            rm = swapmax(rm);
            const float mn = fmaxf(m, rm); const float al = __builtin_amdgcn_exp2f(m - mn); m = mn;
            float ls = 0.f;
#pragma unroll
            for (int r = 0; r < 16; ++r) { p0[r] = __builtin_amdgcn_exp2f(p0[r] - mn); p1[r] = __builtin_amdgcn_exp2f(p1[r] - mn); ls += p0[r] + p1[r]; }
            l = l * al + ls;
#pragma unroll
            for (int i = 0; i < 4; ++i)
#pragma unroll
                for (int r = 0; r < 16; ++r) o[i][r] *= al;
            v4u pw[4];
#pragma unroll
            for (int x = 0; x < 4; ++x) { pw[0][x] = cvtpk(p0[2 * x], p0[2 * x + 1]); pw[1][x] = cvtpk(p0[8 + 2 * x], p0[9 + 2 * x]); pw[2][x] = cvtpk(p1[2 * x], p1[2 * x + 1]); pw[3][x] = cvtpk(p1[8 + 2 * x], p1[9 + 2 * x]); }
            const LAS unsigned char* vb = vb0 + buf * 16384;
#pragma unroll
            for (int db = 0; db < 4; ++db)
#pragma unroll
                for (int ks = 0; ks < 4; ++ks) { const s16x4 lo = vtr(vb + db * 4096 + ks * 1024), hh = vtr(vb + db * 4096 + ks * 1024 + 512);
                    const bf16x8 vf = (bf16x8){lo[0], lo[1], lo[2], lo[3], hh[0], hh[1], hh[2], hh[3]};
                    o[db] = __builtin_amdgcn_mfma_f32_32x32x16_bf16(vf, __builtin_bit_cast(bf16x8, pw[ks]), o[db], 0, 0, 0); }
        }
        if (more) { const int nb = (buf ^ 1) * 16384; *(LAS v4u*)(lds + KBUF + nb + sdst) = kr0; *(LAS v4u*)(lds + KBUF + nb + 8192 + sdst) = kr1; *(LAS v4u*)(lds + VBUF + nb + sdst) = vr0; *(LAS v4u*)(lds + VBUF + nb + 8192 + sdst) = vr1; }
        __syncthreads();
    }
    const float il = 1.f / swapsum(l);
    LAS float* xch = (LAS float*)(lds + XCH) + (qt * 64) * 64 + lane;
    if (c == 1) {
#pragma unroll
        for (int i = 0; i < 4; ++i)
#pragma unroll
            for (int r = 0; r < 16; ++r) xch[(i * 16 + r) * 64] = o[i][r] * il;
    }
    __syncthreads();
    if (c == 0) {
        float ss = 0.f;
#pragma unroll
        for (int i = 0; i < 4; ++i)
#pragma unroll
            for (int r = 0; r < 16; ++r) { const float v = o[i][r] * il - lam * xch[(i * 16 + r) * 64]; o[i][r] = v; ss += v * v; }
        ss = swapsum(ss);
        const float rs = 1.f / sqrtf(ss * (1.f / 128.f) + SUBLN_EPS) * (1.f - LAMBDA_INIT);
        bf16* op = Ob + (rowb + q0 + r32) * DM + h * 128 + 4 * hi;
#pragma unroll
        for (int i = 0; i < 4; ++i)
#pragma unroll
            for (int rr = 0; rr < 4; ++rr) { const f32x4 sg = *(const f32x4*)(subg + 32 * i + 8 * rr + 4 * hi);
                v2u w; w.x = cvtpk(o[i][4 * rr] * rs * sg.x, o[i][4 * rr + 1] * rs * sg.y); w.y = cvtpk(o[i][4 * rr + 2] * rs * sg.z, o[i][4 * rr + 3] * rs * sg.w);
                *(v2u*)(op + 32 * i + 8 * rr) = w; }
    }
    __syncthreads();
}
}

__device__ __forceinline__ void diff_attn_phase(const bf16* kvq, const float* tabB, const float* par, bf16* Ob, LAS unsigned char* lds) {
    PHASE_IDS
    float lam;
    { const float* lp = par + PAR_LAM; const float p1 = lp[lane] * lp[64 + lane], p2 = lp[128 + lane] * lp[192 + lane]; lam = expf(wave_sum(p1)) - expf(wave_sum(p2)) + LAMBDA_INIT; }
    const float* subg = par + PAR_SUBG;
    const int bh = vcu_ >> 2, j = vcu_ & 3, b = bh >> 3, h = bh & 7;
    { LAS float* tabL = (LAS float*)(lds + da::TABL); const float* src = tabB + h * TABB_STRIDE;
      for (int i = tid_; i < da::TABL_FLOATS; i += NTHR) tabL[i] = i < 64 ? 0.f : src[i - 64]; }
    __syncthreads();
#pragma unroll 1
    for (int u = 0; u < 8; ++u) {
        const int base = 4 * (u >> 1) + j; const int qblk = (u & 1) ? 31 - base : base;
        da::diff_unit(b, h, qblk, kvq, lam, subg, Ob, lds, wave, lane);
    }
}

namespace dl {
using da::bf16x8; using da::s16x4; using da::f32x16; using da::cvtpk; using da::vtr; using da::swapmax; using da::swapsum;
constexpr int STAGE = 0, TAB = 32768;
__device__ __forceinline__ void task(int b, int h, int tb, int g, int ti, const bf16* qkv, bf16* Og, float* LSE, LAS unsigned char* lds, int wave, int lane) {
    const int r32 = lane & 31, hi = lane >> 5;
    const int sh = 2 * g;
    int c, m0;
    if (g == 0) { c = 0; m0 = tb * 512 + 32 * ti; } else if (g == 1) { c = ti & 3; m0 = tb * 128 + 32 * (ti >> 2); } else { c = ti; m0 = tb * 32; }
    const size_t rowb = (size_t)b * SEQ;
    const int gcol = g * 1536 + h * 64;
    const int qtok = ((m0 + r32) << sh) + c;
    bf16x8 qf[4];
    { const bf16* qp = qkv + (rowb + qtok) * NQKVA + gcol + hi * 8;
#pragma unroll
      for (int d0 = 0; d0 < 4; ++d0) qf[d0] = *(const bf16x8*)(qp + 16 * d0); }
    const int jmin = (m0 >= 128) ? 0 : 4 - (m0 >> 5);
    f32x16 o[2];
#pragma unroll
    for (int i = 0; i < 2; ++i)
#pragma unroll
        for (int r = 0; r < 16; ++r) o[i][r] = 0.f;
    float m = -INFINITY, l = 0.f;
    LAS unsigned char* stg = lds + STAGE + wave * 4096;
    const LAS unsigned char* vb = stg + ((lane >> 4) & 1) * 32 + (lane & 3) * 8 + (4 * hi + ((lane & 15) >> 2)) * 64;
    const LAS float* tab = (const LAS float*)(lds + TAB) + g * 132;
    const bf16* kbase = qkv + rowb * NQKVA + gcol + 512 + hi * 8;
    const bf16* vbase = qkv + rowb * NQKVA + gcol + 1024 + (lane & 3) * 8;
    bf16x8 kn[4]; v4u vn[4];
#define DL_LOAD(j) do { const int ku0_ = m0 - 128 + 32 * (j); const bf16* kp_ = kbase + (size_t)(((ku0_ + r32) << sh) + c) * NQKVA; \
        _Pragma("unroll") for (int d0 = 0; d0 < 4; ++d0) kn[d0] = *(const bf16x8*)(kp_ + 16 * d0); \
        _Pragma("unroll") for (int i = 0; i < 4; ++i) vn[i] = *(const v4u*)(vbase + (size_t)(((ku0_ + 16 * (i & 1) + (lane >> 2)) << sh) + c) * NQKVA + 32 * (i >> 1)); } while (0)
    DL_LOAD(jmin);
#pragma unroll 1
    for (int j = jmin; j <= 4; ++j) {
        bf16x8 kf[4]; v4u vv[4];
#pragma unroll
        for (int i = 0; i < 4; ++i) { kf[i] = kn[i]; vv[i] = vn[i]; }
        if (j < 4) DL_LOAD(j + 1);
        f32x16 p;
#pragma unroll
        for (int r = 0; r < 16; ++r) p[r] = 0.f;
#pragma unroll
        for (int d0 = 0; d0 < 4; ++d0) p = __builtin_amdgcn_mfma_f32_32x32x16_bf16(kf[d0], qf[d0], p, 0, 0, 0);
        const int du0 = 128 - 32 * j + r32 - 4 * hi;
        const LAS float* tb = tab + du0 - 27;
#pragma unroll
        for (int r = 0; r < 16; ++r) p[r] += tb[27 - DA_CST0(r)];
        if (j == 0 || j == 4) {
#pragma unroll
            for (int r = 0; r < 16; ++r) { const int du = du0 - DA_CST0(r); if (du < 0 || du > 128) p[r] = -INFINITY; }
        }
        float rm = p[0];
#pragma unroll
        for (int r = 1; r < 16; ++r) rm = fmaxf(rm, p[r]);
        rm = swapmax(rm);
        const float mn = fmaxf(m, rm); const float al = __builtin_amdgcn_exp2f(m - mn); m = mn;
        float ls = 0.f;
#pragma unroll
        for (int r = 0; r < 16; ++r) { p[r] = __builtin_amdgcn_exp2f(p[r] - mn); ls += p[r]; }
        l = l * al + ls;
#pragma unroll
        for (int i = 0; i < 2; ++i)
#pragma unroll
            for (int r = 0; r < 16; ++r) o[i][r] *= al;
        v4u pw[2];
#pragma unroll
        for (int x = 0; x < 4; ++x) { pw[0][x] = cvtpk(p[2 * x], p[2 * x + 1]); pw[1][x] = cvtpk(p[8 + 2 * x], p[9 + 2 * x]); }
#pragma unroll
        for (int i = 0; i < 4; ++i) *(LAS v4u*)(stg + i * 1024 + lane * 16) = vv[i];
#pragma unroll
        for (int db = 0; db < 2; ++db)
#pragma unroll
            for (int ks = 0; ks < 2; ++ks) { const s16x4 lo = vtr(vb + (db * 2 + ks) * 1024), hh = vtr(vb + (db * 2 + ks) * 1024 + 512);
                const bf16x8 vf = (bf16x8){lo[0], lo[1], lo[2], lo[3], hh[0], hh[1], hh[2], hh[3]};
                o[db] = __builtin_amdgcn_mfma_f32_32x32x16_bf16(vf, __builtin_bit_cast(bf16x8, pw[ks]), o[db], 0, 0, 0); }
    }
#undef DL_LOAD
    const float lt = swapsum(l); const float il = 1.f / lt;
    bf16* op = Og + ((size_t)g * TOK + rowb + qtok) * AW + h * 64 + 4 * hi;
#pragma unroll
    for (int i = 0; i < 2; ++i)
#pragma unroll
        for (int rr = 0; rr < 4; ++rr) { v2u w; w.x = cvtpk(o[i][4 * rr] * il, o[i][4 * rr + 1] * il); w.y = cvtpk(o[i][4 * rr + 2] * il, o[i][4 * rr + 3] * il); *(v2u*)(op + 32 * i + 8 * rr) = w; }
    if (hi == 0) LSE[((size_t)g * TOK + rowb + qtok) * 8 + h] = m + __builtin_amdgcn_logf(lt);
}
}

__device__ __forceinline__ void dilated_attn_phase(const bf16* qkv, const float* tabA, bf16* Og, float* LSE, bf16* Oa, LAS unsigned char* lds) {
    PHASE_IDS
#pragma unroll 1
    for (int unit = vcu_; unit < 512; unit += G_) {
        const int b = unit >> 6, h = (unit >> 3) & 7, tb = unit & 7;
        { LAS float* tl = (LAS float*)(lds + dl::TAB); for (int i = tid_; i < 3 * 132; i += NTHR) tl[i] = tabA[((i / 132) * 8 + h) * 132 + (i % 132)]; }
        __syncthreads();
#pragma unroll 1
        for (int i = 0; i < 6; ++i) { const int t = wave + 8 * i; dl::task(b, h, tb, t >> 4, t & 15, qkv, Og, LSE, lds, wave, lane); }
        __threadfence(); __syncthreads(); __threadfence();
        const size_t tok0 = (size_t)b * SEQ + tb * 512;
#pragma unroll 1
        for (int it = tid_; it < 4096; it += NTHR) { const int tk = it >> 3, ch = it & 7; const size_t tok = tok0 + tk;
            const float l0 = LSE[tok * 8 + h], l1 = LSE[((size_t)TOK + tok) * 8 + h], l2 = LSE[((size_t)2 * TOK + tok) * 8 + h];
            const float mx = fmaxf(l0, fmaxf(l1, l2)); float a0 = __builtin_amdgcn_exp2f(l0 - mx), a1 = __builtin_amdgcn_exp2f(l1 - mx), a2 = __builtin_amdgcn_exp2f(l2 - mx);
            const float inv = 1.f / (a0 + a1 + a2); a0 *= inv; a1 *= inv; a2 *= inv;
            float f0[8], f1[8], f2[8]; ld8(Og + tok * AW + h * 64 + ch * 8, f0); ld8(Og + ((size_t)TOK + tok) * AW + h * 64 + ch * 8, f1); ld8(Og + ((size_t)2 * TOK + tok) * AW + h * 64 + ch * 8, f2);
            float r8[8];
#pragma unroll
            for (int e = 0; e < 8; ++e) r8[e] = a0 * f0[e] + a1 * f1[e] + a2 * f2[e];
            v4u w; w.x = pk2(r8[0], r8[1]); w.y = pk2(r8[2], r8[3]); w.z = pk2(r8[4], r8[5]); w.w = pk2(r8[6], r8[7]);
            *(v4u*)(Oa + tok * AW + h * 64 + ch * 8) = w; }
        __syncthreads();
    }
}

__device__ __forceinline__ void conv_naive(const bf16* u, int half, const float* cw, const float* cb, bf16* gated) {
    PHASE_IDS
    for (int it = gtid; it < 16384 * 352; it += gstride) {
        const int j8 = it % 352, rl = it / 352; const int t = half * 16384 + rl; const int s = t & (SEQ - 1); const int j = j8 * 8;
        const int ucol = 256 * (j / 128) + (j % 128);
        float cg[8], cv[8];
#pragma unroll
        for (int i = 0; i < 8; ++i) { cg[i] = cb[j + i]; cv[i] = cb[FF + j + i]; }
#pragma unroll
        for (int jj = 0; jj < 3; ++jj) { const int ds = 2 - jj;
            if (s - ds >= 0) { const bf16* up = u + (size_t)(rl - ds) * NUP + ucol; float ug[8], uv[8]; ld8(up, ug); ld8(up + 128, uv);
#pragma unroll
                for (int i = 0; i < 8; ++i) { cg[i] += cw[jj * NUP + j + i] * ug[i]; cv[i] += cw[jj * NUP + FF + j + i] * uv[i]; } } }
        float r[8];
#pragma unroll
        for (int i = 0; i < 8; ++i) r[i] = 0.5f * cg[i] * (1.f + erff(cg[i] * 0.70710678118654752f)) * cv[i];
        v4u w; w.x = pk2(r[0], r[1]); w.y = pk2(r[2], r[3]); w.z = pk2(r[4], r[5]); w.w = pk2(r[6], r[7]);
        *(v4u*)(gated + (size_t)t * FF + j) = w;
    }
}


namespace cg = cooperative_groups;
#define GEMM_PHASE(A_, B_, M_, N_, K_, O_, LDC_) do { pg8::Gemm g{(const bf16*)(A_), (const bf16*)(B_), M_, N_, K_}; pg8::StaticOrder S; S.init(M_, N_, (int)gridDim.x, (int)blockIdx.x); \
    pg8::EpiBf16<0> E{(bf16*)(O_), LDC_, nullptr, 0, 0, 1.f}; pg8::gemm_phase<pg8::EpiBf16<0>, pg8::StaticOrder, PG8_ALIGN, PG8_SP2>(lds, g, S, E); } while (0)
__global__ void __launch_bounds__(NTHR, 2) fwd(Args a) {
    extern __shared__ __attribute__((aligned(16))) unsigned char lds_raw[];
    LAS unsigned char* lds = (LAS unsigned char*)lds_raw;
    cg::grid_group grid = cg::this_grid();
    unsigned char* ws = a.ws;
    prologue(a, lds); grid.sync();
    const float* xin = a.in[0]; float* out = a.out;
#define WSP(T, off) ((T*)(ws + (off)))
#define PARP(off) (WSP(const float, WS_PAR) + (off))
    GEMM_PHASE(WSP(bf16, WS_XN), ws + WS_WIN, TOK, NQKVA, DM, WSP(bf16, WS_BIG), NQKVA); grid.sync();
    dilated_attn_phase(WSP(const bf16, WS_BIG), WSP(const float, WS_TABA), WSP(bf16, 416 * MiB), WSP(float, 64 * MiB), WSP(bf16, 68 * MiB), lds); grid.sync();
    GEMM_PHASE(WSP(bf16, 68 * MiB), ws + WS_WOA, TOK, DM, AW, WSP(bf16, 448 * MiB), DM); grid.sync();
    rowpass(WSP(const bf16, 448 * MiB), PARP(PAR_NORMG + 1 * DM), xin, out, WSP(bf16, WS_XN)); grid.sync();
#pragma unroll 1
    for (int lay = 0; lay < 2; ++lay) {
        if (lay == 1) {
            GEMM_PHASE(WSP(bf16, WS_XN), ws + WS_WKVQ, TOK, NKVQ, DM, WSP(bf16, WS_BIG), NKVQ); grid.sync();
            diff_attn_phase(WSP(const bf16, WS_BIG), WSP(const float, WS_TABB), PARP(0), WSP(bf16, 320 * MiB), lds); grid.sync();
            GEMM_PHASE(WSP(bf16, 320 * MiB), ws + WS_WOB, TOK, DM, DM, WSP(bf16, 448 * MiB), DM); grid.sync();
            rowpass(WSP(const bf16, 448 * MiB), PARP(PAR_NORMG + 5 * DM), out, out, WSP(bf16, WS_XN)); grid.sync();
        }
#pragma unroll 1
        for (int half = 0; half < 2; ++half) {
            GEMM_PHASE(WSP(bf16, WS_XN) + (size_t)half * (TOK / 2) * DM, ws + (lay ? WS_WUP1 : WS_WUP0), TOK / 2, NUP, DM, WSP(bf16, WS_BIG), NUP); grid.sync();
            conv_naive(WSP(const bf16, WS_BIG), half, PARP(PAR_CONVW + lay * 3 * NUP), PARP(PAR_CONVB + lay * NUP), WSP(bf16, 304 * MiB)); grid.sync();
        }
        GEMM_PHASE(WSP(bf16, 304 * MiB), ws + (lay ? WS_WDN1 : WS_WDN0), TOK, DM, FF, WSP(bf16, WS_BIG), DM); grid.sync();
        rowpass(WSP(const bf16, WS_BIG), PARP(PAR_NORMG + (lay * 4 + 3) * DM), out, out, lay == 0 ? WSP(bf16, WS_XN) : (bf16*)nullptr);
        if (lay == 0) grid.sync();
    }
}

extern "C" void kernel_launch(void* const* d_in, const int* in_sizes, int n_in, void* d_out, int out_size, void* d_ws, size_t ws_size, hipStream_t stream) {
    static int grid = 0;
    if (grid == 0) {
        if (n_in != 19 || in_sizes[0] != TOK * DM || out_size != TOK * DM || ws_size < WS_END) {
            fprintf(stderr, "kernel_launch: unexpected shapes: n_in %d in0 %d out %d ws %zu (need %zu)\n", n_in, n_in > 0 ? in_sizes[0] : -1, out_size, ws_size, (size_t)WS_END); grid = -1; return; }
        int dev = 0, cus = 0, per_cu = 0;
        if (hipGetDevice(&dev) != hipSuccess || hipDeviceGetAttribute(&cus, hipDeviceAttributeMultiprocessorCount, dev) != hipSuccess) { grid = -1; return; }
        if (hipFuncSetAttribute((const void*)fwd, hipFuncAttributeMaxDynamicSharedMemorySize, LDS_BYTES) != hipSuccess) { fprintf(stderr, "kernel_launch: hipFuncSetAttribute failed\n"); grid = -1; return; }
        if (hipOccupancyMaxActiveBlocksPerMultiprocessor(&per_cu, (const void*)fwd, NTHR, LDS_BYTES) != hipSuccess || per_cu < 1) { fprintf(stderr, "kernel_launch: occupancy query says %d blocks/CU\n", per_cu); grid = -1; return; }
        grid = cus;
    }
    if (grid < 0) return;
    Args a{};
    for (int i = 0; i < 19; ++i) a.in[i] = (const float*)d_in[i];
    a.out = (float*)d_out; a.ws = (unsigned char*)d_ws;
    void* args[] = {&a};
    hipError_t e = hipLaunchCooperativeKernel((const void*)fwd, dim3(grid), dim3(NTHR), args, LDS_BYTES, stream);
    if (e != hipSuccess) fprintf(stderr, "cooperative launch failed: %s (grid %d)\n", hipGetErrorString(e), grid);
}
```

```cpp
#include <hip/hip_runtime.h>
#include <hip/hip_cooperative_groups.h>
#include <cstdio>
#include <cstdint>
namespace pg8 {
#define PG8_LAS __attribute__((address_space(3)))
typedef unsigned short bf16_t;
typedef short bf16x8 __attribute__((ext_vector_type(8)));
typedef float f32x4 __attribute__((ext_vector_type(4)));
typedef unsigned u32x4 __attribute__((ext_vector_type(4)));
constexpr int BM = 256, BK = 64, HALF = 128, HTB = HALF * BK * 2  , STAGE_BYTES = 8 * HTB, NXCD = 8, WGM = 8;

__host__ __device__ __forceinline__ int lds_byte(int r, int c) { const int st = (r >> 4) * 2 + (c >> 5), rr = r & 15, cc = c & 31, ob = rr * 64 + cc * 2; return st * 1024 + (ob ^ (((ob >> 9) & 1) << 5)); }
__host__ __device__ __forceinline__ void stage_rc(int b, int& R, int& C) { const int st = b / 1024, sb = b % 1024, swz = sb ^ (((sb >> 9) & 1) << 5); R = (st >> 1) * 16 + swz / 64; C = (st & 1) * 32 + (swz % 64) / 2; }
__host__ __device__ __forceinline__ int perm32(int rho) { const int n = rho >> 4, i = rho & 15; return 8 * (i >> 2) + 4 * n + (i & 3); }

struct Unit { int pm, pn; };
struct Gemm { const bf16_t* A; const bf16_t* Bt; int M, N, K; };

struct StaticOrder {
    int nM, nN, nwg, G, c;
    __host__ __device__ void init(int M, int N, int G_, int c_) { nM = M / BM; nN = N / BM; nwg = nM * nN; G = G_; c = c_; }
    __host__ __device__ bool next(int i, Unit& u) const {
        const long L = (long)i * G + c; if (L >= nwg) return false;
        int wgid = (int)L; { const int q = nwg / NXCD, r = nwg % NXCD, xcd = wgid % NXCD, off = wgid / NXCD; wgid = (xcd < r ? xcd * (q + 1) : r * (q + 1) + (xcd - r) * q) + off; }
        const int nig = WGM * nN, gid = wgid / nig, fm = gid * WGM, gsz = (nM - fm) < WGM ? (nM - fm) : WGM;
        u.pm = fm + ((wgid % nig) % gsz); u.pn = (wgid % nig) / gsz; return true;
    }
    __device__ __forceinline__ void a_ready(const Unit&) const {}
    __device__ __forceinline__ void done(const Unit&) const {}
};

__device__ __forceinline__ unsigned cvt_pk_bf16(float lo, float hi) { unsigned r; asm volatile("v_cvt_pk_bf16_f32 %0, %1, %2" : "=v"(r) : "v"(lo), "v"(hi)); return r; }
typedef float f32x2 __attribute__((ext_vector_type(2)));
__device__ __forceinline__ f32x2 gelu_pk(f32x2 v) {
    const f32x2 av = __builtin_elementwise_abs(v), d = av * 0.2316418882f + 1.0f;
    f32x2 t; t.x = __builtin_amdgcn_rcpf(d.x); t.y = __builtin_amdgcn_rcpf(d.y);
    f32x2 q = t * 0.5307027145f + (-0.7265760135f); q = q * t + 0.7107068705f; q = q * t + (-0.142248368f); q = q * t + 0.127414796f; q = q * t;
    const f32x2 s = (v * v) * (-0.72134752044f);
    f32x2 e; e.x = __builtin_amdgcn_exp2f(s.x); e.y = __builtin_amdgcn_exp2f(s.y);
    const f32x2 m = v * (q * e), r = v - m;
    f32x2 o; o.x = v.x < 0.f ? m.x : r.x; o.y = v.y < 0.f ? m.y : r.y; return o;
}

template <int ACT  > struct EpiBf16 {
    static constexpr bool PERM = true, AFTER_DRAIN = false, AMAP = false; static_assert(ACT == 0 || ACT == 1, "EpiBf16: ACT is 0 (none) or 1 (gelu_pk)");
    bf16_t* O; int ldc; const float* bias; int split_cols; size_t split_stride; float scale0;
    __device__ __forceinline__ void operator()(const f32x4 (&acc)[2][2][4][2], const Unit& u, int wr, int wc, int fr, int fq) const {
        const int row0 = u.pm * BM + wr * 64 + fr; int colt = u.pn * BM; bf16_t* base = O;
        float sc = 1.f; if (split_cols) { const int t = colt / split_cols; base += (size_t)t * split_stride; colt -= t * split_cols; if (t == 0) sc = scale0; }
        const int col0 = colt + wc * 32 + 8 * fq, bcol0 = u.pn * BM + wc * 32 + 8 * fq;
        f32x4 bv[2][2];
#pragma unroll
        for (int bj = 0; bj < 2; ++bj)
#pragma unroll
            for (int n = 0; n < 2; ++n) bv[bj][n] = bias ? *(const f32x4*)(bias + bcol0 + bj * HALF + 4 * n) : (f32x4){0.f, 0.f, 0.f, 0.f};
#pragma unroll
        for (int ai = 0; ai < 2; ++ai)
#pragma unroll
            for (int m = 0; m < 4; ++m) { bf16_t* rowp = base + (size_t)(row0 + ai * HALF + m * 16) * ldc + col0;
#pragma unroll
                for (int bj = 0; bj < 2; ++bj) { f32x4 v0 = acc[ai][bj][m][0] + bv[bj][0], v1 = acc[ai][bj][m][1] + bv[bj][1];
                    if (ACT == 1) { f32x2 a = gelu_pk((f32x2){v0[0], v0[1]}), b = gelu_pk((f32x2){v0[2], v0[3]}), c = gelu_pk((f32x2){v1[0], v1[1]}), d = gelu_pk((f32x2){v1[2], v1[3]});
                        v0 = (f32x4){a.x, a.y, b.x, b.y}; v1 = (f32x4){c.x, c.y, d.x, d.y}; }
                    v0 = v0 * sc; v1 = v1 * sc; u32x4 w; w.x = cvt_pk_bf16(v0[0], v0[1]); w.y = cvt_pk_bf16(v0[2], v0[3]); w.z = cvt_pk_bf16(v1[0], v1[1]); w.w = cvt_pk_bf16(v1[2], v1[3]);
                    *(u32x4*)(rowp + bj * HALF) = w; } }
    }
};
template <class Epi, class Sched, bool ALIGN_EPI = false, bool SP2 = false>
__device__ __forceinline__ void gemm_phase(PG8_LAS unsigned char* lds, const Gemm g, const Sched& S, const Epi& E) {
    int tid_l = threadIdx.x; asm volatile("" : "+v"(tid_l));
    const int tid = tid_l, wid = __builtin_amdgcn_readfirstlane(tid >> 6), lane = tid & 63, wr = wid >> 2, wc = wid & 3, fr = lane & 15, fq = lane >> 4;
    const int K = g.K, nt = K / BK;
    unsigned voffA[2], voffB[2];
#pragma unroll
    for (int i = 0; i < 2; ++i) { int R, C; stage_rc(tid * 16 + i * 8192, R, C); const int Rb = Epi::PERM ? ((R & ~31) + perm32(R & 31)) : R;
        const int Ra = Epi::AMAP ? (128 * (R >> 6) + (R & 63)) : R;
        voffA[i] = (unsigned)(Ra * K + C) * 2u; voffB[i] = (unsigned)(Rb * K + C) * 2u; }
    const size_t kstep = (size_t)(BK * 2);
    const size_t hstep = (size_t)HALF * K * 2;
    const size_t hstepA = Epi::AMAP ? (size_t)64 * K * 2 : hstep;
    const size_t tstep = 2 * hstep;
    const unsigned ldsw = (unsigned)wid * 1024u;
    const int aoff = lds_byte(wr * 64 + fr, fq * 8), boff = lds_byte(wc * 32 + fr, fq * 8);
#define PG8_SA(b, h) (((b) * 2 + (h)) * HTB)
#define PG8_SB(b, h) ((4 + (b) * 2 + (h)) * HTB)
#define PG8_STAGE(bufoff, gbase, voff) do { _Pragma("unroll") for (int _i = 0; _i < 2; ++_i) \
        __builtin_amdgcn_global_load_lds((const unsigned*)((const char*)(gbase) + (voff)[_i]), (PG8_LAS unsigned*)(lds + (bufoff) + ldsw + _i * 8192), 16, 0, 0); } while (0)
#define PG8_LDA(dst, b, h) do { _Pragma("unroll") for (int m = 0; m < 4; ++m) _Pragma("unroll") for (int k = 0; k < 2; ++k) dst[m][k] = *(const PG8_LAS bf16x8*)(lds + PG8_SA(b, h) + aoff + m * 2048 + k * 1024); } while (0)
#define PG8_LDB(dst, b, h) do { _Pragma("unroll") for (int n = 0; n < 2; ++n) _Pragma("unroll") for (int k = 0; k < 2; ++k) dst[n][k] = *(const PG8_LAS bf16x8*)(lds + PG8_SB(b, h) + boff + n * 2048 + k * 1024); } while (0)
#define PG8_MMA(ai, bj, At, Bt) do { __builtin_amdgcn_s_setprio(1); _Pragma("unroll") for (int m = 0; m < 4; ++m) _Pragma("unroll") for (int n = 0; n < 2; ++n) _Pragma("unroll") for (int k = 0; k < 2; ++k) \
        acc[ai][bj][m][n] = __builtin_amdgcn_mfma_f32_16x16x32_bf16(Bt[n][k], At[m][k], acc[ai][bj][m][n], 0, 0, 0); __builtin_amdgcn_s_setprio(0); } while (0)
#define PG8_WAIT_V(n) asm volatile("s_waitcnt vmcnt(" #n ")" ::: "memory")
#define PG8_WAIT_L(n) asm volatile("s_waitcnt lgkmcnt(" #n ")" ::: "memory")
#define PG8_BAR __builtin_amdgcn_s_barrier()
#define PG8_SCHED __builtin_amdgcn_sched_barrier(0)
    Unit cur, nxt; int ui = 0;
    if (!S.next(0, cur)) return;
    f32x4 acc[2][2][4][2];
#pragma unroll
    for (int a = 0; a < 2; ++a)
#pragma unroll
        for (int b = 0; b < 2; ++b)
#pragma unroll
            for (int m = 0; m < 4; ++m)
#pragma unroll
                for (int n = 0; n < 2; ++n) acc[a][b][m][n] = (f32x4){0.f, 0.f, 0.f, 0.f};
    bf16x8 At[4][2], B0[2][2], B1[2][2];
    const char* cA = (const char*)g.A + (size_t)cur.pm * tstep; const char* cB = (const char*)g.Bt + (size_t)cur.pn * tstep;
    S.a_ready(cur);
    if constexpr (SP2) {
        PG8_STAGE(PG8_SB(0, 0), cB, voffB); PG8_STAGE(PG8_SB(0, 1), cB + hstep, voffB); PG8_STAGE(PG8_SA(0, 0), cA, voffA); PG8_STAGE(PG8_SA(0, 1), cA + hstepA, voffA);
        if (wr == 1) PG8_BAR;
        PG8_WAIT_V(2); PG8_BAR;
        PG8_STAGE(PG8_SB(1, 0), cB + kstep, voffB); PG8_STAGE(PG8_SA(1, 0), cA + kstep, voffA); PG8_STAGE(PG8_SB(1, 1), cB + hstep + kstep, voffB);
        PG8_WAIT_V(6); PG8_BAR;
    } else {
        PG8_STAGE(PG8_SB(0, 0), cB, voffB); PG8_STAGE(PG8_SA(0, 0), cA, voffA); PG8_STAGE(PG8_SB(0, 1), cB + hstep, voffB); PG8_STAGE(PG8_SA(0, 1), cA + hstepA, voffA);
        if (wr == 1) PG8_BAR;
        PG8_WAIT_V(4); PG8_BAR;
        PG8_STAGE(PG8_SB(1, 0), cB + kstep, voffB); PG8_STAGE(PG8_SA(1, 0), cA + kstep, voffA); PG8_STAGE(PG8_SB(1, 1), cB + hstep + kstep, voffB);
        PG8_WAIT_V(6); PG8_BAR;
    }
    for (;;) {
        const bool has_next = S.next(ui + 1, nxt);
        const char* nA = has_next ? (const char*)g.A + (size_t)nxt.pm * tstep : cA; const char* nB = has_next ? (const char*)g.Bt + (size_t)nxt.pn * tstep : cB;
        for (int t = 0; t < nt; t += 2) {
            const bool last = (t == nt - 2);
            const char* a1 = cA + (size_t)(t + 1) * kstep;
            const char* a2 = last ? nA : cA + (size_t)(t + 2) * kstep; const char* b2 = last ? nB : cB + (size_t)(t + 2) * kstep;
            const char* a3 = a2 + kstep; const char* b3 = b2 + kstep;
            if (last && has_next) S.a_ready(nxt);
            if constexpr (SP2) {
            PG8_LDB(B0, 0, 0); PG8_LDB(B1, 0, 1); PG8_SCHED; PG8_LDA(At, 0, 0); PG8_STAGE(PG8_SA(1, 1), a1 + hstepA, voffA);
            PG8_WAIT_V(8); PG8_WAIT_L(0); PG8_BAR; PG8_MMA(0, 0, At, B0); PG8_MMA(0, 1, At, B1); PG8_BAR; PG8_SCHED;
            PG8_LDA(At, 0, 1); PG8_STAGE(PG8_SB(0, 0), b2, voffB); PG8_STAGE(PG8_SB(0, 1), b2 + hstep, voffB); PG8_STAGE(PG8_SA(0, 0), a2, voffA);
            PG8_WAIT_V(8); PG8_WAIT_L(0); PG8_BAR; PG8_MMA(1, 0, At, B0); PG8_MMA(1, 1, At, B1); PG8_BAR; PG8_SCHED;
            PG8_LDB(B0, 1, 0); PG8_LDB(B1, 1, 1); PG8_SCHED; PG8_LDA(At, 1, 0); PG8_STAGE(PG8_SA(0, 1), a2 + hstepA, voffA);
            PG8_WAIT_V(8); PG8_WAIT_L(0); PG8_BAR; PG8_MMA(0, 0, At, B0); PG8_MMA(0, 1, At, B1); PG8_BAR; PG8_SCHED;
            PG8_LDA(At, 1, 1); PG8_STAGE(PG8_SB(1, 0), b3, voffB); PG8_STAGE(PG8_SB(1, 1), b3 + hstep, voffB); PG8_STAGE(PG8_SA(1, 0), a3, voffA);
            PG8_WAIT_V(8); PG8_WAIT_L(0); PG8_BAR; PG8_MMA(1, 0, At, B0); PG8_MMA(1, 1, At, B1); PG8_BAR; PG8_SCHED;
            } else {
            PG8_LDB(B0, 0, 0); PG8_SCHED; PG8_LDA(At, 0, 0); PG8_STAGE(PG8_SA(1, 1), a1 + hstepA, voffA);
            PG8_WAIT_L(8); PG8_BAR; PG8_WAIT_L(0); PG8_MMA(0, 0, At, B0); PG8_BAR; PG8_SCHED;
            PG8_LDB(B1, 0, 1); PG8_STAGE(PG8_SB(0, 0), b2, voffB);
            PG8_BAR; PG8_WAIT_L(0); PG8_MMA(0, 1, At, B1); PG8_BAR;
            PG8_LDA(At, 0, 1); PG8_STAGE(PG8_SA(0, 0), a2, voffA);
            PG8_BAR; PG8_WAIT_L(0); PG8_MMA(1, 0, At, B0); PG8_BAR; PG8_SCHED;
            PG8_STAGE(PG8_SB(0, 1), b2 + hstep, voffB);
            PG8_WAIT_V(6); PG8_BAR; PG8_MMA(1, 1, At, B1); PG8_BAR;
            PG8_LDB(B0, 1, 0); PG8_SCHED; PG8_LDA(At, 1, 0); PG8_STAGE(PG8_SA(0, 1), a2 + hstepA, voffA);
            PG8_WAIT_L(8); PG8_BAR; PG8_WAIT_L(0); PG8_MMA(0, 0, At, B0); PG8_BAR; PG8_SCHED;
            PG8_LDB(B1, 1, 1); PG8_STAGE(PG8_SB(1, 0), b3, voffB);
            PG8_BAR; PG8_WAIT_L(0); PG8_MMA(0, 1, At, B1); PG8_BAR;
            PG8_LDA(At, 1, 1); PG8_STAGE(PG8_SA(1, 0), a3, voffA);
            PG8_BAR; PG8_WAIT_L(0); PG8_MMA(1, 0, At, B0); PG8_BAR; PG8_SCHED;
            PG8_STAGE(PG8_SB(1, 1), b3 + hstep, voffB);
            PG8_WAIT_V(6); PG8_BAR; PG8_MMA(1, 1, At, B1); PG8_BAR;
            }
        }
        if constexpr (ALIGN_EPI) { if (wr == 0) PG8_BAR; }
        if constexpr (!Epi::AFTER_DRAIN) { E(acc, cur, wr, wc, fr, fq); S.done(cur); }
        if (!has_next) break;
#pragma unroll
        for (int a = 0; a < 2; ++a)
#pragma unroll
            for (int b = 0; b < 2; ++b)
#pragma unroll
                for (int m = 0; m < 4; ++m)
#pragma unroll
                    for (int n = 0; n < 2; ++n) acc[a][b][m][n] = (f32x4){0.f, 0.f, 0.f, 0.f};
        cur = nxt; cA = nA; cB = nB; ++ui;
        if constexpr (ALIGN_EPI) { if (wr == 1) PG8_BAR; }
    }
    PG8_WAIT_V(0);
    if constexpr (!ALIGN_EPI) { if (wr == 0) PG8_BAR; }
    PG8_BAR;
    if constexpr (Epi::AFTER_DRAIN) { E.fused(acc, cur, wr, wc, fr, fq, lds, wid, lane); S.done(cur); }
#undef PG8_SA
#undef PG8_SB
#undef PG8_STAGE
#undef PG8_LDA
#undef PG8_LDB
#undef PG8_MMA
#undef PG8_WAIT_V
#undef PG8_WAIT_L
#undef PG8_BAR
#undef PG8_SCHED
}
}

#ifndef PG8_SP2
#define PG8_SP2 true
#endif
#ifndef PG8_ALIGN
#define PG8_ALIGN true
#endif

constexpr int NWAVES = 8, NTHR = 512;
constexpr int BATCH = 8, SEQ = 4096, DM = 1024, TOK = BATCH * SEQ;
constexpr int NQKVA = 4608, AW = 512, NKVQ = 3072, FF = 2816, NUP = 5632;
constexpr float LOG2E = 1.4426950408889634f;
constexpr float C2 = 0.125f * LOG2E;
constexpr float RMS_EPS = 1e-6f, SUBLN_EPS = 1e-5f;
constexpr float LAMBDA_INIT = 0.8f - 0.6f * 0.7408182206817179f;

constexpr size_t MiB = 1u << 20;
constexpr size_t WS_WIN = 1 * MiB, WS_WOA = 10 * MiB, WS_WKVQ = 11 * MiB, WS_WOB = 17 * MiB, WS_WUP0 = 19 * MiB, WS_WUP1 = 30 * MiB;
constexpr size_t WS_WDN0 = 41 * MiB, WS_WDN1 = WS_WDN0 + (size_t)DM * FF * 2;
constexpr size_t WS_TABB = 63 * MiB, WS_TABA = WS_TABB + 256 * 1024;
constexpr size_t WS_PAR = 62 * MiB;
constexpr int PAR_NORMG = 0, PAR_CONVW = 8 * 1024, PAR_CONVB = PAR_CONVW + 6 * 5632, PAR_LAM = PAR_CONVB + 2 * 5632, PAR_SUBG = PAR_LAM + 256, PAR_END = PAR_SUBG + 128;
constexpr size_t WS_XN = 64 * MiB;
constexpr size_t WS_BIG = 128 * MiB;
constexpr size_t WS_GATED = 128 * MiB, WS_PART = 304 * MiB, WS_LAST = 316 * MiB, WS_MIX = 448 * MiB;
constexpr size_t WS_END = 512 * MiB;
constexpr int TABB_STRIDE = 64 + SEQ;

constexpr int LDS_BYTES = 147456;

#define GAS __attribute__((address_space(1)))
#define LAS __attribute__((address_space(3)))
typedef unsigned short bf16;
typedef unsigned v4u __attribute__((ext_vector_type(4)));
typedef unsigned v2u __attribute__((ext_vector_type(2)));
typedef float f32x4 __attribute__((ext_vector_type(4)));
#define LDS_WAIT() asm volatile("s_waitcnt lgkmcnt(0)" ::: "memory")
#define LAUNDER_V(x) asm volatile("" : "+v"(x))
#define LAUNDER_S(x) asm volatile("" : "+s"(x))
__device__ __forceinline__ unsigned f2bf(float f) { unsigned u = __builtin_bit_cast(unsigned, f); return (u + 0x7fffu + ((u >> 16) & 1u)) >> 16; }
__device__ __forceinline__ unsigned pk2(float lo, float hi) { return f2bf(lo) | (f2bf(hi) << 16); }
__device__ __forceinline__ float bflo(unsigned w) { return __uint_as_float(w << 16); }
__device__ __forceinline__ float bfhi(unsigned w) { return __uint_as_float(w & 0xffff0000u); }
__device__ __forceinline__ float wave_sum(float v) {
#pragma unroll
    for (int o = 1; o < 64; o <<= 1) v += __shfl_xor(v, o);
    return v;
}
__device__ __forceinline__ int t5_bucket(int n) {
    if (n < 16) return n;
    return 16 + (n >= 22) + (n >= 30) + (n >= 40) + (n >= 54) + (n >= 73) + (n >= 99) + (n >= 134) + (n >= 182) + (n >= 246) + (n >= 332) + (n >= 450) + (n >= 609) + (n >= 825) + (n >= 1117) + (n >= 1513);
}

#define PHASE_IDS \
    int tid_ = threadIdx.x; LAUNDER_V(tid_); const int lane = tid_ & 63, wave = __builtin_amdgcn_readfirstlane(tid_ >> 6); \
    const int G_ = gridDim.x, bx_ = blockIdx.x; const int vcu_ = (G_ % 8 == 0) ? (bx_ % 8) * (G_ / 8) + bx_ / 8 : bx_; \
    const int gw = vcu_ * NWAVES + wave, ngw = G_ * NWAVES, gtid = bx_ * NTHR + tid_, gstride = G_ * NTHR; \
    (void)lane; (void)wave; (void)gw; (void)ngw; (void)gtid; (void)gstride;

struct Args {
    const float* in[19]; float* out; unsigned char* ws; int ph_lo, ph_hi;
};

__device__ __forceinline__ void tr_item(const float* W, int K, int N, bf16* WT, int k0, int n0, int drow0, const float* gk, float cs, LAS float* scr, int lane) {
#pragma unroll 8
    for (int i = 0; i < 32; ++i) { const int kk = 2 * i + (lane >> 5); const float g = gk ? gk[k0 + kk] : 1.f;
        scr[kk * 33 + (lane & 31)] = W[(size_t)(k0 + kk) * N + n0 + (lane & 31)] * (g * cs); }
    LDS_WAIT(); asm volatile("" ::: "memory");
    const int c = lane & 7;
#pragma unroll
    for (int j = 0; j < 4; ++j) { const int n = (lane >> 3) + 8 * j; const LAS float* s = scr + (8 * c) * 33 + n;
        v4u o; o.x = pk2(s[0 * 33], s[1 * 33]); o.y = pk2(s[2 * 33], s[3 * 33]); o.z = pk2(s[4 * 33], s[5 * 33]); o.w = pk2(s[6 * 33], s[7 * 33]);
        *(v4u*)(WT + (size_t)(drow0 + n) * K + k0 + 8 * c) = o; }
    LDS_WAIT(); asm volatile("" ::: "memory");
}
__device__ __forceinline__ void tr_mat(int r, const float* W, int K, int N, bf16* WT, int rowoff, const float* gk, int kind, LAS float* scr, int lane) {
    const int nblk = N / 32, kb = r / nblk, nb = r % nblk, n0 = nb * 32; int dr = n0; float cs = 1.f;
    if (kind == 1) cs = ((n0 % 1536) < 512) ? C2 : 1.f;
    if (kind == 2) cs = C2;
    if (kind == 3) dr = (n0 < FF) ? 256 * (n0 / 128) + (n0 % 128) : 256 * ((n0 - FF) / 128) + 128 + ((n0 - FF) % 128);
    tr_item(W, K, N, WT, kb * 64, n0, dr + rowoff, gk, cs, scr, lane);
}

__device__ __forceinline__ void prologue(const Args& a, LAS unsigned char* lds) {
    PHASE_IDS
    LAS float* scr = (LAS float*)(lds + wave * 16384);
    unsigned char* ws = a.ws;
    const float* norm_g = a.in[2];
    constexpr int I_WIN = 16 * 144, I_WOA = 8 * 32, I_SQ = 16 * 32, I_UP = 16 * 176, I_DN = 44 * 32;
    constexpr int NITEMS = I_WIN + I_WOA + 4 * I_SQ + 2 * I_UP + 2 * I_DN;
    for (int it = gw; it < NITEMS; it += ngw) {
        int r = it;
        if (r < I_WIN) { tr_mat(r, a.in[3], DM, NQKVA, (bf16*)(ws + WS_WIN), 0, norm_g + 0 * DM, 1, scr, lane); continue; } r -= I_WIN;
        if (r < I_WOA) { tr_mat(r, a.in[4], AW, DM, (bf16*)(ws + WS_WOA), 0, nullptr, 0, scr, lane); continue; } r -= I_WOA;
        if (r < I_SQ) { tr_mat(r, a.in[6], DM, DM, (bf16*)(ws + WS_WKVQ), 0, a.in[5], 0, scr, lane); continue; } r -= I_SQ;
        if (r < I_SQ) { tr_mat(r, a.in[7], DM, DM, (bf16*)(ws + WS_WKVQ), 1024, a.in[5], 0, scr, lane); continue; } r -= I_SQ;
        if (r < I_SQ) { tr_mat(r, a.in[8], DM, DM, (bf16*)(ws + WS_WKVQ), 2048, norm_g + 4 * DM, 2, scr, lane); continue; } r -= I_SQ;
        if (r < I_SQ) { tr_mat(r, a.in[14], DM, DM, (bf16*)(ws + WS_WOB), 0, nullptr, 0, scr, lane); continue; } r -= I_SQ;
        if (r < I_UP) { tr_mat(r, a.in[15], DM, NUP, (bf16*)(ws + WS_WUP0), 0, norm_g + 2 * DM, 3, scr, lane); continue; } r -= I_UP;
        if (r < I_UP) { tr_mat(r, a.in[15] + (size_t)DM * NUP, DM, NUP, (bf16*)(ws + WS_WUP1), 0, norm_g + 6 * DM, 3, scr, lane); continue; } r -= I_UP;
        if (r < I_DN) { tr_mat(r, a.in[18], FF, DM, (bf16*)(ws + WS_WDN0), 0, nullptr, 0, scr, lane); continue; } r -= I_DN;
        tr_mat(r, a.in[18] + (size_t)FF * DM, FF, DM, (bf16*)(ws + WS_WDN1), 0, nullptr, 0, scr, lane);
    }
    { float* par = (float*)(ws + WS_PAR); const int gt0 = gw * 64 + lane, ngt0 = ngw * 64;
      for (int i = gt0; i < PAR_END; i += ngt0) { float v;
        if (i < PAR_CONVW) v = a.in[2][i]; else if (i < PAR_CONVB) v = a.in[16][i - PAR_CONVW]; else if (i < PAR_LAM) v = a.in[17][i - PAR_CONVB];
        else if (i < PAR_SUBG) { const int k = i - PAR_LAM; v = a.in[9 + (k >> 6)][k & 63]; } else v = a.in[13][i - PAR_SUBG];
        par[i] = v; } }
    const float* table = a.in[1];
    float* tabB = (float*)(ws + WS_TABB); float* tabA = (float*)(ws + WS_TABA);
    const int gt = gw * 64 + lane, ngt = ngw * 64;
    for (int i = gt; i < 8 * TABB_STRIDE; i += ngt) { const int h = i / TABB_STRIDE, d = i % TABB_STRIDE - 64; tabB[i] = d < 0 ? 0.f : table[h * 32 + t5_bucket(d)] * LOG2E; }
    for (int i = gt; i < 3 * 8 * 132; i += ngt) { const int g = i / (8 * 132), h = (i / 132) % 8, du = i % 132; const int r = 1 << (2 * g);
        tabA[i] = du <= 128 ? table[h * 32 + t5_bucket(du * r)] * LOG2E : 0.f; }
    const float* x = a.in[0]; bf16* XN = (bf16*)(ws + WS_XN);
    for (int m = gw; m < TOK; m += ngw) {
        const f32x4* xr = (const f32x4*)(x + (size_t)m * DM) + lane; f32x4 v[4]; float s = 0.f;
#pragma unroll
        for (int j = 0; j < 4; ++j) { v[j] = xr[64 * j]; s += (v[j].x * v[j].x + v[j].y * v[j].y) + (v[j].z * v[j].z + v[j].w * v[j].w); }
        const float rs = 1.f / sqrtf(wave_sum(s) * (1.f / DM) + RMS_EPS);
        v2u* o8 = (v2u*)(XN + (size_t)m * DM) + lane;
#pragma unroll
        for (int j = 0; j < 4; ++j) { v2u w; w.x = pk2(v[j].x * rs, v[j].y * rs); w.y = pk2(v[j].z * rs, v[j].w * rs); o8[64 * j] = w; }
    }
}

__device__ __forceinline__ void rowpass(const bf16* mix, const float* g, const float* hin, float* hout, bf16* xn) {
    PHASE_IDS
    for (int m = gw; m < TOK; m += ngw) {
        const v2u* mr = (const v2u*)(mix + (size_t)m * DM) + lane; f32x4 v[4]; float s = 0.f;
#pragma unroll
        for (int j = 0; j < 4; ++j) { const v2u w = mr[64 * j]; v[j] = (f32x4){bflo(w.x), bfhi(w.x), bflo(w.y), bfhi(w.y)};
            s += (v[j].x * v[j].x + v[j].y * v[j].y) + (v[j].z * v[j].z + v[j].w * v[j].w); }
        const float rs = 1.f / sqrtf(wave_sum(s) * (1.f / DM) + RMS_EPS);
        const f32x4* gr = (const f32x4*)g + lane; const f32x4* hr = (const f32x4*)(hin + (size_t)m * DM) + lane; f32x4* ho = (f32x4*)(hout + (size_t)m * DM) + lane;
        float s2 = 0.f;
#pragma unroll
        for (int j = 0; j < 4; ++j) { const f32x4 gv = gr[64 * j], hv = hr[64 * j]; v[j] = hv + v[j] * rs * gv; ho[64 * j] = v[j];
            s2 += (v[j].x * v[j].x + v[j].y * v[j].y) + (v[j].z * v[j].z + v[j].w * v[j].w); }
        if (xn) {
            const float rs2 = 1.f / sqrtf(wave_sum(s2) * (1.f / DM) + RMS_EPS);
            v2u* o8 = (v2u*)(xn + (size_t)m * DM) + lane;
#pragma unroll
            for (int j = 0; j < 4; ++j) { v2u w; w.x = pk2(v[j].x * rs2, v[j].y * rs2); w.y = pk2(v[j].z * rs2, v[j].w * rs2); o8[64 * j] = w; }
        }
    }
}

__device__ __forceinline__ void ld8(const bf16* p, float* f) { const v4u w = *(const v4u*)p; f[0] = bflo(w.x); f[1] = bfhi(w.x); f[2] = bflo(w.y); f[3] = bfhi(w.y); f[4] = bflo(w.z); f[5] = bfhi(w.z); f[6] = bflo(w.w); f[7] = bfhi(w.w); }

namespace da {
typedef short bf16x8 __attribute__((ext_vector_type(8)));
typedef short s16x4 __attribute__((ext_vector_type(4)));
typedef short v4i16_t __attribute__((ext_vector_type(4)));
typedef float f32x16 __attribute__((ext_vector_type(16)));
typedef float f32x2_t __attribute__((ext_vector_type(2))); typedef __bf16 bf16x2_t __attribute__((ext_vector_type(2)));
constexpr int KBUF = 0, VBUF = 32768, TABL = 65536, TABL_FLOATS = 128 + SEQ, XCH = 0;
__device__ __forceinline__ unsigned cvtpk(float lo, float hi) { f32x2_t v = {lo, hi}; bf16x2_t b = __builtin_convertvector(v, bf16x2_t); return __builtin_bit_cast(unsigned, b); }
__device__ __forceinline__ s16x4 vtr(const LAS unsigned char* p) { return __builtin_bit_cast(s16x4, __builtin_amdgcn_ds_read_tr16_b64_v4i16((LAS v4i16_t*)p)); }
__device__ __forceinline__ float swapmax(float v) { auto rr = __builtin_amdgcn_permlane32_swap(__float_as_uint(v), __float_as_uint(v), false, false); return fmaxf(__uint_as_float(rr[0]), __uint_as_float(rr[1])); }
__device__ __forceinline__ float swapsum(float v) { auto rr = __builtin_amdgcn_permlane32_swap(__float_as_uint(v), __float_as_uint(v), false, false); return __uint_as_float(rr[0]) + __uint_as_float(rr[1]); }
#define DA_CST0(r) (((r) & 3) + 8 * ((r) >> 2))

__device__ __forceinline__ void diff_unit(int b, int h, int qblk, const bf16* kvq, float lam, const float* subg, bf16* Ob, LAS unsigned char* lds, int wave, int lane) {
    const int r32 = lane & 31, hi = lane >> 5, qt = wave >> 1, c = wave & 1;
    const int q0 = qblk * 128 + qt * 32, NT = 2 * qblk + 2;
    const size_t rowb = (size_t)b * SEQ;
    const LAS float* tabL = (const LAS float*)(lds + TABL);
    bf16x8 qf[4];
    { const bf16* qp = kvq + (rowb + q0 + r32) * NKVQ + 2048 + h * 128 + c * 64 + hi * 8;
#pragma unroll
      for (int d0 = 0; d0 < 4; ++d0) qf[d0] = *(const bf16x8*)(qp + 16 * d0); }
    const bf16* ksrc = kvq + (rowb + lane) * NKVQ + h * 128 + wave * 8;
    const bf16* vsrc = kvq + (rowb + 16 * (wave & 3) + (lane >> 2)) * NKVQ + 1024 + h * 128 + (wave >> 2) * 32 + (lane & 3) * 8;
    const int sdst = wave * 1024 + lane * 16;
    const LAS unsigned char* vb0 = lds + VBUF + ((lane >> 4) & 1) * 32 + (lane & 3) * 8 + (4 * hi + ((lane & 15) >> 2)) * 64;
    f32x16 o[4];
#pragma unroll
    for (int i = 0; i < 4; ++i)
#pragma unroll
        for (int r = 0; r < 16; ++r) o[i][r] = 0.f;
    float m = -INFINITY, l = 0.f;
    v4u kr0, kr1, vr0, vr1;
    kr0 = *(const v4u*)ksrc; kr1 = *(const v4u*)(ksrc + 64); vr0 = *(const v4u*)vsrc; vr1 = *(const v4u*)(vsrc + 64);
    *(LAS v4u*)(lds + KBUF + sdst) = kr0; *(LAS v4u*)(lds + KBUF + 8192 + sdst) = kr1; *(LAS v4u*)(lds + VBUF + sdst) = vr0; *(LAS v4u*)(lds + VBUF + 8192 + sdst) = vr1;
    __syncthreads();
#pragma unroll 1
    for (int kt = 0; kt < NT; ++kt) {
        const int buf = kt & 1; const bool more = kt + 1 < NT;
        if (more) { const size_t off = (size_t)(kt + 1) * 64 * NKVQ; kr0 = *(const v4u*)(ksrc + off); kr1 = *(const v4u*)(ksrc + off + 64); vr0 = *(const v4u*)(vsrc + off); vr1 = *(const v4u*)(vsrc + off + 64); }
        if (64 * kt <= q0 + 31) {
            f32x16 p0, p1;
#pragma unroll
            for (int r = 0; r < 16; ++r) { p0[r] = 0.f; p1[r] = 0.f; }
            const LAS unsigned char* kb = lds + KBUF + buf * 16384 + (8 * c + hi) * 1024 + r32 * 16;
#pragma unroll
            for (int d0 = 0; d0 < 4; ++d0) { const bf16x8 a0 = *(const LAS bf16x8*)(kb + d0 * 2048), a1 = *(const LAS bf16x8*)(kb + d0 * 2048 + 512);
                p0 = __builtin_amdgcn_mfma_f32_32x32x16_bf16(a0, qf[d0], p0, 0, 0, 0); p1 = __builtin_amdgcn_mfma_f32_32x32x16_bf16(a1, qf[d0], p1, 0, 0, 0); }
            const int idx0 = q0 + r32 - 64 * kt - 4 * hi;
            const LAS float* tb = tabL + (128 - 59) + idx0;
#pragma unroll
            for (int r = 0; r < 16; ++r) { p0[r] += tb[59 - DA_CST0(r)]; p1[r] += tb[27 - DA_CST0(r)]; }
            if (64 * kt + 63 > q0) {
#pragma unroll
                for (int r = 0; r < 16; ++r) { if (DA_CST0(r) > idx0) p0[r] = -INFINITY; if (32 + DA_CST0(r) > idx0) p1[r] = -INFINITY; }
            }
            float rm = fmaxf(p0[0], p1[0]);
#pragma unroll
            for (int r = 1; r < 16; ++r) rm = fmaxf(rm, fmaxf(p0[r], p1[r]));
            rm = swapmax(rm);
            const float mn = fmaxf(m, rm); const float al = __builtin_amdgcn_exp2f(m - mn); m = mn;
            float ls = 0.f;
#pragma unroll
            for (int r = 0; r < 16; ++r) { p0[r] = __builtin_amdgcn_exp2f(p0[r] - mn); p1[r] = __builtin_amdgcn_exp2f(p1[r] - mn); ls += p0[r] + p1[r]; }
            l = l * al + ls;
#pragma unroll
            for (int i = 0; i < 4; ++i)
#pragma unroll
                for (int r = 0; r < 16; ++r) o[i][r] *= al;
            v4u pw[4];
#pragma unroll
            for (int x = 0; x < 4; ++x) { pw[0][x] = cvtpk(p0[2 * x], p0[2 * x + 1]); pw[1][x] = cvtpk(p0[8 + 2 * x], p0[9 + 2 * x]); pw[2][x] = cvtpk(p1[2 * x], p1[2 * x + 1]); pw[3][x] = cvtpk(p1[8 + 2 * x], p1[9 + 2 * x]); }
            const LAS unsigned char* vb = vb0 + buf * 16384;
#pragma unroll
            for (int db = 0; db < 4; ++db)
#pragma unroll
                for (int ks = 0; ks < 4; ++ks) { const s16x4 lo = vtr(vb + db * 4096 + ks * 1024), hh = vtr(vb + db * 4096 + ks * 1024 + 512);
                    const bf16x8 vf = (bf16x8){lo[0], lo[1], lo[2], lo[3], hh[0], hh[1], hh[2], hh[3]};
                    o[db] = __builtin_amdgcn_mfma_f32_32x32x16_bf16(vf, __builtin_bit_cast(bf16x8, pw[ks]), o[db], 0, 0, 0); }
        }
        if (more) { const int nb = (buf ^ 1) * 16384; *(LAS v4u*)(lds + KBUF + nb + sdst) = kr0; *(LAS v4u*)(lds + KBUF + nb + 8192 + sdst) = kr1; *(LAS v4u*)(lds + VBUF + nb + sdst) = vr0; *(LAS v4u*)(lds + VBUF + nb + 8192 + sdst) = vr1; }
        __syncthreads();
    }
    const float il = 1.f / swapsum(l);
    LAS float* xch = (LAS float*)(lds + XCH) + (qt * 64) * 64 + lane;
    if (c == 1) {
#pragma unroll
        for (int i = 0; i < 4; ++i)
#pragma unroll
            for (int r = 0; r < 16; ++r) xch[(i * 16 + r) * 64] = o[i][r] * il;
    }
    __syncthreads();
    if (c == 0) {
        float ss = 0.f;
#pragma unroll
        for (int i = 0; i < 4; ++i)
#pragma unroll
            for (int r = 0; r < 16; ++r) { const float v = o[i][r] * il - lam * xch[(i * 16 + r) * 64]; o[i][r] = v; ss += v * v; }
        ss = swapsum(ss);
        const float rs = 1.f / sqrtf(ss * (1.f / 128.f) + SUBLN_EPS) * (1.f - LAMBDA_INIT);
        bf16* op = Ob + (rowb + q0 + r32) * DM + h * 128 + 4 * hi;
#pragma unroll
        for (int i = 0; i < 4; ++i)
#pragma unroll
            for (int rr = 0; rr < 4; ++rr) { const f32x4 sg = *(const f32x4*)(subg + 32 * i + 8 * rr + 4 * hi);
                v2u w; w.x = cvtpk(o[i][4 * rr] * rs * sg.x, o[i][4 * rr + 1] * rs * sg.y); w.y = cvtpk(o[i][4 * rr + 2] * rs * sg.z, o[i][4 * rr + 3] * rs * sg.w);
                *(v2u*)(op + 32 * i + 8 * rr) = w; }
    }
    __syncthreads();
}
}

__device__ __forceinline__ void diff_attn_phase(const bf16* kvq, const float* tabB, const float* par, bf16* Ob, LAS unsigned char* lds) {
    PHASE_IDS
    float lam;
    { const float* lp = par + PAR_LAM; const float p1 = lp[lane] * lp[64 + lane], p2 = lp[128 + lane] * lp[192 + lane]; lam = expf(wave_sum(p1)) - expf(wave_sum(p2)) + LAMBDA_INIT; }
    const float* subg = par + PAR_SUBG;
    const int bh = vcu_ >> 2, j = vcu_ & 3, b = bh >> 3, h = bh & 7;
    { LAS float* tabL = (LAS float*)(lds + da::TABL); const float* src = tabB + h * TABB_STRIDE;
      for (int i = tid_; i < da::TABL_FLOATS; i += NTHR) tabL[i] = i < 64 ? 0.f : src[i - 64]; }
    __syncthreads();
#pragma unroll 1
    for (int u = 0; u < 8; ++u) {
        const int base = 4 * (u >> 1) + j; const int qblk = (u & 1) ? 31 - base : base;
        da::diff_unit(b, h, qblk, kvq, lam, subg, Ob, lds, wave, lane);
    }
}

namespace dl {
using da::bf16x8; using da::s16x4; using da::f32x16; using da::cvtpk; using da::vtr; using da::swapmax; using da::swapsum;
constexpr int STAGE = 0, TAB = 32768;
__device__ __forceinline__ void task(int b, int h, int tb, int g, int ti, const bf16* qkv, bf16* Og, float* LSE, LAS unsigned char* lds, int wave, int lane) {
    const int r32 = lane & 31, hi = lane >> 5;
    const int sh = 2 * g;
    int c, m0;
    if (g == 0) { c = 0; m0 = tb * 512 + 32 * ti; } else if (g == 1) { c = ti & 3; m0 = tb * 128 + 32 * (ti >> 2); } else { c = ti; m0 = tb * 32; }
    const size_t rowb = (size_t)b * SEQ;
    const int gcol = g * 1536 + h * 64;
    const int qtok = ((m0 + r32) << sh) + c;
    bf16x8 qf[4];
    { const bf16* qp = qkv + (rowb + qtok) * NQKVA + gcol + hi * 8;
#pragma unroll
      for (int d0 = 0; d0 < 4; ++d0) qf[d0] = *(const bf16x8*)(qp + 16 * d0); }
    const int jmin = (m0 >= 128) ? 0 : 4 - (m0 >> 5);
    f32x16 o[2];
#pragma unroll
    for (int i = 0; i < 2; ++i)
#pragma unroll
        for (int r = 0; r < 16; ++r) o[i][r] = 0.f;
    float m = -INFINITY, l = 0.f;
    LAS unsigned char* stg = lds + STAGE + wave * 4096;
    const LAS unsigned char* vb = stg + ((lane >> 4) & 1) * 32 + (lane & 3) * 8 + (4 * hi + ((lane & 15) >> 2)) * 64;
    const LAS float* tab = (const LAS float*)(lds + TAB) + g * 132;
    const bf16* kbase = qkv + rowb * NQKVA + gcol + 512 + hi * 8;
    const bf16* vbase = qkv + rowb * NQKVA + gcol + 1024 + (lane & 3) * 8;
    bf16x8 kn[4]; v4u vn[4];
#define DL_LOAD(j) do { const int ku0_ = m0 - 128 + 32 * (j); const bf16* kp_ = kbase + (size_t)(((ku0_ + r32) << sh) + c) * NQKVA; \
        _Pragma("unroll") for (int d0 = 0; d0 < 4; ++d0) kn[d0] = *(const bf16x8*)(kp_ + 16 * d0); \
        _Pragma("unroll") for (int i = 0; i < 4; ++i) vn[i] = *(const v4u*)(vbase + (size_t)(((ku0_ + 16 * (i & 1) + (lane >> 2)) << sh) + c) * NQKVA + 32 * (i >> 1)); } while (0)
    DL_LOAD(jmin);
#pragma unroll 1
    for (int j = jmin; j <= 4; ++j) {
        bf16x8 kf[4]; v4u vv[4];
#pragma unroll
        for (int i = 0; i < 4; ++i) { kf[i] = kn[i]; vv[i] = vn[i]; }
        if (j < 4) DL_LOAD(j + 1);
        f32x16 p;
#pragma unroll
        for (int r = 0; r < 16; ++r) p[r] = 0.f;
#pragma unroll
        for (int d0 = 0; d0 < 4; ++d0) p = __builtin_amdgcn_mfma_f32_32x32x16_bf16(kf[d0], qf[d0], p, 0, 0, 0);
        const int du0 = 128 - 32 * j + r32 - 4 * hi;
        const LAS float* tb = tab + du0 - 27;
#pragma unroll
        for (int r = 0; r < 16; ++r) p[r] += tb[27 - DA_CST0(r)];
        if (j == 0 || j == 4) {
#pragma unroll
            for (int r = 0; r < 16; ++r) { const int du = du0 - DA_CST0(r); if (du < 0 || du > 128) p[r] = -INFINITY; }
        }
        float rm = p[0];
#pragma unroll
        for (int r = 1; r < 16; ++r) rm = fmaxf(rm, p[r]);
        rm = swapmax(rm);
        const float mn = fmaxf(m, rm); const float al = __builtin_amdgcn_exp2f(m - mn); m = mn;
        float ls = 0.f;
#pragma unroll
        for (int r = 0; r < 16; ++r) { p[r] = __builtin_amdgcn_exp2f(p[r] - mn); ls += p[r]; }
        l = l * al + ls;
#pragma unroll
        for (int i = 0; i < 2; ++i)
#pragma unroll
            for (int r = 0; r < 16; ++r) o[i][r] *= al;
        v4u pw[2];
#pragma unroll
        for (int x = 0; x < 4; ++x) { pw[0][x] = cvtpk(p[2 * x], p[2 * x + 1]); pw[1][x] = cvtpk(p[8 + 2 * x], p[9 + 2 * x]); }
#pragma unroll
        for (int i = 0; i < 4; ++i) *(LAS v4u*)(stg + i * 1024 + lane * 16) = vv[i];
#pragma unroll
        for (int db = 0; db < 2; ++db)
#pragma unroll
            for (int ks = 0; ks < 2; ++ks) { const s16x4 lo = vtr(vb + (db * 2 + ks) * 1024), hh = vtr(vb + (db * 2 + ks) * 1024 + 512);
                const bf16x8 vf = (bf16x8){lo[0], lo[1], lo[2], lo[3], hh[0], hh[1], hh[2], hh[3]};
                o[db] = __builtin_amdgcn_mfma_f32_32x32x16_bf16(vf, __builtin_bit_cast(bf16x8, pw[ks]), o[db], 0, 0, 0); }
    }
#undef DL_LOAD
    const float lt = swapsum(l); const float il = 1.f / lt;
    bf16* op = Og + ((size_t)g * TOK + rowb + qtok) * AW + h * 64 + 4 * hi;
#pragma unroll
    for (int i = 0; i < 2; ++i)
#pragma unroll
        for (int rr = 0; rr < 4; ++rr) { v2u w; w.x = cvtpk(o[i][4 * rr] * il, o[i][4 * rr + 1] * il); w.y = cvtpk(o[i][4 * rr + 2] * il, o[i][4 * rr + 3] * il); *(v2u*)(op + 32 * i + 8 * rr) = w; }
    if (hi == 0) LSE[((size_t)g * TOK + rowb + qtok) * 8 + h] = m + __builtin_amdgcn_logf(lt);
}
}

__device__ __forceinline__ void dilated_attn_phase(const bf16* qkv, const float* tabA, bf16* Og, float* LSE, bf16* Oa, LAS unsigned char* lds) {
    PHASE_IDS
#pragma unroll 1
    for (int unit = vcu_; unit < 512; unit += G_) {
        const int b = unit >> 6, h = (unit >> 3) & 7, tb = unit & 7;
        { LAS float* tl = (LAS float*)(lds + dl::TAB); for (int i = tid_; i < 3 * 132; i += NTHR) tl[i] = tabA[((i / 132) * 8 + h) * 132 + (i % 132)]; }
        __syncthreads();
#pragma unroll 1
        for (int i = 0; i < 6; ++i) { const int t = wave + 8 * i; dl::task(b, h, tb, t >> 4, t & 15, qkv, Og, LSE, lds, wave, lane); }
        __threadfence(); __syncthreads(); __threadfence();
        const size_t tok0 = (size_t)b * SEQ + tb * 512;
#pragma unroll 1
        for (int it = tid_; it < 4096; it += NTHR) { const int tk = it >> 3, ch = it & 7; const size_t tok = tok0 + tk;
            const float l0 = LSE[tok * 8 + h], l1 = LSE[((size_t)TOK + tok) * 8 + h], l2 = LSE[((size_t)2 * TOK + tok) * 8 + h];
            const float mx = fmaxf(l0, fmaxf(l1, l2)); float a0 = __builtin_amdgcn_exp2f(l0 - mx), a1 = __builtin_amdgcn_exp2f(l1 - mx), a2 = __builtin_amdgcn_exp2f(l2 - mx);
            const float inv = 1.f / (a0 + a1 + a2); a0 *= inv; a1 *= inv; a2 *= inv;
            float f0[8], f1[8], f2[8]; ld8(Og + tok * AW + h * 64 + ch * 8, f0); ld8(Og + ((size_t)TOK + tok) * AW + h * 64 + ch * 8, f1); ld8(Og + ((size_t)2 * TOK + tok) * AW + h * 64 + ch * 8, f2);
            float r8[8];
#pragma unroll
            for (int e = 0; e < 8; ++e) r8[e] = a0 * f0[e] + a1 * f1[e] + a2 * f2[e];
            v4u w; w.x = pk2(r8[0], r8[1]); w.y = pk2(r8[2], r8[3]); w.z = pk2(r8[4], r8[5]); w.w = pk2(r8[6], r8[7]);
            *(v4u*)(Oa + tok * AW + h * 64 + ch * 8) = w; }
        __syncthreads();
    }
}

__device__ __forceinline__ float dpp_ror1(float v) { return __builtin_bit_cast(float, __builtin_amdgcn_update_dpp(0, __builtin_bit_cast(int, v), 0x121, 0xf, 0xf, false)); }
__device__ __forceinline__ float dpp_ror2(float v) { return __builtin_bit_cast(float, __builtin_amdgcn_update_dpp(0, __builtin_bit_cast(int, v), 0x122, 0xf, 0xf, false)); }
struct EpiConvGate {
    static constexpr bool PERM = true, AFTER_DRAIN = false, AMAP = true;
    bf16* gated; float* part; float* last; const float* cw; const float* cb;
    __device__ __forceinline__ void operator()(const pg8::f32x4 (&acc)[2][2][4][2], const pg8::Unit& u, int wr, int wc, int fr, int fq) const {
        typedef pg8::f32x4 f4;
        const int blk = u.pm * 2 + wr; const size_t row0 = (size_t)blk * 128;
        const bool is15 = fr == 15, ge14 = fr >= 14;
#pragma unroll
        for (int n = 0; n < 2; ++n) {
            const int j0 = u.pn * 128 + wc * 32 + 8 * fq + 4 * n;
            f4 w[2][3], bb[2];
#pragma unroll
            for (int bj = 0; bj < 2; ++bj) { bb[bj] = *(const f4*)(cb + bj * FF + j0);
#pragma unroll
                for (int jj = 0; jj < 3; ++jj) w[bj][jj] = *(const f4*)(cw + jj * NUP + bj * FF + j0); }
            f4 pv[2] = {(f4){0.f, 0.f, 0.f, 0.f}, (f4){0.f, 0.f, 0.f, 0.f}};
#pragma unroll
            for (int ai = 0; ai < 2; ++ai)
#pragma unroll
                for (int m = 0; m < 4; ++m) {
                    f4 c[2];
#pragma unroll
                    for (int bj = 0; bj < 2; ++bj) { const f4 cur = acc[ai][bj][m][n]; f4 s1, s2;
#pragma unroll
                        for (int e = 0; e < 4; ++e) { s1[e] = dpp_ror1(is15 ? pv[bj][e] : cur[e]); s2[e] = dpp_ror2(ge14 ? pv[bj][e] : cur[e]); }
                        c[bj] = bb[bj] + w[bj][2] * cur + w[bj][1] * s1 + w[bj][0] * s2; pv[bj] = cur; }
                    if (ai == 0 && m == 0 && fr < 2) {
#pragma unroll
                        for (int bj = 0; bj < 2; ++bj) *(f4*)(part + ((size_t)blk * 2 + fr) * NUP + bj * FF + j0) = c[bj];
                    } else {
                        const pg8::f32x2 ga = pg8::gelu_pk((pg8::f32x2){c[0][0], c[0][1]}), gb = pg8::gelu_pk((pg8::f32x2){c[0][2], c[0][3]});
                        v2u o; o.x = pg8::cvt_pk_bf16(ga.x * c[1][0], ga.y * c[1][1]); o.y = pg8::cvt_pk_bf16(gb.x * c[1][2], gb.y * c[1][3]);
                        *(v2u*)(gated + (row0 + 64 * ai + 16 * m + fr) * FF + j0) = o;
                    }
                    if (ai == 1 && m == 3 && ge14) {
#pragma unroll
                        for (int bj = 0; bj < 2; ++bj) *(f4*)(last + ((size_t)blk * 2 + (fr - 14)) * NUP + bj * FF + j0) = acc[1][bj][3][n];
                    }
                }
        }
    }
};
__device__ __forceinline__ void conv_fixup(const float* part, const float* last, const float* cw, bf16* gated) {
    PHASE_IDS
    for (int it = gtid; it < 256 * 2 * 352; it += gstride) {
        const int j = (it % 352) * 8, rho = (it / 352) & 1, blk = it / 704;
        float cg[8], cv[8];
        { const float* pp = part + ((size_t)blk * 2 + rho) * NUP + j;
#pragma unroll
          for (int e = 0; e < 8; ++e) { cg[e] = pp[e]; cv[e] = pp[FF + e]; } }
        if (blk & 31) {
            const float* l0 = last + ((size_t)(blk - 1) * 2) * NUP + j; const float* l1 = l0 + NUP;
#pragma unroll
            for (int e = 0; e < 8; ++e) {
                if (rho == 0) { cg[e] += cw[NUP + j + e] * l1[e] + cw[j + e] * l0[e]; cv[e] += cw[NUP + FF + j + e] * l1[FF + e] + cw[FF + j + e] * l0[FF + e]; }
                else { cg[e] += cw[j + e] * l1[e]; cv[e] += cw[FF + j + e] * l1[FF + e]; } }
        }
        float r[8];
#pragma unroll
        for (int e = 0; e < 8; e += 2) { const pg8::f32x2 g2 = pg8::gelu_pk((pg8::f32x2){cg[e], cg[e + 1]}); r[e] = g2.x * cv[e]; r[e + 1] = g2.y * cv[e + 1]; }
        v4u w; w.x = pk2(r[0], r[1]); w.y = pk2(r[2], r[3]); w.z = pk2(r[4], r[5]); w.w = pk2(r[6], r[7]);
        *(v4u*)(gated + ((size_t)blk * 128 + rho) * FF + j) = w;
    }
}

namespace cg = cooperative_groups;
#define GEMM_PHASE(A_, B_, M_, N_, K_, O_, LDC_) do { pg8::Gemm g{(const bf16*)(A_), (const bf16*)(B_), M_, N_, K_}; pg8::StaticOrder S; S.init(M_, N_, (int)gridDim.x, (int)blockIdx.x); \
    pg8::EpiBf16<0> E{(bf16*)(O_), LDC_, nullptr, 0, 0, 1.f}; pg8::gemm_phase<pg8::EpiBf16<0>, pg8::StaticOrder, PG8_ALIGN, PG8_SP2>(lds, g, S, E); } while (0)
__global__ void __launch_bounds__(NTHR, 2) fwd(Args a) {
    extern __shared__ __attribute__((aligned(16))) unsigned char lds_raw[];
    LAS unsigned char* lds = (LAS unsigned char*)lds_raw;
    cg::grid_group grid = cg::this_grid();
    unsigned char* ws = a.ws;
    prologue(a, lds); grid.sync();
    const float* xin = a.in[0]; float* out = a.out;
#define WSP(T, off) ((T*)(ws + (off)))
#define PARP(off) (WSP(const float, WS_PAR) + (off))
    GEMM_PHASE(WSP(bf16, WS_XN), ws + WS_WIN, TOK, NQKVA, DM, WSP(bf16, WS_BIG), NQKVA); grid.sync();
    dilated_attn_phase(WSP(const bf16, WS_BIG), WSP(const float, WS_TABA), WSP(bf16, 416 * MiB), WSP(float, 64 * MiB), WSP(bf16, 68 * MiB), lds); grid.sync();
    GEMM_PHASE(WSP(bf16, 68 * MiB), ws + WS_WOA, TOK, DM, AW, WSP(bf16, WS_MIX), DM); grid.sync();
    rowpass(WSP(const bf16, WS_MIX), PARP(PAR_NORMG + 1 * DM), xin, out, WSP(bf16, WS_XN)); grid.sync();
#pragma unroll 1
    for (int lay = 0; lay < 2; ++lay) {
        if (lay == 1) {
            GEMM_PHASE(WSP(bf16, WS_XN), ws + WS_WKVQ, TOK, NKVQ, DM, WSP(bf16, WS_BIG), NKVQ); grid.sync();
            diff_attn_phase(WSP(const bf16, WS_BIG), WSP(const float, WS_TABB), PARP(0), WSP(bf16, 320 * MiB), lds); grid.sync();
            GEMM_PHASE(WSP(bf16, 320 * MiB), ws + WS_WOB, TOK, DM, DM, WSP(bf16, WS_MIX), DM); grid.sync();
            rowpass(WSP(const bf16, WS_MIX), PARP(PAR_NORMG + 5 * DM), out, out, WSP(bf16, WS_XN)); grid.sync();
        }
        { pg8::Gemm g{WSP(const bf16, WS_XN), (const bf16*)(ws + (lay ? WS_WUP1 : WS_WUP0)), TOK, NUP, DM}; pg8::StaticOrder S; S.init(TOK, NUP, (int)gridDim.x, (int)blockIdx.x);
          EpiConvGate E{WSP(bf16, WS_GATED), WSP(float, WS_PART), WSP(float, WS_LAST), PARP(PAR_CONVW + lay * 3 * NUP), PARP(PAR_CONVB + lay * NUP)};
          pg8::gemm_phase<EpiConvGate, pg8::StaticOrder, PG8_ALIGN, PG8_SP2>(lds, g, S, E); }
        grid.sync();
        conv_fixup(WSP(const float, WS_PART), WSP(const float, WS_LAST), PARP(PAR_CONVW + lay * 3 * NUP), WSP(bf16, WS_GATED)); grid.sync();
        GEMM_PHASE(WSP(bf16, WS_GATED), ws + (lay ? WS_WDN1 : WS_WDN0), TOK, DM, FF, WSP(bf16, WS_MIX), DM); grid.sync();
        rowpass(WSP(const bf16, WS_MIX), PARP(PAR_NORMG + (lay * 4 + 3) * DM), out, out, lay == 0 ? WSP(bf16, WS_XN) : (bf16*)nullptr);
        if (lay == 0) grid.sync();
    }
}

extern "C" void kernel_launch(void* const* d_in, const int* in_sizes, int n_in, void* d_out, int out_size, void* d_ws, size_t ws_size, hipStream_t stream) {
    static int grid = 0;
    if (grid == 0) {
        if (n_in != 19 || in_sizes[0] != TOK * DM || out_size != TOK * DM || ws_size < WS_END) {
            fprintf(stderr, "kernel_launch: unexpected shapes: n_in %d in0 %d out %d ws %zu (need %zu)\n", n_in, n_in > 0 ? in_sizes[0] : -1, out_size, ws_size, (size_t)WS_END); grid = -1; return; }
        int dev = 0, cus = 0, per_cu = 0;
        if (hipGetDevice(&dev) != hipSuccess || hipDeviceGetAttribute(&cus, hipDeviceAttributeMultiprocessorCount, dev) != hipSuccess) { grid = -1; return; }
        if (hipFuncSetAttribute((const void*)fwd, hipFuncAttributeMaxDynamicSharedMemorySize, LDS_BYTES) != hipSuccess) { fprintf(stderr, "kernel_launch: hipFuncSetAttribute failed\n"); grid = -1; return; }
        if (hipOccupancyMaxActiveBlocksPerMultiprocessor(&per_cu, (const void*)fwd, NTHR, LDS_BYTES) != hipSuccess || per_cu < 1) { fprintf(stderr, "kernel_launch: occupancy query says %d blocks/CU\n", per_cu); grid = -1; return; }
        grid = cus;
    }
    if (grid < 0) return;
    Args a{};
    for (int i = 0; i < 19; ++i) a.in[i] = (const float*)d_in[i];
    a.out = (float*)d_out; a.ws = (unsigned char*)d_ws;
    void* args[] = {&a};
    hipError_t e = hipLaunchCooperativeKernel((const void*)fwd, dim3(grid), dim3(NTHR), args, LDS_BYTES, stream);
    if (e != hipSuccess) fprintf(stderr, "cooperative launch failed: %s (grid %d)\n", hipGetErrorString(e), grid);
}
```

```cpp
#include <hip/hip_runtime.h>
#include <hip/hip_cooperative_groups.h>
#include <cstdio>
#include <cstdint>
namespace pg8 {
#define PG8_LAS __attribute__((address_space(3)))
typedef unsigned short bf16_t;
typedef short bf16x8 __attribute__((ext_vector_type(8)));
typedef float f32x4 __attribute__((ext_vector_type(4)));
typedef unsigned u32x4 __attribute__((ext_vector_type(4)));
constexpr int BM = 256, BK = 64, HALF = 128, HTB = HALF * BK * 2  , STAGE_BYTES = 8 * HTB, NXCD = 8, WGM = 8;

__host__ __device__ __forceinline__ int lds_byte(int r, int c) { const int st = (r >> 4) * 2 + (c >> 5), rr = r & 15, cc = c & 31, ob = rr * 64 + cc * 2; return st * 1024 + (ob ^ (((ob >> 9) & 1) << 5)); }
__host__ __device__ __forceinline__ void stage_rc(int b, int& R, int& C) { const int st = b / 1024, sb = b % 1024, swz = sb ^ (((sb >> 9) & 1) << 5); R = (st >> 1) * 16 + swz / 64; C = (st & 1) * 32 + (swz % 64) / 2; }
__host__ __device__ __forceinline__ int perm32(int rho) { const int n = rho >> 4, i = rho & 15; return 8 * (i >> 2) + 4 * n + (i & 3); }

struct Unit { int pm, pn; };
struct Gemm { const bf16_t* A; const bf16_t* Bt; int M, N, K; };

struct StaticOrder {
    int nM, nN, nwg, G, c;
    __host__ __device__ void init(int M, int N, int G_, int c_) { nM = M / BM; nN = N / BM; nwg = nM * nN; G = G_; c = c_; }
    __host__ __device__ bool next(int i, Unit& u) const {
        const long L = (long)i * G + c; if (L >= nwg) return false;
        int wgid = (int)L; { const int q = nwg / NXCD, r = nwg % NXCD, xcd = wgid % NXCD, off = wgid / NXCD; wgid = (xcd < r ? xcd * (q + 1) : r * (q + 1) + (xcd - r) * q) + off; }
        const int nig = WGM * nN, gid = wgid / nig, fm = gid * WGM, gsz = (nM - fm) < WGM ? (nM - fm) : WGM;
        u.pm = fm + ((wgid % nig) % gsz); u.pn = (wgid % nig) / gsz; return true;
    }
    __device__ __forceinline__ void a_ready(const Unit&) const {}
    __device__ __forceinline__ void done(const Unit&) const {}
};

__device__ __forceinline__ unsigned cvt_pk_bf16(float lo, float hi) { unsigned r; asm volatile("v_cvt_pk_bf16_f32 %0, %1, %2" : "=v"(r) : "v"(lo), "v"(hi)); return r; }
typedef float f32x2 __attribute__((ext_vector_type(2)));
__device__ __forceinline__ f32x2 gelu_pk(f32x2 v) {
    const f32x2 av = __builtin_elementwise_abs(v), d = av * 0.2316418882f + 1.0f;
    f32x2 t; t.x = __builtin_amdgcn_rcpf(d.x); t.y = __builtin_amdgcn_rcpf(d.y);
    f32x2 q = t * 0.5307027145f + (-0.7265760135f); q = q * t + 0.7107068705f; q = q * t + (-0.142248368f); q = q * t + 0.127414796f; q = q * t;
    const f32x2 s = (v * v) * (-0.72134752044f);
    f32x2 e; e.x = __builtin_amdgcn_exp2f(s.x); e.y = __builtin_amdgcn_exp2f(s.y);
    const f32x2 m = v * (q * e), r = v - m;
    f32x2 o; o.x = v.x < 0.f ? m.x : r.x; o.y = v.y < 0.f ? m.y : r.y; return o;
}

template <int ACT  > struct EpiBf16 {
    static constexpr bool PERM = true, AFTER_DRAIN = false, AMAP = false; static_assert(ACT == 0 || ACT == 1, "EpiBf16: ACT is 0 (none) or 1 (gelu_pk)");
    bf16_t* O; int ldc; const float* bias; int split_cols; size_t split_stride; float scale0;
    __device__ __forceinline__ void operator()(const f32x4 (&acc)[2][2][4][2], const Unit& u, int wr, int wc, int fr, int fq) const {
        const int row0 = u.pm * BM + wr * 64 + fr; int colt = u.pn * BM; bf16_t* base = O;
        float sc = 1.f; if (split_cols) { const int t = colt / split_cols; base += (size_t)t * split_stride; colt -= t * split_cols; if (t == 0) sc = scale0; }
        const int col0 = colt + wc * 32 + 8 * fq, bcol0 = u.pn * BM + wc * 32 + 8 * fq;
        f32x4 bv[2][2];
#pragma unroll
        for (int bj = 0; bj < 2; ++bj)
#pragma unroll
            for (int n = 0; n < 2; ++n) bv[bj][n] = bias ? *(const f32x4*)(bias + bcol0 + bj * HALF + 4 * n) : (f32x4){0.f, 0.f, 0.f, 0.f};
#pragma unroll
        for (int ai = 0; ai < 2; ++ai)
#pragma unroll
            for (int m = 0; m < 4; ++m) { bf16_t* rowp = base + (size_t)(row0 + ai * HALF + m * 16) * ldc + col0;
#pragma unroll
                for (int bj = 0; bj < 2; ++bj) { f32x4 v0 = acc[ai][bj][m][0] + bv[bj][0], v1 = acc[ai][bj][m][1] + bv[bj][1];
                    if (ACT == 1) { f32x2 a = gelu_pk((f32x2){v0[0], v0[1]}), b = gelu_pk((f32x2){v0[2], v0[3]}), c = gelu_pk((f32x2){v1[0], v1[1]}), d = gelu_pk((f32x2){v1[2], v1[3]});
                        v0 = (f32x4){a.x, a.y, b.x, b.y}; v1 = (f32x4){c.x, c.y, d.x, d.y}; }
                    v0 = v0 * sc; v1 = v1 * sc; u32x4 w; w.x = cvt_pk_bf16(v0[0], v0[1]); w.y = cvt_pk_bf16(v0[2], v0[3]); w.z = cvt_pk_bf16(v1[0], v1[1]); w.w = cvt_pk_bf16(v1[2], v1[3]);
                    *(u32x4*)(rowp + bj * HALF) = w; } }
    }
};
template <class Epi, class Sched, bool ALIGN_EPI = false, bool SP2 = false>
__device__ __forceinline__ void gemm_phase(PG8_LAS unsigned char* lds, const Gemm g, const Sched& S, const Epi& E) {
    int tid_l = threadIdx.x; asm volatile("" : "+v"(tid_l));
    const int tid = tid_l, wid = __builtin_amdgcn_readfirstlane(tid >> 6), lane = tid & 63, wr = wid >> 2, wc = wid & 3, fr = lane & 15, fq = lane >> 4;
    const int K = g.K, nt = K / BK;
    unsigned voffA[2], voffB[2];
#pragma unroll
    for (int i = 0; i < 2; ++i) { int R, C; stage_rc(tid * 16 + i * 8192, R, C); const int Rb = Epi::PERM ? ((R & ~31) + perm32(R & 31)) : R;
        const int Ra = Epi::AMAP ? (128 * (R >> 6) + (R & 63)) : R;
        voffA[i] = (unsigned)(Ra * K + C) * 2u; voffB[i] = (unsigned)(Rb * K + C) * 2u; }
    const size_t kstep = (size_t)(BK * 2);
    const size_t hstep = (size_t)HALF * K * 2;
    const size_t hstepA = Epi::AMAP ? (size_t)64 * K * 2 : hstep;
    const size_t tstep = 2 * hstep;
    const unsigned ldsw = (unsigned)wid * 1024u;
    const int aoff = lds_byte(wr * 64 + fr, fq * 8), boff = lds_byte(wc * 32 + fr, fq * 8);
#define PG8_SA(b, h) (((b) * 2 + (h)) * HTB)
#define PG8_SB(b, h) ((4 + (b) * 2 + (h)) * HTB)
#define PG8_STAGE(bufoff, gbase, voff) do { _Pragma("unroll") for (int _i = 0; _i < 2; ++_i) \
        __builtin_amdgcn_global_load_lds((const unsigned*)((const char*)(gbase) + (voff)[_i]), (PG8_LAS unsigned*)(lds + (bufoff) + ldsw + _i * 8192), 16, 0, 0); } while (0)
#define PG8_LDA(dst, b, h) do { _Pragma("unroll") for (int m = 0; m < 4; ++m) _Pragma("unroll") for (int k = 0; k < 2; ++k) dst[m][k] = *(const PG8_LAS bf16x8*)(lds + PG8_SA(b, h) + aoff + m * 2048 + k * 1024); } while (0)
#define PG8_LDB(dst, b, h) do { _Pragma("unroll") for (int n = 0; n < 2; ++n) _Pragma("unroll") for (int k = 0; k < 2; ++k) dst[n][k] = *(const PG8_LAS bf16x8*)(lds + PG8_SB(b, h) + boff + n * 2048 + k * 1024); } while (0)
#define PG8_MMA(ai, bj, At, Bt) do { __builtin_amdgcn_s_setprio(1); _Pragma("unroll") for (int m = 0; m < 4; ++m) _Pragma("unroll") for (int n = 0; n < 2; ++n) _Pragma("unroll") for (int k = 0; k < 2; ++k) \
        acc[ai][bj][m][n] = __builtin_amdgcn_mfma_f32_16x16x32_bf16(Bt[n][k], At[m][k], acc[ai][bj][m][n], 0, 0, 0); __builtin_amdgcn_s_setprio(0); } while (0)
#define PG8_WAIT_V(n) asm volatile("s_waitcnt vmcnt(" #n ")" ::: "memory")
#define PG8_WAIT_L(n) asm volatile("s_waitcnt lgkmcnt(" #n ")" ::: "memory")
#define PG8_BAR __builtin_amdgcn_s_barrier()
#define PG8_SCHED __builtin_amdgcn_sched_barrier(0)
    Unit cur, nxt; int ui = 0;
    if (!S.next(0, cur)) return;
    f32x4 acc[2][2][4][2];
#pragma unroll
    for (int a = 0; a < 2; ++a)
#pragma unroll
        for (int b = 0; b < 2; ++b)
#pragma unroll
            for (int m = 0; m < 4; ++m)
#pragma unroll
                for (int n = 0; n < 2; ++n) acc[a][b][m][n] = (f32x4){0.f, 0.f, 0.f, 0.f};
    bf16x8 At[4][2], B0[2][2], B1[2][2];
    const char* cA = (const char*)g.A + (size_t)cur.pm * tstep; const char* cB = (const char*)g.Bt + (size_t)cur.pn * tstep;
    S.a_ready(cur);
    if constexpr (SP2) {
        PG8_STAGE(PG8_SB(0, 0), cB, voffB); PG8_STAGE(PG8_SB(0, 1), cB + hstep, voffB); PG8_STAGE(PG8_SA(0, 0), cA, voffA); PG8_STAGE(PG8_SA(0, 1), cA + hstepA, voffA);
        if (wr == 1) PG8_BAR;
        PG8_WAIT_V(2); PG8_BAR;
        PG8_STAGE(PG8_SB(1, 0), cB + kstep, voffB); PG8_STAGE(PG8_SA(1, 0), cA + kstep, voffA); PG8_STAGE(PG8_SB(1, 1), cB + hstep + kstep, voffB);
        PG8_WAIT_V(6); PG8_BAR;
    } else {
        PG8_STAGE(PG8_SB(0, 0), cB, voffB); PG8_STAGE(PG8_SA(0, 0), cA, voffA); PG8_STAGE(PG8_SB(0, 1), cB + hstep, voffB); PG8_STAGE(PG8_SA(0, 1), cA + hstepA, voffA);
        if (wr == 1) PG8_BAR;
        PG8_WAIT_V(4); PG8_BAR;
        PG8_STAGE(PG8_SB(1, 0), cB + kstep, voffB); PG8_STAGE(PG8_SA(1, 0), cA + kstep, voffA); PG8_STAGE(PG8_SB(1, 1), cB + hstep + kstep, voffB);
        PG8_WAIT_V(6); PG8_BAR;
    }
    for (;;) {
        const bool has_next = S.next(ui + 1, nxt);
        const char* nA = has_next ? (const char*)g.A + (size_t)nxt.pm * tstep : cA; const char* nB = has_next ? (const char*)g.Bt + (size_t)nxt.pn * tstep : cB;
        for (int t = 0; t < nt; t += 2) {
            const bool last = (t == nt - 2);
            const char* a1 = cA + (size_t)(t + 1) * kstep;
            const char* a2 = last ? nA : cA + (size_t)(t + 2) * kstep; const char* b2 = last ? nB : cB + (size_t)(t + 2) * kstep;
            const char* a3 = a2 + kstep; const char* b3 = b2 + kstep;
            if (last && has_next) S.a_ready(nxt);
            if constexpr (SP2) {
            PG8_LDB(B0, 0, 0); PG8_LDB(B1, 0, 1); PG8_SCHED; PG8_LDA(At, 0, 0); PG8_STAGE(PG8_SA(1, 1), a1 + hstepA, voffA);
            PG8_WAIT_V(8); PG8_WAIT_L(0); PG8_BAR; PG8_MMA(0, 0, At, B0); PG8_MMA(0, 1, At, B1); PG8_BAR; PG8_SCHED;
            PG8_LDA(At, 0, 1); PG8_STAGE(PG8_SB(0, 0), b2, voffB); PG8_STAGE(PG8_SB(0, 1), b2 + hstep, voffB); PG8_STAGE(PG8_SA(0, 0), a2, voffA);
            PG8_WAIT_V(8); PG8_WAIT_L(0); PG8_BAR; PG8_MMA(1, 0, At, B0); PG8_MMA(1, 1, At, B1); PG8_BAR; PG8_SCHED;
            PG8_LDB(B0, 1, 0); PG8_LDB(B1, 1, 1); PG8_SCHED; PG8_LDA(At, 1, 0); PG8_STAGE(PG8_SA(0, 1), a2 + hstepA, voffA);
            PG8_WAIT_V(8); PG8_WAIT_L(0); PG8_BAR; PG8_MMA(0, 0, At, B0); PG8_MMA(0, 1, At, B1); PG8_BAR; PG8_SCHED;
            PG8_LDA(At, 1, 1); PG8_STAGE(PG8_SB(1, 0), b3, voffB); PG8_STAGE(PG8_SB(1, 1), b3 + hstep, voffB); PG8_STAGE(PG8_SA(1, 0), a3, voffA);
            PG8_WAIT_V(8); PG8_WAIT_L(0); PG8_BAR; PG8_MMA(1, 0, At, B0); PG8_MMA(1, 1, At, B1); PG8_BAR; PG8_SCHED;
            } else {
            PG8_LDB(B0, 0, 0); PG8_SCHED; PG8_LDA(At, 0, 0); PG8_STAGE(PG8_SA(1, 1), a1 + hstepA, voffA);
            PG8_WAIT_L(8); PG8_BAR; PG8_WAIT_L(0); PG8_MMA(0, 0, At, B0); PG8_BAR; PG8_SCHED;
            PG8_LDB(B1, 0, 1); PG8_STAGE(PG8_SB(0, 0), b2, voffB);
            PG8_BAR; PG8_WAIT_L(0); PG8_MMA(0, 1, At, B1); PG8_BAR;
            PG8_LDA(At, 0, 1); PG8_STAGE(PG8_SA(0, 0), a2, voffA);
            PG8_BAR; PG8_WAIT_L(0); PG8_MMA(1, 0, At, B0); PG8_BAR; PG8_SCHED;
            PG8_STAGE(PG8_SB(0, 1), b2 + hstep, voffB);
            PG8_WAIT_V(6); PG8_BAR; PG8_MMA(1, 1, At, B1); PG8_BAR;
            PG8_LDB(B0, 1, 0); PG8_SCHED; PG8_LDA(At, 1, 0); PG8_STAGE(PG8_SA(0, 1), a2 + hstepA, voffA);
            PG8_WAIT_L(8); PG8_BAR; PG8_WAIT_L(0); PG8_MMA(0, 0, At, B0); PG8_BAR; PG8_SCHED;
            PG8_LDB(B1, 1, 1); PG8_STAGE(PG8_SB(1, 0), b3, voffB);
            PG8_BAR; PG8_WAIT_L(0); PG8_MMA(0, 1, At, B1); PG8_BAR;
            PG8_LDA(At, 1, 1); PG8_STAGE(PG8_SA(1, 0), a3, voffA);
            PG8_BAR; PG8_WAIT_L(0); PG8_MMA(1, 0, At, B0); PG8_BAR; PG8_SCHED;
            PG8_STAGE(PG8_SB(1, 1), b3 + hstep, voffB);
            PG8_WAIT_V(6); PG8_BAR; PG8_MMA(1, 1, At, B1); PG8_BAR;
            }
        }
        if constexpr (ALIGN_EPI) { if (wr == 0) PG8_BAR; }
        if constexpr (!Epi::AFTER_DRAIN) { E(acc, cur, wr, wc, fr, fq); S.done(cur); }
        if (!has_next) break;
#pragma unroll
        for (int a = 0; a < 2; ++a)
#pragma unroll
            for (int b = 0; b < 2; ++b)
#pragma unroll
                for (int m = 0; m < 4; ++m)
#pragma unroll
                    for (int n = 0; n < 2; ++n) acc[a][b][m][n] = (f32x4){0.f, 0.f, 0.f, 0.f};
        cur = nxt; cA = nA; cB = nB; ++ui;
        if constexpr (ALIGN_EPI) { if (wr == 1) PG8_BAR; }
    }
    PG8_WAIT_V(0);
    if constexpr (!ALIGN_EPI) { if (wr == 0) PG8_BAR; }
    PG8_BAR;
    if constexpr (Epi::AFTER_DRAIN) { E.fused(acc, cur, wr, wc, fr, fq, lds, wid, lane); S.done(cur); }
#undef PG8_SA
#undef PG8_SB
#undef PG8_STAGE
#undef PG8_LDA
#undef PG8_LDB
#undef PG8_MMA
#undef PG8_WAIT_V
#undef PG8_WAIT_L
#undef PG8_BAR
#undef PG8_SCHED
}
}

#ifndef PG8_SP2
#define PG8_SP2 true
#endif
#ifndef PG8_ALIGN
#define PG8_ALIGN true
#endif

constexpr int NWAVES = 8, NTHR = 512;
constexpr int BATCH = 8, SEQ = 4096, DM = 1024, TOK = BATCH * SEQ;
constexpr int NQKVA = 4608, AW = 512, NKVQ = 3072, FF = 2816, NUP = 5632;
constexpr float LOG2E = 1.4426950408889634f;
constexpr float C2 = 0.125f * LOG2E;
constexpr float RMS_EPS = 1e-6f, SUBLN_EPS = 1e-5f;
constexpr float LAMBDA_INIT = 0.8f - 0.6f * 0.7408182206817179f;

constexpr size_t MiB = 1u << 20;
constexpr size_t WS_WIN = 1 * MiB, WS_WOA = 10 * MiB, WS_WKVQ = 11 * MiB, WS_WOB = 17 * MiB, WS_WUP0 = 19 * MiB, WS_WUP1 = 30 * MiB;
constexpr size_t WS_WDN0 = 41 * MiB, WS_WDN1 = WS_WDN0 + (size_t)DM * FF * 2;
constexpr size_t WS_TABB = 63 * MiB, WS_TABA = WS_TABB + 256 * 1024;
constexpr size_t WS_PAR = 62 * MiB;
constexpr int PAR_NORMG = 0, PAR_CONVW = 8 * 1024, PAR_CONVB = PAR_CONVW + 6 * 5632, PAR_LAM = PAR_CONVB + 2 * 5632, PAR_SUBG = PAR_LAM + 256, PAR_END = PAR_SUBG + 128;
constexpr size_t WS_XN = 64 * MiB;
constexpr size_t WS_BIG = 128 * MiB;
constexpr size_t WS_GATED = 128 * MiB, WS_PART = 304 * MiB, WS_LAST = 316 * MiB, WS_MIX = 448 * MiB;
constexpr size_t WS_END = 512 * MiB;
constexpr int TABB_STRIDE = 64 + SEQ;

constexpr int LDS_BYTES = 147456;
constexpr int LDS_MISC_OFF = 131072 + 320;
constexpr size_t WS_CTL = 0, CTL_ZERO_BYTES = 65536;

#define GAS __attribute__((address_space(1)))
#define LAS __attribute__((address_space(3)))
typedef unsigned short bf16;
typedef unsigned v4u __attribute__((ext_vector_type(4)));
typedef unsigned v2u __attribute__((ext_vector_type(2)));
typedef float f32x4 __attribute__((ext_vector_type(4)));
#define LDS_WAIT() asm volatile("s_waitcnt lgkmcnt(0)" ::: "memory")
#define LAUNDER_V(x) asm volatile("" : "+v"(x))
#define LAUNDER_S(x) asm volatile("" : "+s"(x))
__device__ __forceinline__ unsigned f2bf(float f) { unsigned u = __builtin_bit_cast(unsigned, f); return (u + 0x7fffu + ((u >> 16) & 1u)) >> 16; }
__device__ __forceinline__ unsigned pk2(float lo, float hi) { return f2bf(lo) | (f2bf(hi) << 16); }
__device__ __forceinline__ float bflo(unsigned w) { return __uint_as_float(w << 16); }
__device__ __forceinline__ float bfhi(unsigned w) { return __uint_as_float(w & 0xffff0000u); }
__device__ __forceinline__ float wave_sum(float v) {
#pragma unroll
    for (int o = 1; o < 64; o <<= 1) v += __shfl_xor(v, o);
    return v;
}
__device__ __forceinline__ int t5_bucket(int n) {
    if (n < 16) return n;
    return 16 + (n >= 22) + (n >= 30) + (n >= 40) + (n >= 54) + (n >= 73) + (n >= 99) + (n >= 134) + (n >= 182) + (n >= 246) + (n >= 332) + (n >= 450) + (n >= 609) + (n >= 825) + (n >= 1117) + (n >= 1513);
}

#define PHASE_IDS \
    int tid_ = threadIdx.x; LAUNDER_V(tid_); const int lane = tid_ & 63, wave = __builtin_amdgcn_readfirstlane(tid_ >> 6); \
    const int G_ = gridDim.x, bx_ = blockIdx.x; const int vcu_ = (G_ % 8 == 0) ? (bx_ % 8) * (G_ / 8) + bx_ / 8 : bx_; \
    const int gw = vcu_ * NWAVES + wave, ngw = G_ * NWAVES, gtid = bx_ * NTHR + tid_, gstride = G_ * NTHR; \
    (void)lane; (void)wave; (void)gw; (void)ngw; (void)gtid; (void)gstride;

struct Args {
    const float* in[19]; float* out; unsigned char* ws; int ph_lo, ph_hi;
};

__device__ __forceinline__ void tr_item(const float* W, int K, int N, bf16* WT, int k0, int n0, int drow0, const float* gk, float cs, LAS float* scr, int lane) {
#pragma unroll 8
    for (int i = 0; i < 32; ++i) { const int kk = 2 * i + (lane >> 5); const float g = gk ? gk[k0 + kk] : 1.f;
        scr[kk * 33 + (lane & 31)] = W[(size_t)(k0 + kk) * N + n0 + (lane & 31)] * (g * cs); }
    LDS_WAIT(); asm volatile("" ::: "memory");
    const int c = lane & 7;
#pragma unroll
    for (int j = 0; j < 4; ++j) { const int n = (lane >> 3) + 8 * j; const LAS float* s = scr + (8 * c) * 33 + n;
        v4u o; o.x = pk2(s[0 * 33], s[1 * 33]); o.y = pk2(s[2 * 33], s[3 * 33]); o.z = pk2(s[4 * 33], s[5 * 33]); o.w = pk2(s[6 * 33], s[7 * 33]);
        *(v4u*)(WT + (size_t)(drow0 + n) * K + k0 + 8 * c) = o; }
    LDS_WAIT(); asm volatile("" ::: "memory");
}
__device__ __forceinline__ void tr_mat(int r, const float* W, int K, int N, bf16* WT, int rowoff, const float* gk, int kind, LAS float* scr, int lane) {
    const int nblk = N / 32, kb = r / nblk, nb = r % nblk, n0 = nb * 32; int dr = n0; float cs = 1.f;
    if (kind == 1) cs = ((n0 % 1536) < 512) ? C2 : 1.f;
    if (kind == 2) cs = C2;
    if (kind == 3) dr = (n0 < FF) ? 256 * (n0 / 128) + (n0 % 128) : 256 * ((n0 - FF) / 128) + 128 + ((n0 - FF) % 128);
    tr_item(W, K, N, WT, kb * 64, n0, dr + rowoff, gk, cs, scr, lane);
}

__device__ __forceinline__ void prologue(const Args& a, LAS unsigned char* lds) {
    PHASE_IDS
    LAS float* scr = (LAS float*)(lds + wave * 16384);
    unsigned char* ws = a.ws;
    const float* norm_g = a.in[2];
    constexpr int I_WIN = 16 * 144, I_WOA = 8 * 32, I_SQ = 16 * 32, I_UP = 16 * 176, I_DN = 44 * 32;
    constexpr int NITEMS = I_WIN + I_WOA + 4 * I_SQ + 2 * I_UP + 2 * I_DN;
    for (int it = gw; it < NITEMS; it += ngw) {
        int r = it;
        if (r < I_WIN) { tr_mat(r, a.in[3], DM, NQKVA, (bf16*)(ws + WS_WIN), 0, norm_g + 0 * DM, 1, scr, lane); continue; } r -= I_WIN;
        if (r < I_WOA) { tr_mat(r, a.in[4], AW, DM, (bf16*)(ws + WS_WOA), 0, nullptr, 0, scr, lane); continue; } r -= I_WOA;
        if (r < I_SQ) { tr_mat(r, a.in[6], DM, DM, (bf16*)(ws + WS_WKVQ), 0, a.in[5], 0, scr, lane); continue; } r -= I_SQ;
        if (r < I_SQ) { tr_mat(r, a.in[7], DM, DM, (bf16*)(ws + WS_WKVQ), 1024, a.in[5], 0, scr, lane); continue; } r -= I_SQ;
        if (r < I_SQ) { tr_mat(r, a.in[8], DM, DM, (bf16*)(ws + WS_WKVQ), 2048, norm_g + 4 * DM, 2, scr, lane); continue; } r -= I_SQ;
        if (r < I_SQ) { tr_mat(r, a.in[14], DM, DM, (bf16*)(ws + WS_WOB), 0, nullptr, 0, scr, lane); continue; } r -= I_SQ;
        if (r < I_UP) { tr_mat(r, a.in[15], DM, NUP, (bf16*)(ws + WS_WUP0), 0, norm_g + 2 * DM, 3, scr, lane); continue; } r -= I_UP;
        if (r < I_UP) { tr_mat(r, a.in[15] + (size_t)DM * NUP, DM, NUP, (bf16*)(ws + WS_WUP1), 0, norm_g + 6 * DM, 3, scr, lane); continue; } r -= I_UP;
        if (r < I_DN) { tr_mat(r, a.in[18], FF, DM, (bf16*)(ws + WS_WDN0), 0, nullptr, 0, scr, lane); continue; } r -= I_DN;
        tr_mat(r, a.in[18] + (size_t)FF * DM, FF, DM, (bf16*)(ws + WS_WDN1), 0, nullptr, 0, scr, lane);
    }
    { float* par = (float*)(ws + WS_PAR); const int gt0 = gw * 64 + lane, ngt0 = ngw * 64;
      for (int i = gt0; i < PAR_END; i += ngt0) { float v;
        if (i < PAR_CONVW) v = a.in[2][i]; else if (i < PAR_CONVB) v = a.in[16][i - PAR_CONVW]; else if (i < PAR_LAM) v = a.in[17][i - PAR_CONVB];
        else if (i < PAR_SUBG) { const int k = i - PAR_LAM; v = a.in[9 + (k >> 6)][k & 63]; } else v = a.in[13][i - PAR_SUBG];
        par[i] = v; } }
    const float* table = a.in[1];
    float* tabB = (float*)(ws + WS_TABB); float* tabA = (float*)(ws + WS_TABA);
    const int gt = gw * 64 + lane, ngt = ngw * 64;
    for (int i = gt; i < 8 * TABB_STRIDE; i += ngt) { const int h = i / TABB_STRIDE, d = i % TABB_STRIDE - 64; tabB[i] = d < 0 ? 0.f : table[h * 32 + t5_bucket(d)] * LOG2E; }
    for (int i = gt; i < 3 * 8 * 132; i += ngt) { const int g = i / (8 * 132), h = (i / 132) % 8, du = i % 132; const int r = 1 << (2 * g);
        tabA[i] = du <= 128 ? table[h * 32 + t5_bucket(du * r)] * LOG2E : 0.f; }
    const float* x = a.in[0]; bf16* XN = (bf16*)(ws + WS_XN);
    for (int m = gw; m < TOK; m += ngw) {
        const f32x4* xr = (const f32x4*)(x + (size_t)m * DM) + lane; f32x4 v[4]; float s = 0.f;
#pragma unroll
        for (int j = 0; j < 4; ++j) { v[j] = xr[64 * j]; s += (v[j].x * v[j].x + v[j].y * v[j].y) + (v[j].z * v[j].z + v[j].w * v[j].w); }
        const float rs = 1.f / sqrtf(wave_sum(s) * (1.f / DM) + RMS_EPS);
        v2u* o8 = (v2u*)(XN + (size_t)m * DM) + lane;
#pragma unroll
        for (int j = 0; j < 4; ++j) { v2u w; w.x = pk2(v[j].x * rs, v[j].y * rs); w.y = pk2(v[j].z * rs, v[j].w * rs); o8[64 * j] = w; }
    }
}

__device__ __forceinline__ void rowpass(const bf16* mix, const float* g, const float* hin, float* hout, bf16* xn) {
    PHASE_IDS
    for (int m = gw; m < TOK; m += ngw) {
        const v2u* mr = (const v2u*)(mix + (size_t)m * DM) + lane; f32x4 v[4]; float s = 0.f;
#pragma unroll
        for (int j = 0; j < 4; ++j) { const v2u w = mr[64 * j]; v[j] = (f32x4){bflo(w.x), bfhi(w.x), bflo(w.y), bfhi(w.y)};
            s += (v[j].x * v[j].x + v[j].y * v[j].y) + (v[j].z * v[j].z + v[j].w * v[j].w); }
        const float rs = 1.f / sqrtf(wave_sum(s) * (1.f / DM) + RMS_EPS);
        const f32x4* gr = (const f32x4*)g + lane; const f32x4* hr = (const f32x4*)(hin + (size_t)m * DM) + lane; f32x4* ho = (f32x4*)(hout + (size_t)m * DM) + lane;
        float s2 = 0.f;
#pragma unroll
        for (int j = 0; j < 4; ++j) { const f32x4 gv = gr[64 * j], hv = hr[64 * j]; v[j] = hv + v[j] * rs * gv; ho[64 * j] = v[j];
            s2 += (v[j].x * v[j].x + v[j].y * v[j].y) + (v[j].z * v[j].z + v[j].w * v[j].w); }
        if (xn) {
            const float rs2 = 1.f / sqrtf(wave_sum(s2) * (1.f / DM) + RMS_EPS);
            v2u* o8 = (v2u*)(xn + (size_t)m * DM) + lane;
#pragma unroll
            for (int j = 0; j < 4; ++j) { v2u w; w.x = pk2(v[j].x * rs2, v[j].y * rs2); w.y = pk2(v[j].z * rs2, v[j].w * rs2); o8[64 * j] = w; }
        }
    }
}

__device__ __forceinline__ void ld8(const bf16* p, float* f) { const v4u w = *(const v4u*)p; f[0] = bflo(w.x); f[1] = bfhi(w.x); f[2] = bflo(w.y); f[3] = bfhi(w.y); f[4] = bflo(w.z); f[5] = bfhi(w.z); f[6] = bflo(w.w); f[7] = bfhi(w.w); }

namespace da {
typedef short bf16x8 __attribute__((ext_vector_type(8)));
typedef short s16x4 __attribute__((ext_vector_type(4)));
typedef short v4i16_t __attribute__((ext_vector_type(4)));
typedef float f32x16 __attribute__((ext_vector_type(16)));
typedef float f32x2_t __attribute__((ext_vector_type(2))); typedef __bf16 bf16x2_t __attribute__((ext_vector_type(2)));
constexpr int KBUF = 0, VBUF = 32768, TABL = 65536, TABL_FLOATS = 128 + SEQ, XCH = 0;
__device__ __forceinline__ unsigned cvtpk(float lo, float hi) { f32x2_t v = {lo, hi}; bf16x2_t b = __builtin_convertvector(v, bf16x2_t); return __builtin_bit_cast(unsigned, b); }
__device__ __forceinline__ s16x4 vtr(const LAS unsigned char* p) { return __builtin_bit_cast(s16x4, __builtin_amdgcn_ds_read_tr16_b64_v4i16((LAS v4i16_t*)p)); }
__device__ __forceinline__ float swapmax(float v) { auto rr = __builtin_amdgcn_permlane32_swap(__float_as_uint(v), __float_as_uint(v), false, false); return fmaxf(__uint_as_float(rr[0]), __uint_as_float(rr[1])); }
__device__ __forceinline__ float swapsum(float v) { auto rr = __builtin_amdgcn_permlane32_swap(__float_as_uint(v), __float_as_uint(v), false, false); return __uint_as_float(rr[0]) + __uint_as_float(rr[1]); }
#define DA_CST0(r) (((r) & 3) + 8 * ((r) >> 2))

__device__ __forceinline__ void diff_unit(int b, int h, int qblk, const bf16* kvq, float lam, const float* subg, bf16* Ob, LAS unsigned char* lds, int wave, int lane) {
    const int r32 = lane & 31, hi = lane >> 5, qt = wave >> 1, c = wave & 1;
    const int q0 = qblk * 128 + qt * 32, NT = 2 * qblk + 2;
    const size_t rowb = (size_t)b * SEQ;
    const LAS float* tabL = (const LAS float*)(lds + TABL);
    bf16x8 qf[4];
    { const bf16* qp = kvq + (rowb + q0 + r32) * NKVQ + 2048 + h * 128 + c * 64 + hi * 8;
#pragma unroll
      for (int d0 = 0; d0 < 4; ++d0) qf[d0] = *(const bf16x8*)(qp + 16 * d0); }
    const bf16* ksrc = kvq + (rowb + lane) * NKVQ + h * 128 + wave * 8;
    const bf16* vsrc = kvq + (rowb + 16 * (wave & 3) + (lane >> 2)) * NKVQ + 1024 + h * 128 + (wave >> 2) * 32 + (lane & 3) * 8;
    const int sdst = wave * 1024 + lane * 16;
    const LAS unsigned char* vb0 = lds + VBUF + ((lane >> 4) & 1) * 32 + (lane & 3) * 8 + (4 * hi + ((lane & 15) >> 2)) * 64;
    f32x16 o[4];
#pragma unroll
    for (int i = 0; i < 4; ++i)
#pragma unroll
        for (int r = 0; r < 16; ++r) o[i][r] = 0.f;
    float m = -INFINITY, l = 0.f;
    v4u kr0, kr1, vr0, vr1;
    kr0 = *(const v4u*)ksrc; kr1 = *(const v4u*)(ksrc + 64); vr0 = *(const v4u*)vsrc; vr1 = *(const v4u*)(vsrc + 64);
    *(LAS v4u*)(lds + KBUF + sdst) = kr0; *(LAS v4u*)(lds + KBUF + 8192 + sdst) = kr1; *(LAS v4u*)(lds + VBUF + sdst) = vr0; *(LAS v4u*)(lds + VBUF + 8192 + sdst) = vr1;
    __syncthreads();
#pragma unroll 1
    for (int kt = 0; kt < NT; ++kt) {
        const int buf = kt & 1; const bool more = kt + 1 < NT;
        if (more) { const size_t off = (size_t)(kt + 1) * 64 * NKVQ; kr0 = *(const v4u*)(ksrc + off); kr1 = *(const v4u*)(ksrc + off + 64); vr0 = *(const v4u*)(vsrc + off); vr1 = *(const v4u*)(vsrc + off + 64); }
        if (64 * kt <= q0 + 31) {
            f32x16 p0, p1;
#pragma unroll
            for (int r = 0; r < 16; ++r) { p0[r] = 0.f; p1[r] = 0.f; }
            const LAS unsigned char* kb = lds + KBUF + buf * 16384 + (8 * c + hi) * 1024 + r32 * 16;
#pragma unroll
            for (int d0 = 0; d0 < 4; ++d0) { const bf16x8 a0 = *(const LAS bf16x8*)(kb + d0 * 2048), a1 = *(const LAS bf16x8*)(kb + d0 * 2048 + 512);
                p0 = __builtin_amdgcn_mfma_f32_32x32x16_bf16(a0, qf[d0], p0, 0, 0, 0); p1 = __builtin_amdgcn_mfma_f32_32x32x16_bf16(a1, qf[d0], p1, 0, 0, 0); }
            const int idx0 = q0 + r32 - 64 * kt - 4 * hi;
            const LAS float* tb = tabL + (128 - 59) + idx0;
#pragma unroll
            for (int r = 0; r < 16; ++r) { p0[r] += tb[59 - DA_CST0(r)]; p1[r] += tb[27 - DA_CST0(r)]; }
            if (64 * kt + 63 > q0) {
#pragma unroll
                for (int r = 0; r < 16; ++r) { if (DA_CST0(r) > idx0) p0[r] = -INFINITY; if (32 + DA_CST0(r) > idx0) p1[r] = -INFINITY; }
            }
            float rm = fmaxf(p0[0], p1[0]);
#pragma unroll
            for (int r = 1; r < 16; ++r) rm = fmaxf(rm, fmaxf(p0[r], p1[r]));
            rm = swapmax(rm);
            const float mn = fmaxf(m, rm); const float al = __builtin_amdgcn_exp2f(m - mn); m = mn;
            float ls = 0.f;
#pragma unroll
            for (int r = 0; r < 16; ++r) { p0[r] = __builtin_amdgcn_exp2f(p0[r] - mn); p1[r] = __builtin_amdgcn_exp2f(p1[r] - mn); ls += p0[r] + p1[r]; }
            l = l * al + ls;
#pragma unroll
            for (int i = 0; i < 4; ++i)
#pragma unroll
                for (int r = 0; r < 16; ++r) o[i][r] *= al;
            v4u pw[4];
#pragma unroll
            for (int x = 0; x < 4; ++x) { pw[0][x] = cvtpk(p0[2 * x], p0[2 * x + 1]); pw[1][x] = cvtpk(p0[8 + 2 * x], p0[9 + 2 * x]); pw[2][x] = cvtpk(p1[2 * x], p1[2 * x + 1]); pw[3][x] = cvtpk(p1[8 + 2 * x], p1[9 + 2 * x]); }
            const LAS unsigned char* vb = vb0 + buf * 16384;
#pragma unroll
            for (int db = 0; db < 4; ++db)
#pragma unroll
                for (int ks = 0; ks < 4; ++ks) { const s16x4 lo = vtr(vb + db * 4096 + ks * 1024), hh = vtr(vb + db * 4096 + ks * 1024 + 512);
                    const bf16x8 vf = (bf16x8){lo[0], lo[1], lo[2], lo[3], hh[0], hh[1], hh[2], hh[3]};
                    o[db] = __builtin_amdgcn_mfma_f32_32x32x16_bf16(vf, __builtin_bit_cast(bf16x8, pw[ks]), o[db], 0, 0, 0); }
        }
        if (more) { const int nb = (buf ^ 1) * 16384; *(LAS v4u*)(lds + KBUF + nb + sdst) = kr0; *(LAS v4u*)(lds + KBUF + nb + 8192 + sdst) = kr1; *(LAS v4u*)(lds + VBUF + nb + sdst) = vr0; *(LAS v4u*)(lds + VBUF + nb + 8192 + sdst) = vr1; }
        __syncthreads();
    }
    const float il = 1.f / swapsum(l);
    LAS float* xch = (LAS float*)(lds + XCH) + (qt * 64) * 64 + lane;
    if (c == 1) {
#pragma unroll
        for (int i = 0; i < 4; ++i)
#pragma unroll
            for (int r = 0; r < 16; ++r) xch[(i * 16 + r) * 64] = o[i][r] * il;
    }
    __syncthreads();
    if (c == 0) {
        float ss = 0.f;
#pragma unroll
        for (int i = 0; i < 4; ++i)
#pragma unroll
            for (int r = 0; r < 16; ++r) { const float v = o[i][r] * il - lam * xch[(i * 16 + r) * 64]; o[i][r] = v; ss += v * v; }
        ss = swapsum(ss);
        const float rs = 1.f / sqrtf(ss * (1.f / 128.f) + SUBLN_EPS) * (1.f - LAMBDA_INIT);
        bf16* op = Ob + (rowb + q0 + r32) * DM + h * 128 + 4 * hi;
#pragma unroll
        for (int i = 0; i < 4; ++i)
#pragma unroll
            for (int rr = 0; rr < 4; ++rr) { const f32x4 sg = *(const f32x4*)(subg + 32 * i + 8 * rr + 4 * hi);
                v2u w; w.x = cvtpk(o[i][4 * rr] * rs * sg.x, o[i][4 * rr + 1] * rs * sg.y); w.y = cvtpk(o[i][4 * rr + 2] * rs * sg.z, o[i][4 * rr + 3] * rs * sg.w);
                *(v2u*)(op + 32 * i + 8 * rr) = w; }
    }
    __syncthreads();
}
}

__device__ __forceinline__ void diff_attn_phase(const bf16* kvq, const float* tabB, const float* par, bf16* Ob, LAS unsigned char* lds) {
    PHASE_IDS
    float lam;
    { const float* lp = par + PAR_LAM; const float p1 = lp[lane] * lp[64 + lane], p2 = lp[128 + lane] * lp[192 + lane]; lam = expf(wave_sum(p1)) - expf(wave_sum(p2)) + LAMBDA_INIT; }
    const float* subg = par + PAR_SUBG;
    const int bh = vcu_ >> 2, j = vcu_ & 3, b = bh >> 3, h = bh & 7;
    { LAS float* tabL = (LAS float*)(lds + da::TABL); const float* src = tabB + h * TABB_STRIDE;
      for (int i = tid_; i < da::TABL_FLOATS; i += NTHR) tabL[i] = i < 64 ? 0.f : src[i - 64]; }
    __syncthreads();
#pragma unroll 1
    for (int u = 0; u < 8; ++u) {
        const int base = 4 * (u >> 1) + j; const int qblk = (u & 1) ? 31 - base : base;
        da::diff_unit(b, h, qblk, kvq, lam, subg, Ob, lds, wave, lane);
    }
}

namespace dl {
using da::bf16x8; using da::s16x4; using da::f32x16; using da::cvtpk; using da::vtr; using da::swapmax; using da::swapsum;
constexpr int STAGE = 0, TAB = 32768;
__device__ __forceinline__ void task(int b, int h, int tb, int g, int ti, const bf16* qkv, bf16* Og, float* LSE, LAS unsigned char* lds, int wave, int lane) {
    const int r32 = lane & 31, hi = lane >> 5;
    const int sh = 2 * g;
    int c, m0;
    if (g == 0) { c = 0; m0 = tb * 512 + 32 * ti; } else if (g == 1) { c = ti & 3; m0 = tb * 128 + 32 * (ti >> 2); } else { c = ti; m0 = tb * 32; }
    const size_t rowb = (size_t)b * SEQ;
    const int gcol = g * 1536 + h * 64;
    const int qtok = ((m0 + r32) << sh) + c;
    bf16x8 qf[4];
    { const bf16* qp = qkv + (rowb + qtok) * NQKVA + gcol + hi * 8;
#pragma unroll
      for (int d0 = 0; d0 < 4; ++d0) qf[d0] = *(const bf16x8*)(qp + 16 * d0); }
    const int jmin = (m0 >= 128) ? 0 : 4 - (m0 >> 5);
    f32x16 o[2];
#pragma unroll
    for (int i = 0; i < 2; ++i)
#pragma unroll
        for (int r = 0; r < 16; ++r) o[i][r] = 0.f;
    float m = -INFINITY, l = 0.f;
    LAS unsigned char* stg = lds + STAGE + wave * 4096;
    const LAS unsigned char* vb = stg + ((lane >> 4) & 1) * 32 + (lane & 3) * 8 + (4 * hi + ((lane & 15) >> 2)) * 64;
    const LAS float* tab = (const LAS float*)(lds + TAB) + g * 132;
    const bf16* kbase = qkv + rowb * NQKVA + gcol + 512 + hi * 8;
    const bf16* vbase = qkv + rowb * NQKVA + gcol + 1024 + (lane & 3) * 8;
    bf16x8 kn[4]; v4u vn[4];
#define DL_LOAD(j) do { const int ku0_ = m0 - 128 + 32 * (j); const bf16* kp_ = kbase + (size_t)(((ku0_ + r32) << sh) + c) * NQKVA; \
        _Pragma("unroll") for (int d0 = 0; d0 < 4; ++d0) kn[d0] = *(const bf16x8*)(kp_ + 16 * d0); \
        _Pragma("unroll") for (int i = 0; i < 4; ++i) vn[i] = *(const v4u*)(vbase + (size_t)(((ku0_ + 16 * (i & 1) + (lane >> 2)) << sh) + c) * NQKVA + 32 * (i >> 1)); } while (0)
    DL_LOAD(jmin);
#pragma unroll 1
    for (int j = jmin; j <= 4; ++j) {
        bf16x8 kf[4]; v4u vv[4];
#pragma unroll
        for (int i = 0; i < 4; ++i) { kf[i] = kn[i]; vv[i] = vn[i]; }
        if (j < 4) DL_LOAD(j + 1);
        f32x16 p;
#pragma unroll
        for (int r = 0; r < 16; ++r) p[r] = 0.f;
#pragma unroll
        for (int d0 = 0; d0 < 4; ++d0) p = __builtin_amdgcn_mfma_f32_32x32x16_bf16(kf[d0], qf[d0], p, 0, 0, 0);
        const int du0 = 128 - 32 * j + r32 - 4 * hi;
        const LAS float* tb = tab + du0 - 27;
#pragma unroll
        for (int r = 0; r < 16; ++r) p[r] += tb[27 - DA_CST0(r)];
        if (j == 0 || j == 4) {
#pragma unroll
            for (int r = 0; r < 16; ++r) { const int du = du0 - DA_CST0(r); if (du < 0 || du > 128) p[r] = -INFINITY; }
        }
        float rm = p[0];
#pragma unroll
        for (int r = 1; r < 16; ++r) rm = fmaxf(rm, p[r]);
        rm = swapmax(rm);
        const float mn = fmaxf(m, rm); const float al = __builtin_amdgcn_exp2f(m - mn); m = mn;
        float ls = 0.f;
#pragma unroll
        for (int r = 0; r < 16; ++r) { p[r] = __builtin_amdgcn_exp2f(p[r] - mn); ls += p[r]; }
        l = l * al + ls;
#pragma unroll
        for (int i = 0; i < 2; ++i)
#pragma unroll
            for (int r = 0; r < 16; ++r) o[i][r] *= al;
        v4u pw[2];
#pragma unroll
        for (int x = 0; x < 4; ++x) { pw[0][x] = cvtpk(p[2 * x], p[2 * x + 1]); pw[1][x] = cvtpk(p[8 + 2 * x], p[9 + 2 * x]); }
#pragma unroll
        for (int i = 0; i < 4; ++i) *(LAS v4u*)(stg + i * 1024 + lane * 16) = vv[i];
#pragma unroll
        for (int db = 0; db < 2; ++db)
#pragma unroll
            for (int ks = 0; ks < 2; ++ks) { const s16x4 lo = vtr(vb + (db * 2 + ks) * 1024), hh = vtr(vb + (db * 2 + ks) * 1024 + 512);
                const bf16x8 vf = (bf16x8){lo[0], lo[1], lo[2], lo[3], hh[0], hh[1], hh[2], hh[3]};
                o[db] = __builtin_amdgcn_mfma_f32_32x32x16_bf16(vf, __builtin_bit_cast(bf16x8, pw[ks]), o[db], 0, 0, 0); }
    }
#undef DL_LOAD
    const float lt = swapsum(l); const float il = 1.f / lt;
    bf16* op = Og + ((size_t)g * TOK + rowb + qtok) * AW + h * 64 + 4 * hi;
#pragma unroll
    for (int i = 0; i < 2; ++i)
#pragma unroll
        for (int rr = 0; rr < 4; ++rr) { v2u w; w.x = cvtpk(o[i][4 * rr] * il, o[i][4 * rr + 1] * il); w.y = cvtpk(o[i][4 * rr + 2] * il, o[i][4 * rr + 3] * il); *(v2u*)(op + 32 * i + 8 * rr) = w; }
    if (hi == 0) LSE[((size_t)g * TOK + rowb + qtok) * 8 + h] = m + __builtin_amdgcn_logf(lt);
}
}

__device__ __forceinline__ void dilated_attn_phase(const bf16* qkv, const float* tabA, bf16* Og, float* LSE, bf16* Oa, LAS unsigned char* lds) {
    PHASE_IDS
#pragma unroll 1
    for (int unit = vcu_; unit < 512; unit += G_) {
        const int b = unit >> 6, h = (unit >> 3) & 7, tb = unit & 7;
        { LAS float* tl = (LAS float*)(lds + dl::TAB); for (int i = tid_; i < 3 * 132; i += NTHR) tl[i] = tabA[((i / 132) * 8 + h) * 132 + (i % 132)]; }
        __syncthreads();
#pragma unroll 1
        for (int i = 0; i < 6; ++i) { const int t = wave + 8 * i; dl::task(b, h, tb, t >> 4, t & 15, qkv, Og, LSE, lds, wave, lane); }
        __threadfence(); __syncthreads(); __threadfence();
        const size_t tok0 = (size_t)b * SEQ + tb * 512;
#pragma unroll 1
        for (int it = tid_; it < 4096; it += NTHR) { const int tk = it >> 3, ch = it & 7; const size_t tok = tok0 + tk;
            const float l0 = LSE[tok * 8 + h], l1 = LSE[((size_t)TOK + tok) * 8 + h], l2 = LSE[((size_t)2 * TOK + tok) * 8 + h];
            const float mx = fmaxf(l0, fmaxf(l1, l2)); float a0 = __builtin_amdgcn_exp2f(l0 - mx), a1 = __builtin_amdgcn_exp2f(l1 - mx), a2 = __builtin_amdgcn_exp2f(l2 - mx);
            const float inv = 1.f / (a0 + a1 + a2); a0 *= inv; a1 *= inv; a2 *= inv;
            float f0[8], f1[8], f2[8]; ld8(Og + tok * AW + h * 64 + ch * 8, f0); ld8(Og + ((size_t)TOK + tok) * AW + h * 64 + ch * 8, f1); ld8(Og + ((size_t)2 * TOK + tok) * AW + h * 64 + ch * 8, f2);
            float r8[8];
#pragma unroll
            for (int e = 0; e < 8; ++e) r8[e] = a0 * f0[e] + a1 * f1[e] + a2 * f2[e];
            v4u w; w.x = pk2(r8[0], r8[1]); w.y = pk2(r8[2], r8[3]); w.z = pk2(r8[4], r8[5]); w.w = pk2(r8[6], r8[7]);
            *(v4u*)(Oa + tok * AW + h * 64 + ch * 8) = w; }
        __syncthreads();
    }
}

__device__ __forceinline__ float dpp_ror1(float v) { return __builtin_bit_cast(float, __builtin_amdgcn_update_dpp(0, __builtin_bit_cast(int, v), 0x121, 0xf, 0xf, false)); }
__device__ __forceinline__ float dpp_ror2(float v) { return __builtin_bit_cast(float, __builtin_amdgcn_update_dpp(0, __builtin_bit_cast(int, v), 0x122, 0xf, 0xf, false)); }
struct EpiConvGate {
    static constexpr bool PERM = true, AFTER_DRAIN = false, AMAP = true;
    bf16* gated; float* part; float* last; const float* cw; const float* cb;
    __device__ __forceinline__ void operator()(const pg8::f32x4 (&acc)[2][2][4][2], const pg8::Unit& u, int wr, int wc, int fr, int fq) const {
        typedef pg8::f32x4 f4;
        const int blk = u.pm * 2 + wr; const size_t row0 = (size_t)blk * 128;
        const bool is15 = fr == 15, ge14 = fr >= 14;
#pragma unroll
        for (int n = 0; n < 2; ++n) {
            const int j0 = u.pn * 128 + wc * 32 + 8 * fq + 4 * n;
            f4 w[2][3], bb[2];
#pragma unroll
            for (int bj = 0; bj < 2; ++bj) { bb[bj] = *(const f4*)(cb + bj * FF + j0);
#pragma unroll
                for (int jj = 0; jj < 3; ++jj) w[bj][jj] = *(const f4*)(cw + jj * NUP + bj * FF + j0); }
            f4 pv[2] = {(f4){0.f, 0.f, 0.f, 0.f}, (f4){0.f, 0.f, 0.f, 0.f}};
#pragma unroll
            for (int ai = 0; ai < 2; ++ai)
#pragma unroll
                for (int m = 0; m < 4; ++m) {
                    f4 c[2];
#pragma unroll
                    for (int bj = 0; bj < 2; ++bj) { const f4 cur = acc[ai][bj][m][n]; f4 s1, s2;
#pragma unroll
                        for (int e = 0; e < 4; ++e) { s1[e] = dpp_ror1(is15 ? pv[bj][e] : cur[e]); s2[e] = dpp_ror2(ge14 ? pv[bj][e] : cur[e]); }
                        c[bj] = bb[bj] + w[bj][2] * cur + w[bj][1] * s1 + w[bj][0] * s2; pv[bj] = cur; }
                    if (ai == 0 && m == 0 && fr < 2) {
#pragma unroll
                        for (int bj = 0; bj < 2; ++bj) *(f4*)(part + ((size_t)blk * 2 + fr) * NUP + bj * FF + j0) = c[bj];
                    } else {
                        const pg8::f32x2 ga = pg8::gelu_pk((pg8::f32x2){c[0][0], c[0][1]}), gb = pg8::gelu_pk((pg8::f32x2){c[0][2], c[0][3]});
                        v2u o; o.x = pg8::cvt_pk_bf16(ga.x * c[1][0], ga.y * c[1][1]); o.y = pg8::cvt_pk_bf16(gb.x * c[1][2], gb.y * c[1][3]);
                        *(v2u*)(gated + (row0 + 64 * ai + 16 * m + fr) * FF + j0) = o;
                    }
                    if (ai == 1 && m == 3 && ge14) {
#pragma unroll
                        for (int bj = 0; bj < 2; ++bj) *(f4*)(last + ((size_t)blk * 2 + (fr - 14)) * NUP + bj * FF + j0) = acc[1][bj][3][n];
                    }
                }
        }
    }
};
__device__ __forceinline__ void conv_fixup(const float* part, const float* last, const float* cw, bf16* gated) {
    PHASE_IDS
    for (int it = gtid; it < 256 * 2 * 352; it += gstride) {
        const int j = (it % 352) * 8, rho = (it / 352) & 1, blk = it / 704;
        float cg[8], cv[8];
        { const float* pp = part + ((size_t)blk * 2 + rho) * NUP + j;
#pragma unroll
          for (int e = 0; e < 8; ++e) { cg[e] = pp[e]; cv[e] = pp[FF + e]; } }
        if (blk & 31) {
            const float* l0 = last + ((size_t)(blk - 1) * 2) * NUP + j; const float* l1 = l0 + NUP;
#pragma unroll
            for (int e = 0; e < 8; ++e) {
                if (rho == 0) { cg[e] += cw[NUP + j + e] * l1[e] + cw[j + e] * l0[e]; cv[e] += cw[NUP + FF + j + e] * l1[FF + e] + cw[FF + j + e] * l0[FF + e]; }
                else { cg[e] += cw[j + e] * l1[e]; cv[e] += cw[FF + j + e] * l1[FF + e]; } }
        }
        float r[8];
#pragma unroll
        for (int e = 0; e < 8; e += 2) { const pg8::f32x2 g2 = pg8::gelu_pk((pg8::f32x2){cg[e], cg[e + 1]}); r[e] = g2.x * cv[e]; r[e + 1] = g2.y * cv[e + 1]; }
        v4u w; w.x = pk2(r[0], r[1]); w.y = pk2(r[2], r[3]); w.z = pk2(r[4], r[5]); w.w = pk2(r[6], r[7]);
        *(v4u*)(gated + ((size_t)blk * 128 + rho) * FF + j) = w;
    }
}

#define XB_TMO      128
#define XB_XCNT(j)  (256  + 64 * (j))
#define XB_XSUB(j)  (1280 + 64 * (j))
#define XB_XGEN(j)  (2304 + 64 * (j))
#define XB_TOP      3328
#define XB_TOPGEN   3392
#define XCD_BAR_WORDS 3456
#define XB_SPIN_CAP (1u << 18)

__device__ __forceinline__ unsigned xb_ld(unsigned* p)              { return __hip_atomic_load(p, __ATOMIC_RELAXED, __HIP_MEMORY_SCOPE_AGENT); }
__device__ __forceinline__ unsigned xb_add(unsigned* p, unsigned v) { return __hip_atomic_fetch_add(p, v, __ATOMIC_RELAXED, __HIP_MEMORY_SCOPE_AGENT); }
__device__ __forceinline__ unsigned xb_xcc_id() { return (unsigned)__builtin_amdgcn_s_getreg((3 << 11) | 20) & 0xFu; }
#define XB_SPIN(cond, bar) do { unsigned _sp = 0; while (cond) { __builtin_amdgcn_s_sleep(1); \
    if ((++_sp & 255u) == 0u) { if (xb_ld(&(bar)[XB_TMO])) break; if (_sp > XB_SPIN_CAP) { atomicAdd(&(bar)[XB_TMO], 1u); break; } } } } while (0)

struct XcdBarrier {
    unsigned* bar; unsigned x;
    volatile LAS unsigned* st;
};

__device__ __forceinline__ XcdBarrier xcd_barrier_post(unsigned* bar, volatile LAS unsigned* st) {
    XcdBarrier b; b.bar = bar; b.x = xb_xcc_id(); b.st = st;
    if (threadIdx.x == 0) (void)xb_add(&bar[XB_XCNT(b.x)], 1u);
    return b;
}
__device__ __forceinline__ void xcd_barrier_complete(unsigned* bar, unsigned x, unsigned& nloc, unsigned& nx) {
    const unsigned G = gridDim.x * gridDim.y * gridDim.z;
    unsigned sum, cnt, mine, sp = 0u;
    for (;;) {
        sum = 0u; cnt = 0u; mine = 0u;
#pragma unroll
        for (unsigned j = 0; j < 16; ++j) { const unsigned c = xb_ld(&bar[XB_XCNT(j)]); sum += c; cnt += (c > 0u) ? 1u : 0u; mine = (j == x) ? c : mine; }
        if (sum == G) break;
        __builtin_amdgcn_s_sleep(1);
        if ((++sp & 255u) == 0u) { if (xb_ld(&bar[XB_TMO])) break; if (sp > XB_SPIN_CAP) { atomicAdd(&bar[XB_TMO], 1u); break; } }
    }
    nloc = mine > 0u ? mine : 1u; nx = cnt > 0u ? cnt : 1u;
}

__device__ __forceinline__ void xcd_barrier(const XcdBarrier& b) {
    asm volatile("s_waitcnt vmcnt(0)" ::: "memory");
    __syncthreads();
    if (threadIdx.x == 0) {
        unsigned* bar = b.bar;
        __builtin_amdgcn_s_waitcnt(0);
        unsigned nloc = b.st[0], nx = b.st[1];
        if (nloc == 0u) { xcd_barrier_complete(bar, b.x, nloc, nx); b.st[0] = nloc; b.st[1] = nx; }
        const unsigned old = xb_add(&bar[XB_XSUB(b.x)], 1u);
        const unsigned gen = old / nloc;
        if (old + 1u == (gen + 1u) * nloc) {
            __builtin_amdgcn_fence(__ATOMIC_RELEASE, "agent");
            asm volatile("s_waitcnt vmcnt(0)" ::: "memory");
            const unsigned og = xb_add(&bar[XB_TOP], 1u);
            const unsigned tg = og / nx;
            if (og + 1u == (tg + 1u) * nx) xb_add(&bar[XB_TOPGEN], 1u);
            else XB_SPIN(xb_ld(&bar[XB_TOPGEN]) == tg, bar);
            __builtin_amdgcn_fence(__ATOMIC_ACQUIRE, "agent");
            xb_add(&bar[XB_XGEN(b.x)], 1u);
            asm volatile("s_waitcnt vmcnt(0)" ::: "memory");
        } else {
            XB_SPIN(xb_ld(&bar[XB_XGEN(b.x)]) == gen, bar);
            __builtin_amdgcn_fence(__ATOMIC_ACQUIRE, "agent");
            asm volatile("s_waitcnt vmcnt(0)" ::: "memory");
        }
    }
    __syncthreads();
}

namespace cg = cooperative_groups;
#define GEMM_PHASE(A_, B_, M_, N_, K_, O_, LDC_) do { pg8::Gemm g{(const bf16*)(A_), (const bf16*)(B_), M_, N_, K_}; pg8::StaticOrder S; S.init(M_, N_, (int)gridDim.x, (int)blockIdx.x); \
    pg8::EpiBf16<0> E{(bf16*)(O_), LDC_, nullptr, 0, 0, 1.f}; pg8::gemm_phase<pg8::EpiBf16<0>, pg8::StaticOrder, PG8_ALIGN, PG8_SP2>(lds, g, S, E); } while (0)
__global__ void __launch_bounds__(NTHR, 2) fwd(Args a) {
    extern __shared__ __attribute__((aligned(16))) unsigned char lds_raw[];
    LAS unsigned char* lds = (LAS unsigned char*)lds_raw;
    cg::grid_group grid = cg::this_grid();
    { volatile LAS unsigned* misc = (volatile LAS unsigned*)(lds + LDS_MISC_OFF); if (threadIdx.x < 32) misc[threadIdx.x] = 0u; }
    __syncthreads();
    XcdBarrier bar = xcd_barrier_post((unsigned*)(a.ws + WS_CTL) + 1024, (volatile LAS unsigned*)(lds + LDS_MISC_OFF) + 8);
    unsigned char* ws = a.ws;
    prologue(a, lds); grid.sync();
    const float* xin = a.in[0]; float* out = a.out;
#define WSP(T, off) ((T*)(ws + (off)))
#define PARP(off) (WSP(const float, WS_PAR) + (off))
    GEMM_PHASE(WSP(bf16, WS_XN), ws + WS_WIN, TOK, NQKVA, DM, WSP(bf16, WS_BIG), NQKVA); xcd_barrier(bar);
    dilated_attn_phase(WSP(const bf16, WS_BIG), WSP(const float, WS_TABA), WSP(bf16, 416 * MiB), WSP(float, 64 * MiB), WSP(bf16, 68 * MiB), lds); xcd_barrier(bar);
    GEMM_PHASE(WSP(bf16, 68 * MiB), ws + WS_WOA, TOK, DM, AW, WSP(bf16, WS_MIX), DM); xcd_barrier(bar);
    rowpass(WSP(const bf16, WS_MIX), PARP(PAR_NORMG + 1 * DM), xin, out, WSP(bf16, WS_XN)); xcd_barrier(bar);
#pragma unroll 1
    for (int lay = 0; lay < 2; ++lay) {
        if (lay == 1) {
            GEMM_PHASE(WSP(bf16, WS_XN), ws + WS_WKVQ, TOK, NKVQ, DM, WSP(bf16, WS_BIG), NKVQ); xcd_barrier(bar);
            diff_attn_phase(WSP(const bf16, WS_BIG), WSP(const float, WS_TABB), PARP(0), WSP(bf16, 320 * MiB), lds); xcd_barrier(bar);
            GEMM_PHASE(WSP(bf16, 320 * MiB), ws + WS_WOB, TOK, DM, DM, WSP(bf16, WS_MIX), DM); xcd_barrier(bar);
            rowpass(WSP(const bf16, WS_MIX), PARP(PAR_NORMG + 5 * DM), out, out, WSP(bf16, WS_XN)); xcd_barrier(bar);
        }
        { pg8::Gemm g{WSP(const bf16, WS_XN), (const bf16*)(ws + (lay ? WS_WUP1 : WS_WUP0)), TOK, NUP, DM}; pg8::StaticOrder S; S.init(TOK, NUP, (int)gridDim.x, (int)blockIdx.x);
          EpiConvGate E{WSP(bf16, WS_GATED), WSP(float, WS_PART), WSP(float, WS_LAST), PARP(PAR_CONVW + lay * 3 * NUP), PARP(PAR_CONVB + lay * NUP)};
          pg8::gemm_phase<EpiConvGate, pg8::StaticOrder, PG8_ALIGN, PG8_SP2>(lds, g, S, E); }
        xcd_barrier(bar);
        conv_fixup(WSP(const float, WS_PART), WSP(const float, WS_LAST), PARP(PAR_CONVW + lay * 3 * NUP), WSP(bf16, WS_GATED)); xcd_barrier(bar);
        GEMM_PHASE(WSP(bf16, WS_GATED), ws + (lay ? WS_WDN1 : WS_WDN0), TOK, DM, FF, WSP(bf16, WS_MIX), DM); xcd_barrier(bar);
        rowpass(WSP(const bf16, WS_MIX), PARP(PAR_NORMG + (lay * 4 + 3) * DM), out, out, lay == 0 ? WSP(bf16, WS_XN) : (bf16*)nullptr);
        if (lay == 0) xcd_barrier(bar);
    }
}

extern "C" void kernel_launch(void* const* d_in, const int* in_sizes, int n_in, void* d_out, int out_size, void* d_ws, size_t ws_size, hipStream_t stream) {
    static int grid = 0;
    if (grid == 0) {
        if (n_in != 19 || in_sizes[0] != TOK * DM || out_size != TOK * DM || ws_size < WS_END) {
            fprintf(stderr, "kernel_launch: unexpected shapes: n_in %d in0 %d out %d ws %zu (need %zu)\n", n_in, n_in > 0 ? in_sizes[0] : -1, out_size, ws_size, (size_t)WS_END); grid = -1; return; }
        int dev = 0, cus = 0, per_cu = 0;
        if (hipGetDevice(&dev) != hipSuccess || hipDeviceGetAttribute(&cus, hipDeviceAttributeMultiprocessorCount, dev) != hipSuccess) { grid = -1; return; }
        if (hipFuncSetAttribute((const void*)fwd, hipFuncAttributeMaxDynamicSharedMemorySize, LDS_BYTES) != hipSuccess) { fprintf(stderr, "kernel_launch: hipFuncSetAttribute failed\n"); grid = -1; return; }
        if (hipOccupancyMaxActiveBlocksPerMultiprocessor(&per_cu, (const void*)fwd, NTHR, LDS_BYTES) != hipSuccess || per_cu < 1) { fprintf(stderr, "kernel_launch: occupancy query says %d blocks/CU\n", per_cu); grid = -1; return; }
        grid = cus;
    }
    if (grid < 0) return;
    Args a{};
    for (int i = 0; i < 19; ++i) a.in[i] = (const float*)d_in[i];
    a.out = (float*)d_out; a.ws = (unsigned char*)d_ws;
    if (hipMemsetAsync((char*)d_ws + WS_CTL, 0, CTL_ZERO_BYTES, stream) != hipSuccess) { fprintf(stderr, "kernel_launch: hipMemsetAsync failed\n"); return; }
    void* args[] = {&a};
    hipError_t e = hipLaunchCooperativeKernel((const void*)fwd, dim3(grid), dim3(NTHR), args, LDS_BYTES, stream);
    if (e != hipSuccess) fprintf(stderr, "cooperative launch failed: %s (grid %d)\n", hipGetErrorString(e), grid);
}
```

```cpp
#include <hip/hip_runtime.h>
#include <hip/hip_cooperative_groups.h>
#include <cstdio>
#include <cstdint>
namespace pg8 {
#define PG8_LAS __attribute__((address_space(3)))
typedef unsigned short bf16_t;
typedef short bf16x8 __attribute__((ext_vector_type(8)));
typedef float f32x4 __attribute__((ext_vector_type(4)));
typedef unsigned u32x4 __attribute__((ext_vector_type(4)));
constexpr int BM = 256, BK = 64, HALF = 128, HTB = HALF * BK * 2  , STAGE_BYTES = 8 * HTB, NXCD = 8, WGM = 8;

__host__ __device__ __forceinline__ int lds_byte(int r, int c) { const int st = (r >> 4) * 2 + (c >> 5), rr = r & 15, cc = c & 31, ob = rr * 64 + cc * 2; return st * 1024 + (ob ^ (((ob >> 9) & 1) << 5)); }
__host__ __device__ __forceinline__ void stage_rc(int b, int& R, int& C) { const int st = b / 1024, sb = b % 1024, swz = sb ^ (((sb >> 9) & 1) << 5); R = (st >> 1) * 16 + swz / 64; C = (st & 1) * 32 + (swz % 64) / 2; }
__host__ __device__ __forceinline__ int perm32(int rho) { const int n = rho >> 4, i = rho & 15; return 8 * (i >> 2) + 4 * n + (i & 3); }

struct Unit { int pm, pn; };
struct Gemm { const bf16_t* A; const bf16_t* Bt; int M, N, K; };

struct StaticOrder {
    int nM, nN, nwg, G, c;
    __host__ __device__ void init(int M, int N, int G_, int c_) { nM = M / BM; nN = N / BM; nwg = nM * nN; G = G_; c = c_; }
    __host__ __device__ bool next(int i, Unit& u) const {
        const long L = (long)i * G + c; if (L >= nwg) return false;
        int wgid = (int)L; { const int q = nwg / NXCD, r = nwg % NXCD, xcd = wgid % NXCD, off = wgid / NXCD; wgid = (xcd < r ? xcd * (q + 1) : r * (q + 1) + (xcd - r) * q) + off; }
        const int nig = WGM * nN, gid = wgid / nig, fm = gid * WGM, gsz = (nM - fm) < WGM ? (nM - fm) : WGM;
        u.pm = fm + ((wgid % nig) % gsz); u.pn = (wgid % nig) / gsz; return true;
    }
    __device__ __forceinline__ void a_ready(const Unit&) const {}
    __device__ __forceinline__ void done(const Unit&) const {}
};

__device__ __forceinline__ unsigned cvt_pk_bf16(float lo, float hi) { unsigned r; asm volatile("v_cvt_pk_bf16_f32 %0, %1, %2" : "=v"(r) : "v"(lo), "v"(hi)); return r; }
typedef float f32x2 __attribute__((ext_vector_type(2)));
__device__ __forceinline__ f32x2 gelu_pk(f32x2 v) {
    const f32x2 av = __builtin_elementwise_abs(v), d = av * 0.2316418882f + 1.0f;
    f32x2 t; t.x = __builtin_amdgcn_rcpf(d.x); t.y = __builtin_amdgcn_rcpf(d.y);
    f32x2 q = t * 0.5307027145f + (-0.7265760135f); q = q * t + 0.7107068705f; q = q * t + (-0.142248368f); q = q * t + 0.127414796f; q = q * t;
    const f32x2 s = (v * v) * (-0.72134752044f);
    f32x2 e; e.x = __builtin_amdgcn_exp2f(s.x); e.y = __builtin_amdgcn_exp2f(s.y);
    const f32x2 m = v * (q * e), r = v - m;
    f32x2 o; o.x = v.x < 0.f ? m.x : r.x; o.y = v.y < 0.f ? m.y : r.y; return o;
}

template <int ACT  > struct EpiBf16 {
    static constexpr bool PERM = true, AFTER_DRAIN = false, AMAP = false; static_assert(ACT == 0 || ACT == 1, "EpiBf16: ACT is 0 (none) or 1 (gelu_pk)");
    bf16_t* O; int ldc; const float* bias; int split_cols; size_t split_stride; float scale0;
    __device__ __forceinline__ void operator()(const f32x4 (&acc)[2][2][4][2], const Unit& u, int wr, int wc, int fr, int fq) const {
        const int row0 = u.pm * BM + wr * 64 + fr; int colt = u.pn * BM; bf16_t* base = O;
        float sc = 1.f; if (split_cols) { const int t = colt / split_cols; base += (size_t)t * split_stride; colt -= t * split_cols; if (t == 0) sc = scale0; }
        const int col0 = colt + wc * 32 + 8 * fq, bcol0 = u.pn * BM + wc * 32 + 8 * fq;
        f32x4 bv[2][2];
#pragma unroll
        for (int bj = 0; bj < 2; ++bj)
#pragma unroll
            for (int n = 0; n < 2; ++n) bv[bj][n] = bias ? *(const f32x4*)(bias + bcol0 + bj * HALF + 4 * n) : (f32x4){0.f, 0.f, 0.f, 0.f};
#pragma unroll
        for (int ai = 0; ai < 2; ++ai)
#pragma unroll
            for (int m = 0; m < 4; ++m) { bf16_t* rowp = base + (size_t)(row0 + ai * HALF + m * 16) * ldc + col0;
#pragma unroll
                for (int bj = 0; bj < 2; ++bj) { f32x4 v0 = acc[ai][bj][m][0] + bv[bj][0], v1 = acc[ai][bj][m][1] + bv[bj][1];
                    if (ACT == 1) { f32x2 a = gelu_pk((f32x2){v0[0], v0[1]}), b = gelu_pk((f32x2){v0[2], v0[3]}), c = gelu_pk((f32x2){v1[0], v1[1]}), d = gelu_pk((f32x2){v1[2], v1[3]});
                        v0 = (f32x4){a.x, a.y, b.x, b.y}; v1 = (f32x4){c.x, c.y, d.x, d.y}; }
                    v0 = v0 * sc; v1 = v1 * sc; u32x4 w; w.x = cvt_pk_bf16(v0[0], v0[1]); w.y = cvt_pk_bf16(v0[2], v0[3]); w.z = cvt_pk_bf16(v1[0], v1[1]); w.w = cvt_pk_bf16(v1[2], v1[3]);
                    *(u32x4*)(rowp + bj * HALF) = w; } }
    }
};
template <class Epi, class Sched, bool ALIGN_EPI = false, bool SP2 = false>
__device__ __forceinline__ void gemm_phase(PG8_LAS unsigned char* lds, const Gemm g, const Sched& S, const Epi& E) {
    int tid_l = threadIdx.x; asm volatile("" : "+v"(tid_l));
    const int tid = tid_l, wid = __builtin_amdgcn_readfirstlane(tid >> 6), lane = tid & 63, wr = wid >> 2, wc = wid & 3, fr = lane & 15, fq = lane >> 4;
    const int K = g.K, nt = K / BK;
    unsigned voffA[2], voffB[2];
#pragma unroll
    for (int i = 0; i < 2; ++i) { int R, C; stage_rc(tid * 16 + i * 8192, R, C); const int Rb = Epi::PERM ? ((R & ~31) + perm32(R & 31)) : R;
        const int Ra = Epi::AMAP ? (128 * (R >> 6) + (R & 63)) : R;
        voffA[i] = (unsigned)(Ra * K + C) * 2u; voffB[i] = (unsigned)(Rb * K + C) * 2u; }
    const size_t kstep = (size_t)(BK * 2);
    const size_t hstep = (size_t)HALF * K * 2;
    const size_t hstepA = Epi::AMAP ? (size_t)64 * K * 2 : hstep;
    const size_t tstep = 2 * hstep;
    const unsigned ldsw = (unsigned)wid * 1024u;
    const int aoff = lds_byte(wr * 64 + fr, fq * 8), boff = lds_byte(wc * 32 + fr, fq * 8);
#define PG8_SA(b, h) (((b) * 2 + (h)) * HTB)
#define PG8_SB(b, h) ((4 + (b) * 2 + (h)) * HTB)
#define PG8_STAGE(bufoff, gbase, voff) do { _Pragma("unroll") for (int _i = 0; _i < 2; ++_i) \
        __builtin_amdgcn_global_load_lds((const unsigned*)((const char*)(gbase) + (voff)[_i]), (PG8_LAS unsigned*)(lds + (bufoff) + ldsw + _i * 8192), 16, 0, 0); } while (0)
#define PG8_LDA(dst, b, h) do { _Pragma("unroll") for (int m = 0; m < 4; ++m) _Pragma("unroll") for (int k = 0; k < 2; ++k) dst[m][k] = *(const PG8_LAS bf16x8*)(lds + PG8_SA(b, h) + aoff + m * 2048 + k * 1024); } while (0)
#define PG8_LDB(dst, b, h) do { _Pragma("unroll") for (int n = 0; n < 2; ++n) _Pragma("unroll") for (int k = 0; k < 2; ++k) dst[n][k] = *(const PG8_LAS bf16x8*)(lds + PG8_SB(b, h) + boff + n * 2048 + k * 1024); } while (0)
#define PG8_MMA(ai, bj, At, Bt) do { __builtin_amdgcn_s_setprio(1); _Pragma("unroll") for (int m = 0; m < 4; ++m) _Pragma("unroll") for (int n = 0; n < 2; ++n) _Pragma("unroll") for (int k = 0; k < 2; ++k) \
        acc[ai][bj][m][n] = __builtin_amdgcn_mfma_f32_16x16x32_bf16(Bt[n][k], At[m][k], acc[ai][bj][m][n], 0, 0, 0); __builtin_amdgcn_s_setprio(0); } while (0)
#define PG8_WAIT_V(n) asm volatile("s_waitcnt vmcnt(" #n ")" ::: "memory")
#define PG8_WAIT_L(n) asm volatile("s_waitcnt lgkmcnt(" #n ")" ::: "memory")
#define PG8_BAR __builtin_amdgcn_s_barrier()
#define PG8_SCHED __builtin_amdgcn_sched_barrier(0)
    Unit cur, nxt; int ui = 0;
    if (!S.next(0, cur)) return;
    f32x4 acc[2][2][4][2];
#pragma unroll
    for (int a = 0; a < 2; ++a)
#pragma unroll
        for (int b = 0; b < 2; ++b)
#pragma unroll
            for (int m = 0; m < 4; ++m)
#pragma unroll
                for (int n = 0; n < 2; ++n) acc[a][b][m][n] = (f32x4){0.f, 0.f, 0.f, 0.f};
    bf16x8 At[4][2], B0[2][2], B1[2][2];
    const char* cA = (const char*)g.A + (size_t)cur.pm * tstep; const char* cB = (const char*)g.Bt + (size_t)cur.pn * tstep;
    S.a_ready(cur);
    if constexpr (SP2) {
        PG8_STAGE(PG8_SB(0, 0), cB, voffB); PG8_STAGE(PG8_SB(0, 1), cB + hstep, voffB); PG8_STAGE(PG8_SA(0, 0), cA, voffA); PG8_STAGE(PG8_SA(0, 1), cA + hstepA, voffA);
        if (wr == 1) PG8_BAR;
        PG8_WAIT_V(2); PG8_BAR;
        PG8_STAGE(PG8_SB(1, 0), cB + kstep, voffB); PG8_STAGE(PG8_SA(1, 0), cA + kstep, voffA); PG8_STAGE(PG8_SB(1, 1), cB + hstep + kstep, voffB);
        PG8_WAIT_V(6); PG8_BAR;
    } else {
        PG8_STAGE(PG8_SB(0, 0), cB, voffB); PG8_STAGE(PG8_SA(0, 0), cA, voffA); PG8_STAGE(PG8_SB(0, 1), cB + hstep, voffB); PG8_STAGE(PG8_SA(0, 1), cA + hstepA, voffA);
        if (wr == 1) PG8_BAR;
        PG8_WAIT_V(4); PG8_BAR;
        PG8_STAGE(PG8_SB(1, 0), cB + kstep, voffB); PG8_STAGE(PG8_SA(1, 0), cA + kstep, voffA); PG8_STAGE(PG8_SB(1, 1), cB + hstep + kstep, voffB);
        PG8_WAIT_V(6); PG8_BAR;
    }
    for (;;) {
        const bool has_next = S.next(ui + 1, nxt);
        const char* nA = has_next ? (const char*)g.A + (size_t)nxt.pm * tstep : cA; const char* nB = has_next ? (const char*)g.Bt + (size_t)nxt.pn * tstep : cB;
        for (int t = 0; t < nt; t += 2) {
            const bool last = (t == nt - 2);
            const char* a1 = cA + (size_t)(t + 1) * kstep;
            const char* a2 = last ? nA : cA + (size_t)(t + 2) * kstep; const char* b2 = last ? nB : cB + (size_t)(t + 2) * kstep;
            const char* a3 = a2 + kstep; const char* b3 = b2 + kstep;
            if (last && has_next) S.a_ready(nxt);
            if constexpr (SP2) {
            PG8_LDB(B0, 0, 0); PG8_LDB(B1, 0, 1); PG8_SCHED; PG8_LDA(At, 0, 0); PG8_STAGE(PG8_SA(1, 1), a1 + hstepA, voffA);
            PG8_WAIT_V(8); PG8_WAIT_L(0); PG8_BAR; PG8_MMA(0, 0, At, B0); PG8_MMA(0, 1, At, B1); PG8_BAR; PG8_SCHED;
            PG8_LDA(At, 0, 1); PG8_STAGE(PG8_SB(0, 0), b2, voffB); PG8_STAGE(PG8_SB(0, 1), b2 + hstep, voffB); PG8_STAGE(PG8_SA(0, 0), a2, voffA);
            PG8_WAIT_V(8); PG8_WAIT_L(0); PG8_BAR; PG8_MMA(1, 0, At, B0); PG8_MMA(1, 1, At, B1); PG8_BAR; PG8_SCHED;
            PG8_LDB(B0, 1, 0); PG8_LDB(B1, 1, 1); PG8_SCHED; PG8_LDA(At, 1, 0); PG8_STAGE(PG8_SA(0, 1), a2 + hstepA, voffA);
            PG8_WAIT_V(8); PG8_WAIT_L(0); PG8_BAR; PG8_MMA(0, 0, At, B0); PG8_MMA(0, 1, At, B1); PG8_BAR; PG8_SCHED;
            PG8_LDA(At, 1, 1); PG8_STAGE(PG8_SB(1, 0), b3, voffB); PG8_STAGE(PG8_SB(1, 1), b3 + hstep, voffB); PG8_STAGE(PG8_SA(1, 0), a3, voffA);
            PG8_WAIT_V(8); PG8_WAIT_L(0); PG8_BAR; PG8_MMA(1, 0, At, B0); PG8_MMA(1, 1, At, B1); PG8_BAR; PG8_SCHED;
            } else {
            PG8_LDB(B0, 0, 0); PG8_SCHED; PG8_LDA(At, 0, 0); PG8_STAGE(PG8_SA(1, 1), a1 + hstepA, voffA);
            PG8_WAIT_L(8); PG8_BAR; PG8_WAIT_L(0); PG8_MMA(0, 0, At, B0); PG8_BAR; PG8_SCHED;
            PG8_LDB(B1, 0, 1); PG8_STAGE(PG8_SB(0, 0), b2, voffB);
            PG8_BAR; PG8_WAIT_L(0); PG8_MMA(0, 1, At, B1); PG8_BAR;
            PG8_LDA(At, 0, 1); PG8_STAGE(PG8_SA(0, 0), a2, voffA);
            PG8_BAR; PG8_WAIT_L(0); PG8_MMA(1, 0, At, B0); PG8_BAR; PG8_SCHED;
            PG8_STAGE(PG8_SB(0, 1), b2 + hstep, voffB);
            PG8_WAIT_V(6); PG8_BAR; PG8_MMA(1, 1, At, B1); PG8_BAR;
            PG8_LDB(B0, 1, 0); PG8_SCHED; PG8_LDA(At, 1, 0); PG8_STAGE(PG8_SA(0, 1), a2 + hstepA, voffA);
            PG8_WAIT_L(8); PG8_BAR; PG8_WAIT_L(0); PG8_MMA(0, 0, At, B0); PG8_BAR; PG8_SCHED;
            PG8_LDB(B1, 1, 1); PG8_STAGE(PG8_SB(1, 0), b3, voffB);
            PG8_BAR; PG8_WAIT_L(0); PG8_MMA(0, 1, At, B1); PG8_BAR;
            PG8_LDA(At, 1, 1); PG8_STAGE(PG8_SA(1, 0), a3, voffA);
            PG8_BAR; PG8_WAIT_L(0); PG8_MMA(1, 0, At, B0); PG8_BAR; PG8_SCHED;
            PG8_STAGE(PG8_SB(1, 1), b3 + hstep, voffB);
            PG8_WAIT_V(6); PG8_BAR; PG8_MMA(1, 1, At, B1); PG8_BAR;
            }
        }
        if constexpr (ALIGN_EPI) { if (wr == 0) PG8_BAR; }
        if constexpr (!Epi::AFTER_DRAIN) { E(acc, cur, wr, wc, fr, fq); S.done(cur); }
        if (!has_next) break;
#pragma unroll
        for (int a = 0; a < 2; ++a)
#pragma unroll
            for (int b = 0; b < 2; ++b)
#pragma unroll
                for (int m = 0; m < 4; ++m)
#pragma unroll
                    for (int n = 0; n < 2; ++n) acc[a][b][m][n] = (f32x4){0.f, 0.f, 0.f, 0.f};
        cur = nxt; cA = nA; cB = nB; ++ui;
        if constexpr (ALIGN_EPI) { if (wr == 1) PG8_BAR; }
    }
    PG8_WAIT_V(0);
    if constexpr (!ALIGN_EPI) { if (wr == 0) PG8_BAR; }
    PG8_BAR;
    if constexpr (Epi::AFTER_DRAIN) { E.fused(acc, cur, wr, wc, fr, fq, lds, wid, lane); S.done(cur); }
#undef PG8_SA
#undef PG8_SB
#undef PG8_STAGE
#undef PG8_LDA
#undef PG8_LDB
#undef PG8_MMA
#undef PG8_WAIT_V
#undef PG8_WAIT_L
#undef PG8_BAR
#undef PG8_SCHED
}
}

#ifndef PG8_SP2
#define PG8_SP2 true
#endif
#ifndef PG8_ALIGN
#define PG8_ALIGN true
#endif

constexpr int NWAVES = 8, NTHR = 512;
constexpr int BATCH = 8, SEQ = 4096, DM = 1024, TOK = BATCH * SEQ;
constexpr int NQKVA = 4608, AW = 512, NKVQ = 3072, FF = 2816, NUP = 5632;
constexpr float LOG2E = 1.4426950408889634f;
constexpr float C2 = 0.125f * LOG2E;
constexpr float RMS_EPS = 1e-6f, SUBLN_EPS = 1e-5f;
constexpr float LAMBDA_INIT = 0.8f - 0.6f * 0.7408182206817179f;

constexpr size_t MiB = 1u << 20;
constexpr size_t WS_WIN = 1 * MiB, WS_WOA = 10 * MiB, WS_WKVQ = 11 * MiB, WS_WOB = 17 * MiB, WS_WUP0 = 19 * MiB, WS_WUP1 = 30 * MiB;
constexpr size_t WS_WDN0 = 41 * MiB, WS_WDN1 = WS_WDN0 + (size_t)DM * FF * 2;
constexpr size_t WS_TABB = 63 * MiB, WS_TABA = WS_TABB + 256 * 1024;
constexpr size_t WS_PAR = 62 * MiB;
constexpr int PAR_NORMG = 0, PAR_CONVW = 8 * 1024, PAR_CONVB = PAR_CONVW + 6 * 5632, PAR_LAM = PAR_CONVB + 2 * 5632, PAR_SUBG = PAR_LAM + 256, PAR_END = PAR_SUBG + 128;
constexpr size_t WS_XN = 64 * MiB;
constexpr size_t WS_BIG = 128 * MiB;
constexpr size_t WS_GATED = 128 * MiB, WS_PART = 304 * MiB, WS_LAST = 316 * MiB, WS_MIX = 448 * MiB;
constexpr size_t WS_END = 512 * MiB;
constexpr int TABB_STRIDE = 64 + SEQ;

constexpr int LDS_BYTES = 147456;
constexpr int LDS_MISC_OFF = 131072 + 320;
constexpr size_t WS_CTL = 0, CTL_ZERO_BYTES = 65536;

#define GAS __attribute__((address_space(1)))
#define LAS __attribute__((address_space(3)))
typedef unsigned short bf16;
typedef unsigned v4u __attribute__((ext_vector_type(4)));
typedef unsigned v2u __attribute__((ext_vector_type(2)));
typedef float f32x4 __attribute__((ext_vector_type(4)));
#define LDS_WAIT() asm volatile("s_waitcnt lgkmcnt(0)" ::: "memory")
#define LAUNDER_V(x) asm volatile("" : "+v"(x))
#define LAUNDER_S(x) asm volatile("" : "+s"(x))
__device__ __forceinline__ unsigned f2bf(float f) { unsigned u = __builtin_bit_cast(unsigned, f); return (u + 0x7fffu + ((u >> 16) & 1u)) >> 16; }
__device__ __forceinline__ unsigned pk2(float lo, float hi) { return f2bf(lo) | (f2bf(hi) << 16); }
__device__ __forceinline__ float bflo(unsigned w) { return __uint_as_float(w << 16); }
__device__ __forceinline__ float bfhi(unsigned w) { return __uint_as_float(w & 0xffff0000u); }
__device__ __forceinline__ float wave_sum(float v) {
#pragma unroll
    for (int o = 1; o < 64; o <<= 1) v += __shfl_xor(v, o);
    return v;
}
__device__ __forceinline__ int t5_bucket(int n) {
    if (n < 16) return n;
    return 16 + (n >= 22) + (n >= 30) + (n >= 40) + (n >= 54) + (n >= 73) + (n >= 99) + (n >= 134) + (n >= 182) + (n >= 246) + (n >= 332) + (n >= 450) + (n >= 609) + (n >= 825) + (n >= 1117) + (n >= 1513);
}

#define PHASE_IDS \
    int tid_ = threadIdx.x; LAUNDER_V(tid_); const int lane = tid_ & 63, wave = __builtin_amdgcn_readfirstlane(tid_ >> 6); \
    const int G_ = gridDim.x, bx_ = blockIdx.x; const int vcu_ = (G_ % 8 == 0) ? (bx_ % 8) * (G_ / 8) + bx_ / 8 : bx_; \
    const int gw = vcu_ * NWAVES + wave, ngw = G_ * NWAVES, gtid = bx_ * NTHR + tid_, gstride = G_ * NTHR; \
    (void)lane; (void)wave; (void)gw; (void)ngw; (void)gtid; (void)gstride;

struct Args {
    const float* in[19]; float* out; unsigned char* ws; int ph_lo, ph_hi;
};

__device__ __forceinline__ void tr_item(const float* W, int K, int N, bf16* WT, int k0, int n0, int drow0, const float* gk, float cs, LAS float* scr, int lane) {
#pragma unroll 8
    for (int i = 0; i < 32; ++i) { const int kk = 2 * i + (lane >> 5); const float g = gk ? gk[k0 + kk] : 1.f;
        scr[kk * 33 + (lane & 31)] = W[(size_t)(k0 + kk) * N + n0 + (lane & 31)] * (g * cs); }
    LDS_WAIT(); asm volatile("" ::: "memory");
    const int c = lane & 7;
#pragma unroll
    for (int j = 0; j < 4; ++j) { const int n = (lane >> 3) + 8 * j; const LAS float* s = scr + (8 * c) * 33 + n;
        v4u o; o.x = pk2(s[0 * 33], s[1 * 33]); o.y = pk2(s[2 * 33], s[3 * 33]); o.z = pk2(s[4 * 33], s[5 * 33]); o.w = pk2(s[6 * 33], s[7 * 33]);
        *(v4u*)(WT + (size_t)(drow0 + n) * K + k0 + 8 * c) = o; }
    LDS_WAIT(); asm volatile("" ::: "memory");
}
__device__ __forceinline__ void tr_mat(int r, const float* W, int K, int N, bf16* WT, int rowoff, const float* gk, int kind, LAS float* scr, int lane) {
    const int nblk = N / 32, kb = r / nblk, nb = r % nblk, n0 = nb * 32; int dr = n0; float cs = 1.f;
    if (kind == 1) cs = ((n0 % 1536) < 512) ? C2 : 1.f;
    if (kind == 2) cs = C2;
    if (kind == 3) dr = (n0 < FF) ? 256 * (n0 / 128) + (n0 % 128) : 256 * ((n0 - FF) / 128) + 128 + ((n0 - FF) % 128);
    tr_item(W, K, N, WT, kb * 64, n0, dr + rowoff, gk, cs, scr, lane);
}

__device__ __forceinline__ void prologue(const Args& a, LAS unsigned char* lds) {
    PHASE_IDS
    LAS float* scr = (LAS float*)(lds + wave * 16384);
    unsigned char* ws = a.ws;
    const float* norm_g = a.in[2];
    constexpr int I_WIN = 16 * 144, I_WOA = 8 * 32, I_SQ = 16 * 32, I_UP = 16 * 176, I_DN = 44 * 32;
    constexpr int NITEMS = I_WIN + I_WOA + 4 * I_SQ + 2 * I_UP + 2 * I_DN;
    for (int it = gw; it < NITEMS; it += ngw) {
        int r = it;
        if (r < I_WIN) { tr_mat(r, a.in[3], DM, NQKVA, (bf16*)(ws + WS_WIN), 0, norm_g + 0 * DM, 1, scr, lane); continue; } r -= I_WIN;
        if (r < I_WOA) { tr_mat(r, a.in[4], AW, DM, (bf16*)(ws + WS_WOA), 0, nullptr, 0, scr, lane); continue; } r -= I_WOA;
        if (r < I_SQ) { tr_mat(r, a.in[6], DM, DM, (bf16*)(ws + WS_WKVQ), 0, a.in[5], 0, scr, lane); continue; } r -= I_SQ;
        if (r < I_SQ) { tr_mat(r, a.in[7], DM, DM, (bf16*)(ws + WS_WKVQ), 1024, a.in[5], 0, scr, lane); continue; } r -= I_SQ;
        if (r < I_SQ) { tr_mat(r, a.in[8], DM, DM, (bf16*)(ws + WS_WKVQ), 2048, norm_g + 4 * DM, 2, scr, lane); continue; } r -= I_SQ;
        if (r < I_SQ) { tr_mat(r, a.in[14], DM, DM, (bf16*)(ws + WS_WOB), 0, nullptr, 0, scr, lane); continue; } r -= I_SQ;
        if (r < I_UP) { tr_mat(r, a.in[15], DM, NUP, (bf16*)(ws + WS_WUP0), 0, norm_g + 2 * DM, 3, scr, lane); continue; } r -= I_UP;
        if (r < I_UP) { tr_mat(r, a.in[15] + (size_t)DM * NUP, DM, NUP, (bf16*)(ws + WS_WUP1), 0, norm_g + 6 * DM, 3, scr, lane); continue; } r -= I_UP;
        if (r < I_DN) { tr_mat(r, a.in[18], FF, DM, (bf16*)(ws + WS_WDN0), 0, nullptr, 0, scr, lane); continue; } r -= I_DN;
        tr_mat(r, a.in[18] + (size_t)FF * DM, FF, DM, (bf16*)(ws + WS_WDN1), 0, nullptr, 0, scr, lane);
    }
    { float* par = (float*)(ws + WS_PAR); const int gt0 = gw * 64 + lane, ngt0 = ngw * 64;
      for (int i = gt0; i < PAR_END; i += ngt0) { float v;
        if (i < PAR_CONVW) v = a.in[2][i]; else if (i < PAR_CONVB) v = a.in[16][i - PAR_CONVW]; else if (i < PAR_LAM) v = a.in[17][i - PAR_CONVB];
        else if (i < PAR_SUBG) { const int k = i - PAR_LAM; v = a.in[9 + (k >> 6)][k & 63]; } else v = a.in[13][i - PAR_SUBG];
        par[i] = v; } }
    const float* table = a.in[1];
    float* tabB = (float*)(ws + WS_TABB); float* tabA = (float*)(ws + WS_TABA);
    const int gt = gw * 64 + lane, ngt = ngw * 64;
    for (int i = gt; i < 8 * TABB_STRIDE; i += ngt) { const int h = i / TABB_STRIDE, d = i % TABB_STRIDE - 64; tabB[i] = d < 0 ? 0.f : table[h * 32 + t5_bucket(d)] * LOG2E; }
    for (int i = gt; i < 3 * 8 * 132; i += ngt) { const int g = i / (8 * 132), h = (i / 132) % 8, du = i % 132; const int r = 1 << (2 * g);
        tabA[i] = du <= 128 ? table[h * 32 + t5_bucket(du * r)] * LOG2E : 0.f; }
    const float* x = a.in[0]; bf16* XN = (bf16*)(ws + WS_XN);
    for (int m = gw; m < TOK; m += ngw) {
        const f32x4* xr = (const f32x4*)(x + (size_t)m * DM) + lane; f32x4 v[4]; float s = 0.f;
#pragma unroll
        for (int j = 0; j < 4; ++j) { v[j] = xr[64 * j]; s += (v[j].x * v[j].x + v[j].y * v[j].y) + (v[j].z * v[j].z + v[j].w * v[j].w); }
        const float rs = 1.f / sqrtf(wave_sum(s) * (1.f / DM) + RMS_EPS);
        v2u* o8 = (v2u*)(XN + (size_t)m * DM) + lane;
#pragma unroll
        for (int j = 0; j < 4; ++j) { v2u w; w.x = pk2(v[j].x * rs, v[j].y * rs); w.y = pk2(v[j].z * rs, v[j].w * rs); o8[64 * j] = w; }
    }
}

__device__ __forceinline__ void rowpass(const bf16* mix, const float* g, const float* hin, float* hout, bf16* xn) {
    PHASE_IDS
    for (int m = gw; m < TOK; m += ngw) {
        const v2u* mr = (const v2u*)(mix + (size_t)m * DM) + lane; f32x4 v[4]; float s = 0.f;
#pragma unroll
        for (int j = 0; j < 4; ++j) { const v2u w = mr[64 * j]; v[j] = (f32x4){bflo(w.x), bfhi(w.x), bflo(w.y), bfhi(w.y)};
            s += (v[j].x * v[j].x + v[j].y * v[j].y) + (v[j].z * v[j].z + v[j].w * v[j].w); }
        const float rs = 1.f / sqrtf(wave_sum(s) * (1.f / DM) + RMS_EPS);
        const f32x4* gr = (const f32x4*)g + lane; const f32x4* hr = (const f32x4*)(hin + (size_t)m * DM) + lane; f32x4* ho = (f32x4*)(hout + (size_t)m * DM) + lane;
        float s2 = 0.f;
#pragma unroll
        for (int j = 0; j < 4; ++j) { const f32x4 gv = gr[64 * j], hv = hr[64 * j]; v[j] = hv + v[j] * rs * gv; ho[64 * j] = v[j];
            s2 += (v[j].x * v[j].x + v[j].y * v[j].y) + (v[j].z * v[j].z + v[j].w * v[j].w); }
        if (xn) {
            const float rs2 = 1.f / sqrtf(wave_sum(s2) * (1.f / DM) + RMS_EPS);
            v2u* o8 = (v2u*)(xn + (size_t)m * DM) + lane;
#pragma unroll
            for (int j = 0; j < 4; ++j) { v2u w; w.x = pk2(v[j].x * rs2, v[j].y * rs2); w.y = pk2(v[j].z * rs2, v[j].w * rs2); o8[64 * j] = w; }
        }
    }
}

__device__ __forceinline__ void ld8(const bf16* p, float* f) { const v4u w = *(const v4u*)p; f[0] = bflo(w.x); f[1] = bfhi(w.x); f[2] = bflo(w.y); f[3] = bfhi(w.y); f[4] = bflo(w.z); f[5] = bfhi(w.z); f[6] = bflo(w.w); f[7] = bfhi(w.w); }

namespace da {
typedef short bf16x8 __attribute__((ext_vector_type(8)));
typedef short s16x4 __attribute__((ext_vector_type(4)));
typedef short v4i16_t __attribute__((ext_vector_type(4)));
typedef float f32x16 __attribute__((ext_vector_type(16)));
typedef float f32x2_t __attribute__((ext_vector_type(2))); typedef __bf16 bf16x2_t __attribute__((ext_vector_type(2)));
constexpr int KBUF = 0, VBUF = 32768, TABL = 65536, TABL_FLOATS = 128 + SEQ, XCH = 0;
__device__ __forceinline__ unsigned cvtpk(float lo, float hi) { f32x2_t v = {lo, hi}; bf16x2_t b = __builtin_convertvector(v, bf16x2_t); return __builtin_bit_cast(unsigned, b); }
__device__ __forceinline__ s16x4 vtr(const LAS unsigned char* p) { return __builtin_bit_cast(s16x4, __builtin_amdgcn_ds_read_tr16_b64_v4i16((LAS v4i16_t*)p)); }
__device__ __forceinline__ float swapmax(float v) { auto rr = __builtin_amdgcn_permlane32_swap(__float_as_uint(v), __float_as_uint(v), false, false); return fmaxf(__uint_as_float(rr[0]), __uint_as_float(rr[1])); }
__device__ __forceinline__ float swapsum(float v) { auto rr = __builtin_amdgcn_permlane32_swap(__float_as_uint(v), __float_as_uint(v), false, false); return __uint_as_float(rr[0]) + __uint_as_float(rr[1]); }
#define DA_CST0(r) (((r) & 3) + 8 * ((r) >> 2))

__device__ __forceinline__ void diff_unit(int b, int h, int qblk, const bf16* kvq, float lam, const float* subg, bf16* Ob, LAS unsigned char* lds, int wave, int lane) {
    const int r32 = lane & 31, hi = lane >> 5, qt = wave >> 1, c = wave & 1;
    const int q0 = qblk * 128 + qt * 32, NT = 2 * qblk + 2;
    const size_t rowb = (size_t)b * SEQ;
    const LAS float* tabL = (const LAS float*)(lds + TABL);
    bf16x8 qf[4];
    { const bf16* qp = kvq + (rowb + q0 + r32) * NKVQ + 2048 + h * 128 + c * 64 + hi * 8;
#pragma unroll
      for (int d0 = 0; d0 < 4; ++d0) qf[d0] = *(const bf16x8*)(qp + 16 * d0); }
    const bf16* ksrc = kvq + (rowb + lane) * NKVQ + h * 128 + wave * 8;
    const bf16* vsrc = kvq + (rowb + 16 * (wave & 3) + (lane >> 2)) * NKVQ + 1024 + h * 128 + (wave >> 2) * 32 + (lane & 3) * 8;
    const int sdst = wave * 1024 + lane * 16;
    const LAS unsigned char* vb0 = lds + VBUF + ((lane >> 4) & 1) * 32 + (lane & 3) * 8 + (4 * hi + ((lane & 15) >> 2)) * 64;
    f32x16 o[4];
#pragma unroll
    for (int i = 0; i < 4; ++i)
#pragma unroll
        for (int r = 0; r < 16; ++r) o[i][r] = 0.f;
    float m = -INFINITY, l = 0.f;
    v4u kr0, kr1, vr0, vr1;
    kr0 = *(const v4u*)ksrc; kr1 = *(const v4u*)(ksrc + 64); vr0 = *(const v4u*)vsrc; vr1 = *(const v4u*)(vsrc + 64);
    *(LAS v4u*)(lds + KBUF + sdst) = kr0; *(LAS v4u*)(lds + KBUF + 8192 + sdst) = kr1; *(LAS v4u*)(lds + VBUF + sdst) = vr0; *(LAS v4u*)(lds + VBUF + 8192 + sdst) = vr1;
    __syncthreads();
#pragma unroll 1
    for (int kt = 0; kt < NT; ++kt) {
        const int buf = kt & 1; const bool more = kt + 1 < NT;
        if (more) { const size_t off = (size_t)(kt + 1) * 64 * NKVQ; kr0 = *(const v4u*)(ksrc + off); kr1 = *(const v4u*)(ksrc + off + 64); vr0 = *(const v4u*)(vsrc + off); vr1 = *(const v4u*)(vsrc + off + 64); }
        if (64 * kt <= q0 + 31) {
            const int idx0 = q0 + r32 - 64 * kt - 4 * hi;
            const LAS float* tb = tabL + (128 - 59) + idx0;
            f32x16 p0, p1;
#pragma unroll
            for (int r = 0; r < 16; ++r) { p0[r] = tb[59 - DA_CST0(r)]; p1[r] = tb[27 - DA_CST0(r)]; }
            const LAS unsigned char* kb = lds + KBUF + buf * 16384 + (8 * c + hi) * 1024 + r32 * 16;
            bf16x8 ka[8];
#pragma unroll
            for (int d0 = 0; d0 < 4; ++d0) { ka[2 * d0] = *(const LAS bf16x8*)(kb + d0 * 2048); ka[2 * d0 + 1] = *(const LAS bf16x8*)(kb + d0 * 2048 + 512); }
            const LAS unsigned char* vb = vb0 + buf * 16384;
            s16x4 va[8], vc[8];
#define DA_VREAD(dst, db) do { _Pragma("unroll") for (int ks = 0; ks < 4; ++ks) { dst[2 * ks] = vtr(vb + (db) * 4096 + ks * 1024); dst[2 * ks + 1] = vtr(vb + (db) * 4096 + ks * 1024 + 512); } } while (0)
#define DA_PV(src, db) do { _Pragma("unroll") for (int ks = 0; ks < 4; ++ks) { const bf16x8 vf = (bf16x8){src[2 * ks][0], src[2 * ks][1], src[2 * ks][2], src[2 * ks][3], src[2 * ks + 1][0], src[2 * ks + 1][1], src[2 * ks + 1][2], src[2 * ks + 1][3]}; \
                o[db] = __builtin_amdgcn_mfma_f32_32x32x16_bf16(vf, __builtin_bit_cast(bf16x8, pw[ks]), o[db], 0, 0, 0); } } while (0)
#define DA_SB() __builtin_amdgcn_sched_barrier(0)
            DA_VREAD(va, 0);
            DA_SB();
#pragma unroll
            for (int d0 = 0; d0 < 4; ++d0) { p0 = __builtin_amdgcn_mfma_f32_32x32x16_bf16(ka[2 * d0], qf[d0], p0, 0, 0, 0); p1 = __builtin_amdgcn_mfma_f32_32x32x16_bf16(ka[2 * d0 + 1], qf[d0], p1, 0, 0, 0); }
            DA_VREAD(vc, 1);
            DA_SB();
            if (64 * kt + 63 > q0) {
#pragma unroll
                for (int r = 0; r < 16; ++r) { if (DA_CST0(r) > idx0) p0[r] = -INFINITY; if (32 + DA_CST0(r) > idx0) p1[r] = -INFINITY; }
            }
            float rm = fmaxf(p0[0], p1[0]);
#pragma unroll
            for (int r = 1; r < 16; ++r) rm = fmaxf(rm, fmaxf(p0[r], p1[r]));
            rm = swapmax(rm);
            if (__any(rm > m + 8.f)) {
                const float mn = fmaxf(m, rm); const float al = __builtin_amdgcn_exp2f(m - mn); m = mn; l *= al;
#pragma unroll
                for (int i = 0; i < 4; ++i)
#pragma unroll
                    for (int r = 0; r < 16; ++r) o[i][r] *= al;
            }
            float ls = 0.f;
#pragma unroll
            for (int r = 0; r < 16; ++r) { p0[r] = __builtin_amdgcn_exp2f(p0[r] - m); p1[r] = __builtin_amdgcn_exp2f(p1[r] - m); ls += p0[r] + p1[r]; }
            l += ls;
            v4u pw[4];
#pragma unroll
            for (int x = 0; x < 4; ++x) { pw[0][x] = cvtpk(p0[2 * x], p0[2 * x + 1]); pw[1][x] = cvtpk(p0[8 + 2 * x], p0[9 + 2 * x]); pw[2][x] = cvtpk(p1[2 * x], p1[2 * x + 1]); pw[3][x] = cvtpk(p1[8 + 2 * x], p1[9 + 2 * x]); }
            DA_SB();
            DA_PV(va, 0); DA_VREAD(va, 2); DA_SB();
            DA_PV(vc, 1); DA_VREAD(vc, 3); DA_SB();
            DA_PV(va, 2); DA_SB();
            DA_PV(vc, 3);
#undef DA_VREAD
#undef DA_PV
#undef DA_SB
        }
        if (more) { const int nb = (buf ^ 1) * 16384; *(LAS v4u*)(lds + KBUF + nb + sdst) = kr0; *(LAS v4u*)(lds + KBUF + nb + 8192 + sdst) = kr1; *(LAS v4u*)(lds + VBUF + nb + sdst) = vr0; *(LAS v4u*)(lds + VBUF + nb + 8192 + sdst) = vr1; }
        __syncthreads();
    }
    const float il = 1.f / swapsum(l);
    LAS float* xch = (LAS float*)(lds + XCH) + (qt * 64) * 64 + lane;
    if (c == 1) {
#pragma unroll
        for (int i = 0; i < 4; ++i)
#pragma unroll
            for (int r = 0; r < 16; ++r) xch[(i * 16 + r) * 64] = o[i][r] * il;
    }
    __syncthreads();
    if (c == 0) {
        float ss = 0.f;
#pragma unroll
        for (int i = 0; i < 4; ++i)
#pragma unroll
            for (int r = 0; r < 16; ++r) { const float v = o[i][r] * il - lam * xch[(i * 16 + r) * 64]; o[i][r] = v; ss += v * v; }
        ss = swapsum(ss);
        const float rs = 1.f / sqrtf(ss * (1.f / 128.f) + SUBLN_EPS) * (1.f - LAMBDA_INIT);
        bf16* op = Ob + (rowb + q0 + r32) * DM + h * 128 + 4 * hi;
#pragma unroll
        for (int i = 0; i < 4; ++i)
#pragma unroll
            for (int rr = 0; rr < 4; ++rr) { const f32x4 sg = *(const f32x4*)(subg + 32 * i + 8 * rr + 4 * hi);
                v2u w; w.x = cvtpk(o[i][4 * rr] * rs * sg.x, o[i][4 * rr + 1] * rs * sg.y); w.y = cvtpk(o[i][4 * rr + 2] * rs * sg.z, o[i][4 * rr + 3] * rs * sg.w);
                *(v2u*)(op + 32 * i + 8 * rr) = w; }
    }
    __syncthreads();
}
}

__device__ __forceinline__ void diff_attn_phase(const bf16* kvq, const float* tabB, const float* par, bf16* Ob, LAS unsigned char* lds) {
    PHASE_IDS
    float lam;
    { const float* lp = par + PAR_LAM; const float p1 = lp[lane] * lp[64 + lane], p2 = lp[128 + lane] * lp[192 + lane]; lam = expf(wave_sum(p1)) - expf(wave_sum(p2)) + LAMBDA_INIT; }
    const float* subg = par + PAR_SUBG;
    const int bh = vcu_ >> 2, j = vcu_ & 3, b = bh >> 3, h = bh & 7;
    { LAS float* tabL = (LAS float*)(lds + da::TABL); const float* src = tabB + h * TABB_STRIDE;
      for (int i = tid_; i < da::TABL_FLOATS; i += NTHR) tabL[i] = i < 64 ? 0.f : src[i - 64]; }
    __syncthreads();
#pragma unroll 1
    for (int u = 0; u < 8; ++u) {
        const int base = 4 * (u >> 1) + j; const int qblk = (u & 1) ? 31 - base : base;
        da::diff_unit(b, h, qblk, kvq, lam, subg, Ob, lds, wave, lane);
    }
}

namespace dl {
using da::bf16x8; using da::s16x4; using da::f32x16; using da::cvtpk; using da::vtr; using da::swapmax; using da::swapsum;
constexpr int STAGE = 0, TAB = 32768;
__device__ __forceinline__ void task(int b, int h, int tb, int g, int ti, const bf16* qkv, bf16* Og, float* LSE, LAS unsigned char* lds, int wave, int lane) {
    const int r32 = lane & 31, hi = lane >> 5;
    const int sh = 2 * g;
    int c, m0;
    if (g == 0) { c = 0; m0 = tb * 512 + 32 * ti; } else if (g == 1) { c = ti & 3; m0 = tb * 128 + 32 * (ti >> 2); } else { c = ti; m0 = tb * 32; }
    const size_t rowb = (size_t)b * SEQ;
    const int gcol = g * 1536 + h * 64;
    const int qtok = ((m0 + r32) << sh) + c;
    bf16x8 qf[4];
    { const bf16* qp = qkv + (rowb + qtok) * NQKVA + gcol + hi * 8;
#pragma unroll
      for (int d0 = 0; d0 < 4; ++d0) qf[d0] = *(const bf16x8*)(qp + 16 * d0); }
    const int jmin = (m0 >= 128) ? 0 : 4 - (m0 >> 5);
    f32x16 o[2];
#pragma unroll
    for (int i = 0; i < 2; ++i)
#pragma unroll
        for (int r = 0; r < 16; ++r) o[i][r] = 0.f;
    float m = -INFINITY, l = 0.f;
    LAS unsigned char* stg = lds + STAGE + wave * 4096;
    const LAS unsigned char* vb = stg + ((lane >> 4) & 1) * 32 + (lane & 3) * 8 + (4 * hi + ((lane & 15) >> 2)) * 64;
    const LAS float* tab = (const LAS float*)(lds + TAB) + g * 132;
    const bf16* kbase = qkv + rowb * NQKVA + gcol + 512 + hi * 8;
    const bf16* vbase = qkv + rowb * NQKVA + gcol + 1024 + (lane & 3) * 8;
    bf16x8 kn[4]; v4u vn[4];
#define DL_LOAD(j) do { const int ku0_ = m0 - 128 + 32 * (j); const bf16* kp_ = kbase + (size_t)(((ku0_ + r32) << sh) + c) * NQKVA; \
        _Pragma("unroll") for (int d0 = 0; d0 < 4; ++d0) kn[d0] = *(const bf16x8*)(kp_ + 16 * d0); \
        _Pragma("unroll") for (int i = 0; i < 4; ++i) vn[i] = *(const v4u*)(vbase + (size_t)(((ku0_ + 16 * (i & 1) + (lane >> 2)) << sh) + c) * NQKVA + 32 * (i >> 1)); } while (0)
    DL_LOAD(jmin);
#pragma unroll 1
    for (int j = jmin; j <= 4; ++j) {
        bf16x8 kf[4]; v4u vv[4];
#pragma unroll
        for (int i = 0; i < 4; ++i) { kf[i] = kn[i]; vv[i] = vn[i]; }
        if (j < 4) DL_LOAD(j + 1);
        f32x16 p;
#pragma unroll
        for (int r = 0; r < 16; ++r) p[r] = 0.f;
#pragma unroll
        for (int d0 = 0; d0 < 4; ++d0) p = __builtin_amdgcn_mfma_f32_32x32x16_bf16(kf[d0], qf[d0], p, 0, 0, 0);
        const int du0 = 128 - 32 * j + r32 - 4 * hi;
        const LAS float* tb = tab + du0 - 27;
#pragma unroll
        for (int r = 0; r < 16; ++r) p[r] += tb[27 - DA_CST0(r)];
        if (j == 0 || j == 4) {
#pragma unroll
            for (int r = 0; r < 16; ++r) { const int du = du0 - DA_CST0(r); if (du < 0 || du > 128) p[r] = -INFINITY; }
        }
        float rm = p[0];
#pragma unroll
        for (int r = 1; r < 16; ++r) rm = fmaxf(rm, p[r]);
        rm = swapmax(rm);
        const float mn = fmaxf(m, rm); const float al = __builtin_amdgcn_exp2f(m - mn); m = mn;
        float ls = 0.f;
#pragma unroll
        for (int r = 0; r < 16; ++r) { p[r] = __builtin_amdgcn_exp2f(p[r] - mn); ls += p[r]; }
        l = l * al + ls;
#pragma unroll
        for (int i = 0; i < 2; ++i)
#pragma unroll
            for (int r = 0; r < 16; ++r) o[i][r] *= al;
        v4u pw[2];
#pragma unroll
        for (int x = 0; x < 4; ++x) { pw[0][x] = cvtpk(p[2 * x], p[2 * x + 1]); pw[1][x] = cvtpk(p[8 + 2 * x], p[9 + 2 * x]); }
#pragma unroll
        for (int i = 0; i < 4; ++i) *(LAS v4u*)(stg + i * 1024 + lane * 16) = vv[i];
#pragma unroll
        for (int db = 0; db < 2; ++db)
#pragma unroll
            for (int ks = 0; ks < 2; ++ks) { const s16x4 lo = vtr(vb + (db * 2 + ks) * 1024), hh = vtr(vb + (db * 2 + ks) * 1024 + 512);
                const bf16x8 vf = (bf16x8){lo[0], lo[1], lo[2], lo[3], hh[0], hh[1], hh[2], hh[3]};
                o[db] = __builtin_amdgcn_mfma_f32_32x32x16_bf16(vf, __builtin_bit_cast(bf16x8, pw[ks]), o[db], 0, 0, 0); }
    }
#undef DL_LOAD
    const float lt = swapsum(l); const float il = 1.f / lt;
    bf16* op = Og + ((size_t)g * TOK + rowb + qtok) * AW + h * 64 + 4 * hi;
#pragma unroll
    for (int i = 0; i < 2; ++i)
#pragma unroll
        for (int rr = 0; rr < 4; ++rr) { v2u w; w.x = cvtpk(o[i][4 * rr] * il, o[i][4 * rr + 1] * il); w.y = cvtpk(o[i][4 * rr + 2] * il, o[i][4 * rr + 3] * il); *(v2u*)(op + 32 * i + 8 * rr) = w; }
    if (hi == 0) LSE[((size_t)g * TOK + rowb + qtok) * 8 + h] = m + __builtin_amdgcn_logf(lt);
}
}

__device__ __forceinline__ void dilated_attn_phase(const bf16* qkv, const float* tabA, bf16* Og, float* LSE, bf16* Oa, LAS unsigned char* lds) {
    PHASE_IDS
#pragma unroll 1
    for (int unit = vcu_; unit < 512; unit += G_) {
        const int b = unit >> 6, h = (unit >> 3) & 7, tb = unit & 7;
        { LAS float* tl = (LAS float*)(lds + dl::TAB); for (int i = tid_; i < 3 * 132; i += NTHR) tl[i] = tabA[((i / 132) * 8 + h) * 132 + (i % 132)]; }
        __syncthreads();
#pragma unroll 1
        for (int i = 0; i < 6; ++i) { const int t = wave + 8 * i; dl::task(b, h, tb, t >> 4, t & 15, qkv, Og, LSE, lds, wave, lane); }
        __syncthreads();
        const size_t tok0 = (size_t)b * SEQ + tb * 512;
#pragma unroll 1
        for (int it = tid_; it < 4096; it += NTHR) { const int tk = it >> 3, ch = it & 7; const size_t tok = tok0 + tk;
            const float l0 = LSE[tok * 8 + h], l1 = LSE[((size_t)TOK + tok) * 8 + h], l2 = LSE[((size_t)2 * TOK + tok) * 8 + h];
            const float mx = fmaxf(l0, fmaxf(l1, l2)); float a0 = __builtin_amdgcn_exp2f(l0 - mx), a1 = __builtin_amdgcn_exp2f(l1 - mx), a2 = __builtin_amdgcn_exp2f(l2 - mx);
            const float inv = 1.f / (a0 + a1 + a2); a0 *= inv; a1 *= inv; a2 *= inv;
            float f0[8], f1[8], f2[8]; ld8(Og + tok * AW + h * 64 + ch * 8, f0); ld8(Og + ((size_t)TOK + tok) * AW + h * 64 + ch * 8, f1); ld8(Og + ((size_t)2 * TOK + tok) * AW + h * 64 + ch * 8, f2);
            float r8[8];
#pragma unroll
            for (int e = 0; e < 8; ++e) r8[e] = a0 * f0[e] + a1 * f1[e] + a2 * f2[e];
            v4u w; w.x = pk2(r8[0], r8[1]); w.y = pk2(r8[2], r8[3]); w.z = pk2(r8[4], r8[5]); w.w = pk2(r8[6], r8[7]);
            *(v4u*)(Oa + tok * AW + h * 64 + ch * 8) = w; }
        __syncthreads();
    }
}

__device__ __forceinline__ float dpp_ror1(float v) { return __builtin_bit_cast(float, __builtin_amdgcn_update_dpp(0, __builtin_bit_cast(int, v), 0x121, 0xf, 0xf, false)); }
__device__ __forceinline__ float dpp_ror2(float v) { return __builtin_bit_cast(float, __builtin_amdgcn_update_dpp(0, __builtin_bit_cast(int, v), 0x122, 0xf, 0xf, false)); }
struct EpiConvGate {
    static constexpr bool PERM = true, AFTER_DRAIN = false, AMAP = true;
    bf16* gated; float* part; float* last; const float* cw; const float* cb;
    __device__ __forceinline__ void operator()(const pg8::f32x4 (&acc)[2][2][4][2], const pg8::Unit& u, int wr, int wc, int fr, int fq) const {
        typedef pg8::f32x4 f4;
        const int blk = u.pm * 2 + wr; const size_t row0 = (size_t)blk * 128;
        const bool is15 = fr == 15, ge14 = fr >= 14;
#pragma unroll
        for (int n = 0; n < 2; ++n) {
            const int j0 = u.pn * 128 + wc * 32 + 8 * fq + 4 * n;
            f4 w[2][3], bb[2];
#pragma unroll
            for (int bj = 0; bj < 2; ++bj) { bb[bj] = *(const f4*)(cb + bj * FF + j0);
#pragma unroll
                for (int jj = 0; jj < 3; ++jj) w[bj][jj] = *(const f4*)(cw + jj * NUP + bj * FF + j0); }
            f4 pv[2] = {(f4){0.f, 0.f, 0.f, 0.f}, (f4){0.f, 0.f, 0.f, 0.f}};
#pragma unroll
            for (int ai = 0; ai < 2; ++ai)
#pragma unroll
                for (int m = 0; m < 4; ++m) {
                    f4 c[2];
#pragma unroll
                    for (int bj = 0; bj < 2; ++bj) { const f4 cur = acc[ai][bj][m][n]; f4 s1, s2;
#pragma unroll
                        for (int e = 0; e < 4; ++e) { s1[e] = dpp_ror1(is15 ? pv[bj][e] : cur[e]); s2[e] = dpp_ror2(ge14 ? pv[bj][e] : cur[e]); }
                        c[bj] = bb[bj] + w[bj][2] * cur + w[bj][1] * s1 + w[bj][0] * s2; pv[bj] = cur; }
                    if (ai == 0 && m == 0 && fr < 2) {
#pragma unroll
                        for (int bj = 0; bj < 2; ++bj) *(f4*)(part + ((size_t)blk * 2 + fr) * NUP + bj * FF + j0) = c[bj];
                    } else {
                        const pg8::f32x2 ga = pg8::gelu_pk((pg8::f32x2){c[0][0], c[0][1]}), gb = pg8::gelu_pk((pg8::f32x2){c[0][2], c[0][3]});
                        v2u o; o.x = pg8::cvt_pk_bf16(ga.x * c[1][0], ga.y * c[1][1]); o.y = pg8::cvt_pk_bf16(gb.x * c[1][2], gb.y * c[1][3]);
                        *(v2u*)(gated + (row0 + 64 * ai + 16 * m + fr) * FF + j0) = o;
                    }
                    if (ai == 1 && m == 3 && ge14) {
#pragma unroll
                        for (int bj = 0; bj < 2; ++bj) *(f4*)(last + ((size_t)blk * 2 + (fr - 14)) * NUP + bj * FF + j0) = acc[1][bj][3][n];
                    }
                }
        }
    }
};
__device__ __forceinline__ void conv_fixup(const float* part, const float* last, const float* cw, bf16* gated) {
    PHASE_IDS
    for (int it = gtid; it < 256 * 2 * 352; it += gstride) {
        const int j = (it % 352) * 8, rho = (it / 352) & 1, blk = it / 704;
        float cg[8], cv[8];
        { const float* pp = part + ((size_t)blk * 2 + rho) * NUP + j;
#pragma unroll
          for (int e = 0; e < 8; ++e) { cg[e] = pp[e]; cv[e] = pp[FF + e]; } }
        if (blk & 31) {
            const float* l0 = last + ((size_t)(blk - 1) * 2) * NUP + j; const float* l1 = l0 + NUP;
#pragma unroll
            for (int e = 0; e < 8; ++e) {
                if (rho == 0) { cg[e] += cw[NUP + j + e] * l1[e] + cw[j + e] * l0[e]; cv[e] += cw[NUP + FF + j + e] * l1[FF + e] + cw[FF + j + e] * l0[FF + e]; }
                else { cg[e] += cw[j + e] * l1[e]; cv[e] += cw[FF + j + e] * l1[FF + e]; } }
        }
        float r[8];
#pragma unroll
        for (int e = 0; e < 8; e += 2) { const pg8::f32x2 g2 = pg8::gelu_pk((pg8::f32x2){cg[e], cg[e + 1]}); r[e] = g2.x * cv[e]; r[e + 1] = g2.y * cv[e + 1]; }
        v4u w; w.x = pk2(r[0], r[1]); w.y = pk2(r[2], r[3]); w.z = pk2(r[4], r[5]); w.w = pk2(r[6], r[7]);
        *(v4u*)(gated + ((size_t)blk * 128 + rho) * FF + j) = w;
    }
}

#define XB_TMO      128
#define XB_XCNT(j)  (256  + 64 * (j))
#define XB_XSUB(j)  (1280 + 64 * (j))
#define XB_XGEN(j)  (2304 + 64 * (j))
#define XB_TOP      3328
#define XB_TOPGEN   3392
#define XCD_BAR_WORDS 3456
#define XB_SPIN_CAP (1u << 18)

__device__ __forceinline__ unsigned xb_ld(unsigned* p)              { return __hip_atomic_load(p, __ATOMIC_RELAXED, __HIP_MEMORY_SCOPE_AGENT); }
__device__ __forceinline__ unsigned xb_add(unsigned* p, unsigned v) { return __hip_atomic_fetch_add(p, v, __ATOMIC_RELAXED, __HIP_MEMORY_SCOPE_AGENT); }
__device__ __forceinline__ unsigned xb_xcc_id() { return (unsigned)__builtin_amdgcn_s_getreg((3 << 11) | 20) & 0xFu; }
#define XB_SPIN(cond, bar) do { unsigned _sp = 0; while (cond) { __builtin_amdgcn_s_sleep(1); \
    if ((++_sp & 255u) == 0u) { if (xb_ld(&(bar)[XB_TMO])) break; if (_sp > XB_SPIN_CAP) { atomicAdd(&(bar)[XB_TMO], 1u); break; } } } } while (0)

struct XcdBarrier {
    unsigned* bar; unsigned x;
    volatile LAS unsigned* st;
};

__device__ __forceinline__ XcdBarrier xcd_barrier_post(unsigned* bar, volatile LAS unsigned* st) {
    XcdBarrier b; b.bar = bar; b.x = xb_xcc_id(); b.st = st;
    if (threadIdx.x == 0) (void)xb_add(&bar[XB_XCNT(b.x)], 1u);
    return b;
}
__device__ __forceinline__ void xcd_barrier_complete(unsigned* bar, unsigned x, unsigned& nloc, unsigned& nx) {
    const unsigned G = gridDim.x * gridDim.y * gridDim.z;
    unsigned sum, cnt, mine, sp = 0u;
    for (;;) {
        sum = 0u; cnt = 0u; mine = 0u;
#pragma unroll
        for (unsigned j = 0; j < 16; ++j) { const unsigned c = xb_ld(&bar[XB_XCNT(j)]); sum += c; cnt += (c > 0u) ? 1u : 0u; mine = (j == x) ? c : mine; }
        if (sum == G) break;
        __builtin_amdgcn_s_sleep(1);
        if ((++sp & 255u) == 0u) { if (xb_ld(&bar[XB_TMO])) break; if (sp > XB_SPIN_CAP) { atomicAdd(&bar[XB_TMO], 1u); break; } }
    }
    nloc = mine > 0u ? mine : 1u; nx = cnt > 0u ? cnt : 1u;
}

__device__ __forceinline__ void xcd_barrier(const XcdBarrier& b) {
    asm volatile("s_waitcnt vmcnt(0)" ::: "memory");
    __syncthreads();
    if (threadIdx.x == 0) {
        unsigned* bar = b.bar;
        __builtin_amdgcn_s_waitcnt(0);
        unsigned nloc = b.st[0], nx = b.st[1];
        if (nloc == 0u) { xcd_barrier_complete(bar, b.x, nloc, nx); b.st[0] = nloc; b.st[1] = nx; }
        const unsigned old = xb_add(&bar[XB_XSUB(b.x)], 1u);
        const unsigned gen = old / nloc;
        if (old + 1u == (gen + 1u) * nloc) {
            __builtin_amdgcn_fence(__ATOMIC_RELEASE, "agent");
            asm volatile("s_waitcnt vmcnt(0)" ::: "memory");
            const unsigned og = xb_add(&bar[XB_TOP], 1u);
            const unsigned tg = og / nx;
            if (og + 1u == (tg + 1u) * nx) xb_add(&bar[XB_TOPGEN], 1u);
            else XB_SPIN(xb_ld(&bar[XB_TOPGEN]) == tg, bar);
            __builtin_amdgcn_fence(__ATOMIC_ACQUIRE, "agent");
            xb_add(&bar[XB_XGEN(b.x)], 1u);
            asm volatile("s_waitcnt vmcnt(0)" ::: "memory");
        } else {
            XB_SPIN(xb_ld(&bar[XB_XGEN(b.x)]) == gen, bar);
            __builtin_amdgcn_fence(__ATOMIC_ACQUIRE, "agent");
            asm volatile("s_waitcnt vmcnt(0)" ::: "memory");
        }
    }
    __syncthreads();
}

namespace cg = cooperative_groups;
#define GEMM_PHASE(A_, B_, M_, N_, K_, O_, LDC_) do { pg8::Gemm g{(const bf16*)(A_), (const bf16*)(B_), M_, N_, K_}; pg8::StaticOrder S; S.init(M_, N_, (int)gridDim.x, (int)blockIdx.x); \
    pg8::EpiBf16<0> E{(bf16*)(O_), LDC_, nullptr, 0, 0, 1.f}; pg8::gemm_phase<pg8::EpiBf16<0>, pg8::StaticOrder, PG8_ALIGN, PG8_SP2>(lds, g, S, E); } while (0)
__global__ void __launch_bounds__(NTHR, 2) fwd(Args a) {
    extern __shared__ __attribute__((aligned(16))) unsigned char lds_raw[];
    LAS unsigned char* lds = (LAS unsigned char*)lds_raw;
    cg::grid_group grid = cg::this_grid();
    { volatile LAS unsigned* misc = (volatile LAS unsigned*)(lds + LDS_MISC_OFF); if (threadIdx.x < 32) misc[threadIdx.x] = 0u; }
    __syncthreads();
    XcdBarrier bar = xcd_barrier_post((unsigned*)(a.ws + WS_CTL) + 1024, (volatile LAS unsigned*)(lds + LDS_MISC_OFF) + 8);
    unsigned char* ws = a.ws;
    prologue(a, lds); grid.sync();
    const float* xin = a.in[0]; float* out = a.out;
#define WSP(T, off) ((T*)(ws + (off)))
#define PARP(off) (WSP(const float, WS_PAR) + (off))
    GEMM_PHASE(WSP(bf16, WS_XN), ws + WS_WIN, TOK, NQKVA, DM, WSP(bf16, WS_BIG), NQKVA); xcd_barrier(bar);
    dilated_attn_phase(WSP(const bf16, WS_BIG), WSP(const float, WS_TABA), WSP(bf16, 416 * MiB), WSP(float, 64 * MiB), WSP(bf16, 68 * MiB), lds); xcd_barrier(bar);
    GEMM_PHASE(WSP(bf16, 68 * MiB), ws + WS_WOA, TOK, DM, AW, WSP(bf16, WS_MIX), DM); xcd_barrier(bar);
    rowpass(WSP(const bf16, WS_MIX), PARP(PAR_NORMG + 1 * DM), xin, out, WSP(bf16, WS_XN)); xcd_barrier(bar);
#pragma unroll 1
    for (int lay = 0; lay < 2; ++lay) {
        if (lay == 1) {
            GEMM_PHASE(WSP(bf16, WS_XN), ws + WS_WKVQ, TOK, NKVQ, DM, WSP(bf16, WS_BIG), NKVQ); xcd_barrier(bar);
            diff_attn_phase(WSP(const bf16, WS_BIG), WSP(const float, WS_TABB), PARP(0), WSP(bf16, 320 * MiB), lds); xcd_barrier(bar);
            GEMM_PHASE(WSP(bf16, 320 * MiB), ws + WS_WOB, TOK, DM, DM, WSP(bf16, WS_MIX), DM); xcd_barrier(bar);
            rowpass(WSP(const bf16, WS_MIX), PARP(PAR_NORMG + 5 * DM), out, out, WSP(bf16, WS_XN)); xcd_barrier(bar);
        }
        { pg8::Gemm g{WSP(const bf16, WS_XN), (const bf16*)(ws + (lay ? WS_WUP1 : WS_WUP0)), TOK, NUP, DM}; pg8::StaticOrder S; S.init(TOK, NUP, (int)gridDim.x, (int)blockIdx.x);
          EpiConvGate E{WSP(bf16, WS_GATED), WSP(float, WS_PART), WSP(float, WS_LAST), PARP(PAR_CONVW + lay * 3 * NUP), PARP(PAR_CONVB + lay * NUP)};
          pg8::gemm_phase<EpiConvGate, pg8::StaticOrder, PG8_ALIGN, PG8_SP2>(lds, g, S, E); }
        xcd_barrier(bar);
        conv_fixup(WSP(const float, WS_PART), WSP(const float, WS_LAST), PARP(PAR_CONVW + lay * 3 * NUP), WSP(bf16, WS_GATED)); xcd_barrier(bar);
        GEMM_PHASE(WSP(bf16, WS_GATED), ws + (lay ? WS_WDN1 : WS_WDN0), TOK, DM, FF, WSP(bf16, WS_MIX), DM); xcd_barrier(bar);
        rowpass(WSP(const bf16, WS_MIX), PARP(PAR_NORMG + (lay * 4 + 3) * DM), out, out, lay == 0 ? WSP(bf16, WS_XN) : (bf16*)nullptr);
        if (lay == 0) xcd_barrier(bar);
    }
}

extern "C" void kernel_launch(void* const* d_in, const int* in_sizes, int n_in, void* d_out, int out_size, void* d_ws, size_t ws_size, hipStream_t stream) {
    static int grid = 0;
    if (grid == 0) {
        if (n_in != 19 || in_sizes[0] != TOK * DM || out_size != TOK * DM || ws_size < WS_END) {
            fprintf(stderr, "kernel_launch: unexpected shapes: n_in %d in0 %d out %d ws %zu (need %zu)\n", n_in, n_in > 0 ? in_sizes[0] : -1, out_size, ws_size, (size_t)WS_END); grid = -1; return; }
        int dev = 0, cus = 0, per_cu = 0;
        if (hipGetDevice(&dev) != hipSuccess || hipDeviceGetAttribute(&cus, hipDeviceAttributeMultiprocessorCount, dev) != hipSuccess) { grid = -1; return; }
        if (hipFuncSetAttribute((const void*)fwd, hipFuncAttributeMaxDynamicSharedMemorySize, LDS_BYTES) != hipSuccess) { fprintf(stderr, "kernel_launch: hipFuncSetAttribute failed\n"); grid = -1; return; }
        if (hipOccupancyMaxActiveBlocksPerMultiprocessor(&per_cu, (const void*)fwd, NTHR, LDS_BYTES) != hipSuccess || per_cu < 1) { fprintf(stderr, "kernel_launch: occupancy query says %d blocks/CU\n", per_cu); grid = -1; return; }
        grid = cus;
    }
    if (grid < 0) return;
    Args a{};
    for (int i = 0; i < 19; ++i) a.in[i] = (const float*)d_in[i];
    a.out = (float*)d_out; a.ws = (unsigned char*)d_ws;
    if (hipMemsetAsync((char*)d_ws + WS_CTL, 0, CTL_ZERO_BYTES, stream) != hipSuccess) { fprintf(stderr, "kernel_launch: hipMemsetAsync failed\n"); return; }
    void* args[] = {&a};
    hipError_t e = hipLaunchCooperativeKernel((const void*)fwd, dim3(grid), dim3(NTHR), args, LDS_BYTES, stream);
    if (e != hipSuccess) fprintf(stderr, "cooperative launch failed: %s (grid %d)\n", hipGetErrorString(e), grid);
}
```

```cpp
#include <hip/hip_runtime.h>
#include <hip/hip_cooperative_groups.h>
#include <cstdio>
#include <cstdint>
namespace pg8 {
#define PG8_LAS __attribute__((address_space(3)))
typedef unsigned short bf16_t;
typedef short bf16x8 __attribute__((ext_vector_type(8)));
typedef float f32x4 __attribute__((ext_vector_type(4)));
typedef unsigned u32x4 __attribute__((ext_vector_type(4)));
constexpr int BM = 256, BK = 64, HALF = 128, HTB = HALF * BK * 2  , STAGE_BYTES = 8 * HTB, NXCD = 8, WGM = 8;

__host__ __device__ __forceinline__ int lds_byte(int r, int c) { const int st = (r >> 4) * 2 + (c >> 5), rr = r & 15, cc = c & 31, ob = rr * 64 + cc * 2; return st * 1024 + (ob ^ (((ob >> 9) & 1) << 5)); }
__host__ __device__ __forceinline__ void stage_rc(int b, int& R, int& C) { const int st = b / 1024, sb = b % 1024, swz = sb ^ (((sb >> 9) & 1) << 5); R = (st >> 1) * 16 + swz / 64; C = (st & 1) * 32 + (swz % 64) / 2; }
__host__ __device__ __forceinline__ int perm32(int rho) { const int n = rho >> 4, i = rho & 15; return 8 * (i >> 2) + 4 * n + (i & 3); }

struct Unit { int pm, pn; };
struct Gemm { const bf16_t* A; const bf16_t* Bt; int M, N, K; };

struct StaticOrder {
    int nM, nN, nwg, G, c;
    __host__ __device__ void init(int M, int N, int G_, int c_) { nM = M / BM; nN = N / BM; nwg = nM * nN; G = G_; c = c_; }
    __host__ __device__ bool next(int i, Unit& u) const {
        const long L = (long)i * G + c; if (L >= nwg) return false;
        int wgid = (int)L; { const int q = nwg / NXCD, r = nwg % NXCD, xcd = wgid % NXCD, off = wgid / NXCD; wgid = (xcd < r ? xcd * (q + 1) : r * (q + 1) + (xcd - r) * q) + off; }
        const int nig = WGM * nN, gid = wgid / nig, fm = gid * WGM, gsz = (nM - fm) < WGM ? (nM - fm) : WGM;
        u.pm = fm + ((wgid % nig) % gsz); u.pn = (wgid % nig) / gsz; return true;
    }
    __device__ __forceinline__ void a_ready(const Unit&) const {}
    __device__ __forceinline__ void done(const Unit&) const {}
};

__device__ __forceinline__ unsigned cvt_pk_bf16(float lo, float hi) { unsigned r; asm volatile("v_cvt_pk_bf16_f32 %0, %1, %2" : "=v"(r) : "v"(lo), "v"(hi)); return r; }
typedef float f32x2 __attribute__((ext_vector_type(2)));
__device__ __forceinline__ f32x2 gelu_pk(f32x2 v) {
    const f32x2 av = __builtin_elementwise_abs(v), d = av * 0.2316418882f + 1.0f;
    f32x2 t; t.x = __builtin_amdgcn_rcpf(d.x); t.y = __builtin_amdgcn_rcpf(d.y);
    f32x2 q = t * 0.5307027145f + (-0.7265760135f); q = q * t + 0.7107068705f; q = q * t + (-0.142248368f); q = q * t + 0.127414796f; q = q * t;
    const f32x2 s = (v * v) * (-0.72134752044f);
    f32x2 e; e.x = __builtin_amdgcn_exp2f(s.x); e.y = __builtin_amdgcn_exp2f(s.y);
    const f32x2 m = v * (q * e), r = v - m;
    f32x2 o; o.x = v.x < 0.f ? m.x : r.x; o.y = v.y < 0.f ? m.y : r.y; return o;
}

template <int ACT  > struct EpiBf16 {
    static constexpr bool PERM = true, AFTER_DRAIN = false, AMAP = false; static_assert(ACT == 0 || ACT == 1, "EpiBf16: ACT is 0 (none) or 1 (gelu_pk)");
    bf16_t* O; int ldc; const float* bias; int split_cols; size_t split_stride; float scale0;
    __device__ __forceinline__ void operator()(const f32x4 (&acc)[2][2][4][2], const Unit& u, int wr, int wc, int fr, int fq) const {
        const int row0 = u.pm * BM + wr * 64 + fr; int colt = u.pn * BM; bf16_t* base = O;
        float sc = 1.f; if (split_cols) { const int t = colt / split_cols; base += (size_t)t * split_stride; colt -= t * split_cols; if (t == 0) sc = scale0; }
        const int col0 = colt + wc * 32 + 8 * fq, bcol0 = u.pn * BM + wc * 32 + 8 * fq;
        f32x4 bv[2][2];
#pragma unroll
        for (int bj = 0; bj < 2; ++bj)
#pragma unroll
            for (int n = 0; n < 2; ++n) bv[bj][n] = bias ? *(const f32x4*)(bias + bcol0 + bj * HALF + 4 * n) : (f32x4){0.f, 0.f, 0.f, 0.f};
#pragma unroll
        for (int ai = 0; ai < 2; ++ai)
#pragma unroll
            for (int m = 0; m < 4; ++m) { bf16_t* rowp = base + (size_t)(row0 + ai * HALF + m * 16) * ldc + col0;
#pragma unroll
                for (int bj = 0; bj < 2; ++bj) { f32x4 v0 = acc[ai][bj][m][0] + bv[bj][0], v1 = acc[ai][bj][m][1] + bv[bj][1];
                    if (ACT == 1) { f32x2 a = gelu_pk((f32x2){v0[0], v0[1]}), b = gelu_pk((f32x2){v0[2], v0[3]}), c = gelu_pk((f32x2){v1[0], v1[1]}), d = gelu_pk((f32x2){v1[2], v1[3]});
                        v0 = (f32x4){a.x, a.y, b.x, b.y}; v1 = (f32x4){c.x, c.y, d.x, d.y}; }
                    v0 = v0 * sc; v1 = v1 * sc; u32x4 w; w.x = cvt_pk_bf16(v0[0], v0[1]); w.y = cvt_pk_bf16(v0[2], v0[3]); w.z = cvt_pk_bf16(v1[0], v1[1]); w.w = cvt_pk_bf16(v1[2], v1[3]);
                    *(u32x4*)(rowp + bj * HALF) = w; } }
    }
};
template <class Epi, class Sched, bool ALIGN_EPI = false, bool SP2 = false>
__device__ __forceinline__ void gemm_phase(PG8_LAS unsigned char* lds, const Gemm g, const Sched& S, const Epi& E) {
    int tid_l = threadIdx.x; asm volatile("" : "+v"(tid_l));
    const int tid = tid_l, wid = __builtin_amdgcn_readfirstlane(tid >> 6), lane = tid & 63, wr = wid >> 2, wc = wid & 3, fr = lane & 15, fq = lane >> 4;
    const int K = g.K, nt = K / BK;
    unsigned voffA[2], voffB[2];
#pragma unroll
    for (int i = 0; i < 2; ++i) { int R, C; stage_rc(tid * 16 + i * 8192, R, C); const int Rb = Epi::PERM ? ((R & ~31) + perm32(R & 31)) : R;
        const int Ra = Epi::AMAP ? (128 * (R >> 6) + (R & 63)) : R;
        voffA[i] = (unsigned)(Ra * K + C) * 2u; voffB[i] = (unsigned)(Rb * K + C) * 2u; }
    const size_t kstep = (size_t)(BK * 2);
    const size_t hstep = (size_t)HALF * K * 2;
    const size_t hstepA = Epi::AMAP ? (size_t)64 * K * 2 : hstep;
    const size_t tstep = 2 * hstep;
    const unsigned ldsw = (unsigned)wid * 1024u;
    const int aoff = lds_byte(wr * 64 + fr, fq * 8), boff = lds_byte(wc * 32 + fr, fq * 8);
#define PG8_SA(b, h) (((b) * 2 + (h)) * HTB)
#define PG8_SB(b, h) ((4 + (b) * 2 + (h)) * HTB)
#define PG8_STAGE(bufoff, gbase, voff) do { _Pragma("unroll") for (int _i = 0; _i < 2; ++_i) \
        __builtin_amdgcn_global_load_lds((const unsigned*)((const char*)(gbase) + (voff)[_i]), (PG8_LAS unsigned*)(lds + (bufoff) + ldsw + _i * 8192), 16, 0, 0); } while (0)
#define PG8_LDA(dst, b, h) do { _Pragma("unroll") for (int m = 0; m < 4; ++m) _Pragma("unroll") for (int k = 0; k < 2; ++k) dst[m][k] = *(const PG8_LAS bf16x8*)(lds + PG8_SA(b, h) + aoff + m * 2048 + k * 1024); } while (0)
#define PG8_LDB(dst, b, h) do { _Pragma("unroll") for (int n = 0; n < 2; ++n) _Pragma("unroll") for (int k = 0; k < 2; ++k) dst[n][k] = *(const PG8_LAS bf16x8*)(lds + PG8_SB(b, h) + boff + n * 2048 + k * 1024); } while (0)
#define PG8_MMA(ai, bj, At, Bt) do { __builtin_amdgcn_s_setprio(1); _Pragma("unroll") for (int m = 0; m < 4; ++m) _Pragma("unroll") for (int n = 0; n < 2; ++n) _Pragma("unroll") for (int k = 0; k < 2; ++k) \
        acc[ai][bj][m][n] = __builtin_amdgcn_mfma_f32_16x16x32_bf16(Bt[n][k], At[m][k], acc[ai][bj][m][n], 0, 0, 0); __builtin_amdgcn_s_setprio(0); } while (0)
#define PG8_WAIT_V(n) asm volatile("s_waitcnt vmcnt(" #n ")" ::: "memory")
#define PG8_WAIT_L(n) asm volatile("s_waitcnt lgkmcnt(" #n ")" ::: "memory")
#define PG8_BAR __builtin_amdgcn_s_barrier()
#define PG8_SCHED __builtin_amdgcn_sched_barrier(0)
    Unit cur, nxt; int ui = 0;
    if (!S.next(0, cur)) return;
    f32x4 acc[2][2][4][2];
#pragma unroll
    for (int a = 0; a < 2; ++a)
#pragma unroll
        for (int b = 0; b < 2; ++b)
#pragma unroll
            for (int m = 0; m < 4; ++m)
#pragma unroll
                for (int n = 0; n < 2; ++n) acc[a][b][m][n] = (f32x4){0.f, 0.f, 0.f, 0.f};
    bf16x8 At[4][2], B0[2][2], B1[2][2];
    const char* cA = (const char*)g.A + (size_t)cur.pm * tstep; const char* cB = (const char*)g.Bt + (size_t)cur.pn * tstep;
    S.a_ready(cur);
    if constexpr (SP2) {
        PG8_STAGE(PG8_SB(0, 0), cB, voffB); PG8_STAGE(PG8_SB(0, 1), cB + hstep, voffB); PG8_STAGE(PG8_SA(0, 0), cA, voffA); PG8_STAGE(PG8_SA(0, 1), cA + hstepA, voffA);
        if (wr == 1) PG8_BAR;
        PG8_WAIT_V(2); PG8_BAR;
        PG8_STAGE(PG8_SB(1, 0), cB + kstep, voffB); PG8_STAGE(PG8_SA(1, 0), cA + kstep, voffA); PG8_STAGE(PG8_SB(1, 1), cB + hstep + kstep, voffB);
        PG8_WAIT_V(6); PG8_BAR;
    } else {
        PG8_STAGE(PG8_SB(0, 0), cB, voffB); PG8_STAGE(PG8_SA(0, 0), cA, voffA); PG8_STAGE(PG8_SB(0, 1), cB + hstep, voffB); PG8_STAGE(PG8_SA(0, 1), cA + hstepA, voffA);
        if (wr == 1) PG8_BAR;
        PG8_WAIT_V(4); PG8_BAR;
        PG8_STAGE(PG8_SB(1, 0), cB + kstep, voffB); PG8_STAGE(PG8_SA(1, 0), cA + kstep, voffA); PG8_STAGE(PG8_SB(1, 1), cB + hstep + kstep, voffB);
        PG8_WAIT_V(6); PG8_BAR;
    }
    for (;;) {
        const bool has_next = S.next(ui + 1, nxt);
        const char* nA = has_next ? (const char*)g.A + (size_t)nxt.pm * tstep : cA; const char* nB = has_next ? (const char*)g.Bt + (size_t)nxt.pn * tstep : cB;
        for (int t = 0; t < nt; t += 2) {
            const bool last = (t == nt - 2);
            const char* a1 = cA + (size_t)(t + 1) * kstep;
            const char* a2 = last ? nA : cA + (size_t)(t + 2) * kstep; const char* b2 = last ? nB : cB + (size_t)(t + 2) * kstep;
            const char* a3 = a2 + kstep; const char* b3 = b2 + kstep;
            if (last && has_next) S.a_ready(nxt);
            if constexpr (SP2) {
            PG8_LDB(B0, 0, 0); PG8_LDB(B1, 0, 1); PG8_SCHED; PG8_LDA(At, 0, 0); PG8_STAGE(PG8_SA(1, 1), a1 + hstepA, voffA);
            PG8_WAIT_V(8); PG8_WAIT_L(0); PG8_BAR; PG8_MMA(0, 0, At, B0); PG8_MMA(0, 1, At, B1); PG8_BAR; PG8_SCHED;
            PG8_LDA(At, 0, 1); PG8_STAGE(PG8_SB(0, 0), b2, voffB); PG8_STAGE(PG8_SB(0, 1), b2 + hstep, voffB); PG8_STAGE(PG8_SA(0, 0), a2, voffA);
            PG8_WAIT_V(8); PG8_WAIT_L(0); PG8_BAR; PG8_MMA(1, 0, At, B0); PG8_MMA(1, 1, At, B1); PG8_BAR; PG8_SCHED;
            PG8_LDB(B0, 1, 0); PG8_LDB(B1, 1, 1); PG8_SCHED; PG8_LDA(At, 1, 0); PG8_STAGE(PG8_SA(0, 1), a2 + hstepA, voffA);
            PG8_WAIT_V(8); PG8_WAIT_L(0); PG8_BAR; PG8_MMA(0, 0, At, B0); PG8_MMA(0, 1, At, B1); PG8_BAR; PG8_SCHED;
            PG8_LDA(At, 1, 1); PG8_STAGE(PG8_SB(1, 0), b3, voffB); PG8_STAGE(PG8_SB(1, 1), b3 + hstep, voffB); PG8_STAGE(PG8_SA(1, 0), a3, voffA);
            PG8_WAIT_V(8); PG8_WAIT_L(0); PG8_BAR; PG8_MMA(1, 0, At, B0); PG8_MMA(1, 1, At, B1); PG8_BAR; PG8_SCHED;
            } else {
            PG8_LDB(B0, 0, 0); PG8_SCHED; PG8_LDA(At, 0, 0); PG8_STAGE(PG8_SA(1, 1), a1 + hstepA, voffA);
            PG8_WAIT_L(8); PG8_BAR; PG8_WAIT_L(0); PG8_MMA(0, 0, At, B0); PG8_BAR; PG8_SCHED;
            PG8_LDB(B1, 0, 1); PG8_STAGE(PG8_SB(0, 0), b2, voffB);
            PG8_BAR; PG8_WAIT_L(0); PG8_MMA(0, 1, At, B1); PG8_BAR;
            PG8_LDA(At, 0, 1); PG8_STAGE(PG8_SA(0, 0), a2, voffA);
            PG8_BAR; PG8_WAIT_L(0); PG8_MMA(1, 0, At, B0); PG8_BAR; PG8_SCHED;
            PG8_STAGE(PG8_SB(0, 1), b2 + hstep, voffB);
            PG8_WAIT_V(6); PG8_BAR; PG8_MMA(1, 1, At, B1); PG8_BAR;
            PG8_LDB(B0, 1, 0); PG8_SCHED; PG8_LDA(At, 1, 0); PG8_STAGE(PG8_SA(0, 1), a2 + hstepA, voffA);
            PG8_WAIT_L(8); PG8_BAR; PG8_WAIT_L(0); PG8_MMA(0, 0, At, B0); PG8_BAR; PG8_SCHED;
            PG8_LDB(B1, 1, 1); PG8_STAGE(PG8_SB(1, 0), b3, voffB);
            PG8_BAR; PG8_WAIT_L(0); PG8_MMA(0, 1, At, B1); PG8_BAR;
            PG8_LDA(At, 1, 1); PG8_STAGE(PG8_SA(1, 0), a3, voffA);
            PG8_BAR; PG8_WAIT_L(0); PG8_MMA(1, 0, At, B0); PG8_BAR; PG8_SCHED;
            PG8_STAGE(PG8_SB(1, 1), b3 + hstep, voffB);
            PG8_WAIT_V(6); PG8_BAR; PG8_MMA(1, 1, At, B1); PG8_BAR;
            }
        }
        if constexpr (ALIGN_EPI) { if (wr == 0) PG8_BAR; }
        if constexpr (!Epi::AFTER_DRAIN) { E(acc, cur, wr, wc, fr, fq); S.done(cur); }
        if (!has_next) break;
#pragma unroll
        for (int a = 0; a < 2; ++a)
#pragma unroll
            for (int b = 0; b < 2; ++b)
#pragma unroll
                for (int m = 0; m < 4; ++m)
#pragma unroll
                    for (int n = 0; n < 2; ++n) acc[a][b][m][n] = (f32x4){0.f, 0.f, 0.f, 0.f};
        cur = nxt; cA = nA; cB = nB; ++ui;
        if constexpr (ALIGN_EPI) { if (wr == 1) PG8_BAR; }
    }
    PG8_WAIT_V(0);
    if constexpr (!ALIGN_EPI) { if (wr == 0) PG8_BAR; }
    PG8_BAR;
    if constexpr (Epi::AFTER_DRAIN) { E.fused(acc, cur, wr, wc, fr, fq, lds, wid, lane); S.done(cur); }
#undef PG8_SA
#undef PG8_SB
#undef PG8_STAGE
#undef PG8_LDA
#undef PG8_LDB
#undef PG8_MMA
#undef PG8_WAIT_V
#undef PG8_WAIT_L
#undef PG8_BAR
#undef PG8_SCHED
}
}

#ifndef PG8_SP2
#define PG8_SP2 true
#endif
#ifndef PG8_ALIGN
#define PG8_ALIGN true
#endif

constexpr int NWAVES = 8, NTHR = 512;
constexpr int BATCH = 8, SEQ = 4096, DM = 1024, TOK = BATCH * SEQ;
constexpr int NQKVA = 4608, AW = 512, NKVQ = 3072, FF = 2816, NUP = 5632;
constexpr float LOG2E = 1.4426950408889634f;
constexpr float C2 = 0.125f * LOG2E;
constexpr float RMS_EPS = 1e-6f, SUBLN_EPS = 1e-5f;
constexpr float LAMBDA_INIT = 0.8f - 0.6f * 0.7408182206817179f;

constexpr size_t MiB = 1u << 20;
constexpr size_t WS_WIN = 1 * MiB, WS_WOA = 10 * MiB, WS_WKVQ = 11 * MiB, WS_WOB = 17 * MiB, WS_WUP0 = 19 * MiB, WS_WUP1 = 30 * MiB;
constexpr size_t WS_WDN0 = 41 * MiB, WS_WDN1 = WS_WDN0 + (size_t)DM * FF * 2;
constexpr size_t WS_TABB = 63 * MiB, WS_TABA = WS_TABB + 256 * 1024;
constexpr size_t WS_PAR = 62 * MiB;
constexpr int PAR_NORMG = 0, PAR_CONVW = 8 * 1024, PAR_CONVB = PAR_CONVW + 6 * 5632, PAR_LAM = PAR_CONVB + 2 * 5632, PAR_SUBG = PAR_LAM + 256, PAR_END = PAR_SUBG + 128;
constexpr size_t WS_XN = 64 * MiB;
constexpr size_t WS_BIG = 128 * MiB;
constexpr size_t WS_GATED = 128 * MiB, WS_PART = 304 * MiB, WS_LAST = 316 * MiB, WS_MIX = 448 * MiB;
constexpr size_t WS_END = 512 * MiB;
constexpr int TABB_STRIDE = SEQ + 128;

constexpr int LDS_BYTES = 147456;
constexpr int LDS_MISC_OFF = 131072 + 320;
constexpr size_t WS_CTL = 0, CTL_ZERO_BYTES = 65536;

#define GAS __attribute__((address_space(1)))
#define LAS __attribute__((address_space(3)))
typedef unsigned short bf16;
typedef unsigned v4u __attribute__((ext_vector_type(4)));
typedef unsigned v2u __attribute__((ext_vector_type(2)));
typedef float f32x4 __attribute__((ext_vector_type(4)));
#define LDS_WAIT() asm volatile("s_waitcnt lgkmcnt(0)" ::: "memory")
#define LAUNDER_V(x) asm volatile("" : "+v"(x))
#define LAUNDER_S(x) asm volatile("" : "+s"(x))
__device__ __forceinline__ unsigned f2bf(float f) { unsigned u = __builtin_bit_cast(unsigned, f); return (u + 0x7fffu + ((u >> 16) & 1u)) >> 16; }
__device__ __forceinline__ unsigned pk2(float lo, float hi) { return f2bf(lo) | (f2bf(hi) << 16); }
__device__ __forceinline__ float bflo(unsigned w) { return __uint_as_float(w << 16); }
__device__ __forceinline__ float bfhi(unsigned w) { return __uint_as_float(w & 0xffff0000u); }
__device__ __forceinline__ float wave_sum(float v) {
#pragma unroll
    for (int o = 1; o < 64; o <<= 1) v += __shfl_xor(v, o);
    return v;
}
__device__ __forceinline__ int t5_bucket(int n) {
    if (n < 16) return n;
    return 16 + (n >= 22) + (n >= 30) + (n >= 40) + (n >= 54) + (n >= 73) + (n >= 99) + (n >= 134) + (n >= 182) + (n >= 246) + (n >= 332) + (n >= 450) + (n >= 609) + (n >= 825) + (n >= 1117) + (n >= 1513);
}

#define PHASE_IDS \
    int tid_ = threadIdx.x; LAUNDER_V(tid_); const int lane = tid_ & 63, wave = __builtin_amdgcn_readfirstlane(tid_ >> 6); \
    const int G_ = gridDim.x, bx_ = blockIdx.x; const int vcu_ = (G_ % 8 == 0) ? (bx_ % 8) * (G_ / 8) + bx_ / 8 : bx_; \
    const int gw = vcu_ * NWAVES + wave, ngw = G_ * NWAVES, gtid = bx_ * NTHR + tid_, gstride = G_ * NTHR; \
    (void)lane; (void)wave; (void)gw; (void)ngw; (void)gtid; (void)gstride;

struct Args {
    const float* in[19]; float* out; unsigned char* ws; int ph_lo, ph_hi;
};

__device__ __forceinline__ void tr_item(const float* W, int K, int N, bf16* WT, int k0, int n0, int drow0, const float* gk, float cs, LAS float* scr, int lane) {
#pragma unroll 8
    for (int i = 0; i < 32; ++i) { const int kk = 2 * i + (lane >> 5); const float g = gk ? gk[k0 + kk] : 1.f;
        scr[kk * 33 + (lane & 31)] = W[(size_t)(k0 + kk) * N + n0 + (lane & 31)] * (g * cs); }
    LDS_WAIT(); asm volatile("" ::: "memory");
    const int c = lane & 7;
#pragma unroll
    for (int j = 0; j < 4; ++j) { const int n = (lane >> 3) + 8 * j; const LAS float* s = scr + (8 * c) * 33 + n;
        v4u o; o.x = pk2(s[0 * 33], s[1 * 33]); o.y = pk2(s[2 * 33], s[3 * 33]); o.z = pk2(s[4 * 33], s[5 * 33]); o.w = pk2(s[6 * 33], s[7 * 33]);
        *(v4u*)(WT + (size_t)(drow0 + n) * K + k0 + 8 * c) = o; }
    LDS_WAIT(); asm volatile("" ::: "memory");
}
__device__ __forceinline__ void tr_mat(int r, const float* W, int K, int N, bf16* WT, int rowoff, const float* gk, int kind, LAS float* scr, int lane) {
    const int nblk = N / 32, kb = r / nblk, nb = r % nblk, n0 = nb * 32; int dr = n0; float cs = 1.f;
    if (kind == 1) cs = ((n0 % 1536) < 512) ? C2 : 1.f;
    if (kind == 2) cs = C2;
    if (kind == 3) dr = (n0 < FF) ? 256 * (n0 / 128) + (n0 % 128) : 256 * ((n0 - FF) / 128) + 128 + ((n0 - FF) % 128);
    tr_item(W, K, N, WT, kb * 64, n0, dr + rowoff, gk, cs, scr, lane);
}

__device__ __forceinline__ void prologue(const Args& a, LAS unsigned char* lds) {
    PHASE_IDS
    LAS float* scr = (LAS float*)(lds + wave * 16384);
    unsigned char* ws = a.ws;
    const float* norm_g = a.in[2];
    constexpr int I_WIN = 16 * 144, I_WOA = 8 * 32, I_SQ = 16 * 32, I_UP = 16 * 176, I_DN = 44 * 32;
    constexpr int NITEMS = I_WIN + I_WOA + 4 * I_SQ + 2 * I_UP + 2 * I_DN;
    for (int it = gw; it < NITEMS; it += ngw) {
        int r = it;
        if (r < I_WIN) { tr_mat(r, a.in[3], DM, NQKVA, (bf16*)(ws + WS_WIN), 0, norm_g + 0 * DM, 1, scr, lane); continue; } r -= I_WIN;
        if (r < I_WOA) { tr_mat(r, a.in[4], AW, DM, (bf16*)(ws + WS_WOA), 0, nullptr, 0, scr, lane); continue; } r -= I_WOA;
        if (r < I_SQ) { tr_mat(r, a.in[6], DM, DM, (bf16*)(ws + WS_WKVQ), 0, a.in[5], 0, scr, lane); continue; } r -= I_SQ;
        if (r < I_SQ) { tr_mat(r, a.in[7], DM, DM, (bf16*)(ws + WS_WKVQ), 1024, a.in[5], 0, scr, lane); continue; } r -= I_SQ;
        if (r < I_SQ) { tr_mat(r, a.in[8], DM, DM, (bf16*)(ws + WS_WKVQ), 2048, norm_g + 4 * DM, 2, scr, lane); continue; } r -= I_SQ;
        if (r < I_SQ) { tr_mat(r, a.in[14], DM, DM, (bf16*)(ws + WS_WOB), 0, nullptr, 0, scr, lane); continue; } r -= I_SQ;
        if (r < I_UP) { tr_mat(r, a.in[15], DM, NUP, (bf16*)(ws + WS_WUP0), 0, norm_g + 2 * DM, 3, scr, lane); continue; } r -= I_UP;
        if (r < I_UP) { tr_mat(r, a.in[15] + (size_t)DM * NUP, DM, NUP, (bf16*)(ws + WS_WUP1), 0, norm_g + 6 * DM, 3, scr, lane); continue; } r -= I_UP;
        if (r < I_DN) { tr_mat(r, a.in[18], FF, DM, (bf16*)(ws + WS_WDN0), 0, nullptr, 0, scr, lane); continue; } r -= I_DN;
        tr_mat(r, a.in[18] + (size_t)FF * DM, FF, DM, (bf16*)(ws + WS_WDN1), 0, nullptr, 0, scr, lane);
    }
    { float* par = (float*)(ws + WS_PAR); const int gt0 = gw * 64 + lane, ngt0 = ngw * 64;
      for (int i = gt0; i < PAR_END; i += ngt0) { float v;
        if (i < PAR_CONVW) v = a.in[2][i]; else if (i < PAR_CONVB) v = a.in[16][i - PAR_CONVW]; else if (i < PAR_LAM) v = a.in[17][i - PAR_CONVB];
        else if (i < PAR_SUBG) { const int k = i - PAR_LAM; v = a.in[9 + (k >> 6)][k & 63]; } else v = a.in[13][i - PAR_SUBG];
        par[i] = v; } }
    const float* table = a.in[1];
    float* tabB = (float*)(ws + WS_TABB); float* tabA = (float*)(ws + WS_TABA);
    const int gt = gw * 64 + lane, ngt = ngw * 64;
    for (int i = gt; i < 8 * TABB_STRIDE; i += ngt) { const int h = i / TABB_STRIDE, d = (SEQ + 63) - i % TABB_STRIDE; tabB[i] = d < 0 ? 0.f : table[h * 32 + t5_bucket(d)] * LOG2E; }
    for (int i = gt; i < 3 * 8 * 132; i += ngt) { const int g = i / (8 * 132), h = (i / 132) % 8, du = i % 132; const int r = 1 << (2 * g);
        tabA[i] = du <= 128 ? table[h * 32 + t5_bucket(du * r)] * LOG2E : 0.f; }
    const float* x = a.in[0]; bf16* XN = (bf16*)(ws + WS_XN);
    for (int m = gw; m < TOK; m += ngw) {
        const f32x4* xr = (const f32x4*)(x + (size_t)m * DM) + lane; f32x4 v[4]; float s = 0.f;
#pragma unroll
        for (int j = 0; j < 4; ++j) { v[j] = xr[64 * j]; s += (v[j].x * v[j].x + v[j].y * v[j].y) + (v[j].z * v[j].z + v[j].w * v[j].w); }
        const float rs = 1.f / sqrtf(wave_sum(s) * (1.f / DM) + RMS_EPS);
        v2u* o8 = (v2u*)(XN + (size_t)m * DM) + lane;
#pragma unroll
        for (int j = 0; j < 4; ++j) { v2u w; w.x = pk2(v[j].x * rs, v[j].y * rs); w.y = pk2(v[j].z * rs, v[j].w * rs); o8[64 * j] = w; }
    }
}

__device__ __forceinline__ void rowpass(const bf16* mix, const float* g, const float* hin, float* hout, bf16* xn) {
    PHASE_IDS
    for (int m = gw; m < TOK; m += ngw) {
        const v2u* mr = (const v2u*)(mix + (size_t)m * DM) + lane; f32x4 v[4]; float s = 0.f;
#pragma unroll
        for (int j = 0; j < 4; ++j) { const v2u w = mr[64 * j]; v[j] = (f32x4){bflo(w.x), bfhi(w.x), bflo(w.y), bfhi(w.y)};
            s += (v[j].x * v[j].x + v[j].y * v[j].y) + (v[j].z * v[j].z + v[j].w * v[j].w); }
        const float rs = 1.f / sqrtf(wave_sum(s) * (1.f / DM) + RMS_EPS);
        const f32x4* gr = (const f32x4*)g + lane; const f32x4* hr = (const f32x4*)(hin + (size_t)m * DM) + lane; f32x4* ho = (f32x4*)(hout + (size_t)m * DM) + lane;
        float s2 = 0.f;
#pragma unroll
        for (int j = 0; j < 4; ++j) { const f32x4 gv = gr[64 * j], hv = hr[64 * j]; v[j] = hv + v[j] * rs * gv; ho[64 * j] = v[j];
            s2 += (v[j].x * v[j].x + v[j].y * v[j].y) + (v[j].z * v[j].z + v[j].w * v[j].w); }
        if (xn) {
            const float rs2 = 1.f / sqrtf(wave_sum(s2) * (1.f / DM) + RMS_EPS);
            v2u* o8 = (v2u*)(xn + (size_t)m * DM) + lane;
#pragma unroll
            for (int j = 0; j < 4; ++j) { v2u w; w.x = pk2(v[j].x * rs2, v[j].y * rs2); w.y = pk2(v[j].z * rs2, v[j].w * rs2); o8[64 * j] = w; }
        }
    }
}

__device__ __forceinline__ void ld8(const bf16* p, float* f) { const v4u w = *(const v4u*)p; f[0] = bflo(w.x); f[1] = bfhi(w.x); f[2] = bflo(w.y); f[3] = bfhi(w.y); f[4] = bflo(w.z); f[5] = bfhi(w.z); f[6] = bflo(w.w); f[7] = bfhi(w.w); }

namespace da {
typedef short bf16x8 __attribute__((ext_vector_type(8)));
typedef short s16x4 __attribute__((ext_vector_type(4)));
typedef short v4i16_t __attribute__((ext_vector_type(4)));
typedef float f32x16 __attribute__((ext_vector_type(16)));
typedef float f32x2_t __attribute__((ext_vector_type(2))); typedef __bf16 bf16x2_t __attribute__((ext_vector_type(2)));
constexpr int SLOT = 32768, NSLOT = 3, KOFF = 0, VOFF = 16384, TABL = NSLOT * SLOT, TABL_FLOATS = 128 + SEQ, XCH = 0;
__device__ __forceinline__ unsigned cvtpk(float lo, float hi) { f32x2_t v = {lo, hi}; bf16x2_t b = __builtin_convertvector(v, bf16x2_t); return __builtin_bit_cast(unsigned, b); }
__device__ __forceinline__ s16x4 vtr(const LAS unsigned char* p) { return __builtin_bit_cast(s16x4, __builtin_amdgcn_ds_read_tr16_b64_v4i16((LAS v4i16_t*)p)); }
__device__ __forceinline__ void glds16(const void* gsrc, unsigned lds_dst) { unsigned keep;
    asm volatile("s_mov_b32 %0, m0\n\ts_mov_b32 m0, %2\n\ts_nop 0\n\tglobal_load_lds_dwordx4 %1, off\n\ts_mov_b32 m0, %0" : "=&s"(keep) : "v"(gsrc), "s"(lds_dst) : "memory"); }
__device__ __forceinline__ float swapmax(float v) { auto rr = __builtin_amdgcn_permlane32_swap(__float_as_uint(v), __float_as_uint(v), false, false); return fmaxf(__uint_as_float(rr[0]), __uint_as_float(rr[1])); }
__device__ __forceinline__ float swapsum(float v) { auto rr = __builtin_amdgcn_permlane32_swap(__float_as_uint(v), __float_as_uint(v), false, false); return __uint_as_float(rr[0]) + __uint_as_float(rr[1]); }
#define DA_CST0(r) (((r) & 3) + 8 * ((r) >> 2))

#define DA_SB() __builtin_amdgcn_sched_barrier(0)
#define DA_VREAD(dst, db, vbp) do { _Pragma("unroll") for (int ks = 0; ks < 4; ++ks) { dst[2 * ks] = vtr((vbp) + (db) * 4096 + ks * 1024); dst[2 * ks + 1] = vtr((vbp) + (db) * 4096 + ks * 1024 + 512); } } while (0)
#define DA_VF(src, ks) ((bf16x8){src[2 * (ks)][0], src[2 * (ks)][1], src[2 * (ks)][2], src[2 * (ks)][3], src[2 * (ks) + 1][0], src[2 * (ks) + 1][1], src[2 * (ks) + 1][2], src[2 * (ks) + 1][3]})
#define DA_EXP2(C, r) do { C[r] = __builtin_amdgcn_exp2f(C[r] - m); C[(r) + 1] = __builtin_amdgcn_exp2f(C[(r) + 1] - m); } while (0)
#define DA_STEP(DOQK, DOPV, PWP, PWN, T, SO_K, SO_V) do { \
    f32x16 C0, C1; s16x4 va[8], vc[8]; bf16x8 ka[4]; float fsc = 1.f; bool resc = false; \
    const LAS unsigned char* vbp = vb0 + (SO_V); const LAS unsigned char* kbp = lds + KOFF + (SO_K) + (8 * c + hi) * 1024 + r32 * 16; \
    const int idx0 = q0 + r32 - 64 * (T) - 4 * hi; \
    if (DOQK) { const LAS float* tb = tabL + (SEQ + 63) - idx0; \
        _Pragma("unroll") for (int r = 0; r < 16; ++r) { C0[r] = tb[DA_CST0(r)]; C1[r] = tb[32 + DA_CST0(r)]; } \
        _Pragma("unroll") for (int d0 = 0; d0 < 2; ++d0) { ka[2 * d0] = *(const LAS bf16x8*)(kbp + d0 * 2048); ka[2 * d0 + 1] = *(const LAS bf16x8*)(kbp + d0 * 2048 + 512); } } \
    if (DOPV) DA_VREAD(va, 0, vbp); \
    DA_SB(); \
    if (DOQK) { _Pragma("unroll") for (int d0 = 0; d0 < 2; ++d0) { C0 = __builtin_amdgcn_mfma_f32_32x32x16_bf16(ka[2 * d0], qf[d0], C0, 0, 0, 0); C1 = __builtin_amdgcn_mfma_f32_32x32x16_bf16(ka[2 * d0 + 1], qf[d0], C1, 0, 0, 0); } \
        _Pragma("unroll") for (int d0 = 2; d0 < 4; ++d0) { ka[2 * d0 - 4] = *(const LAS bf16x8*)(kbp + d0 * 2048); ka[2 * d0 - 3] = *(const LAS bf16x8*)(kbp + d0 * 2048 + 512); } \
        DA_SB(); \
        _Pragma("unroll") for (int d0 = 2; d0 < 4; ++d0) { C0 = __builtin_amdgcn_mfma_f32_32x32x16_bf16(ka[2 * d0 - 4], qf[d0], C0, 0, 0, 0); C1 = __builtin_amdgcn_mfma_f32_32x32x16_bf16(ka[2 * d0 - 3], qf[d0], C1, 0, 0, 0); } } \
    if (DOPV) DA_VREAD(vc, 1, vbp); \
    DA_SB(); \
    if (DOQK) { \
        if (64 * (T) + 63 > q0) { _Pragma("unroll") for (int r = 0; r < 16; ++r) { if (DA_CST0(r) > idx0) C0[r] = -INFINITY; if (32 + DA_CST0(r) > idx0) C1[r] = -INFINITY; } } \
        float rm = fmaxf(C0[0], C1[0]); \
        _Pragma("unroll") for (int r = 1; r < 16; ++r) rm = fmaxf(rm, fmaxf(C0[r], C1[r])); \
        rm = swapmax(rm); \
        resc = __any(rm > m + 8.f);                                     \
        { const float mn = resc ? fmaxf(m, rm) : m; fsc = __builtin_amdgcn_exp2f(m - mn); m = mn; l *= fsc; } } \
    DA_SB(); \
    { float s0 = 0.f, s1 = 0.f; \
      _Pragma("unroll") for (int g = 0; g < 16; ++g) { \
        if (DOPV) { if ((g >> 2) & 1) o[g >> 2] = __builtin_amdgcn_mfma_f32_32x32x16_bf16(DA_VF(vc, g & 3), __builtin_bit_cast(bf16x8, PWP[g & 3]), o[g >> 2], 0, 0, 0); \
                    else o[g >> 2] = __builtin_amdgcn_mfma_f32_32x32x16_bf16(DA_VF(va, g & 3), __builtin_bit_cast(bf16x8, PWP[g & 3]), o[g >> 2], 0, 0, 0); } \
        if (DOQK) { if (g < 8) { C0[2 * g] = __builtin_amdgcn_exp2f(C0[2 * g] - m); C0[2 * g + 1] = __builtin_amdgcn_exp2f(C0[2 * g + 1] - m); s0 += C0[2 * g]; s1 += C0[2 * g + 1]; asm volatile("" : "+v"(C0), "+v"(s0), "+v"(s1)); } \
                    else { C1[2 * g - 16] = __builtin_amdgcn_exp2f(C1[2 * g - 16] - m); C1[2 * g - 15] = __builtin_amdgcn_exp2f(C1[2 * g - 15] - m); s0 += C1[2 * g - 16]; s1 += C1[2 * g - 15]; asm volatile("" : "+v"(C1), "+v"(s0), "+v"(s1)); } } \
        if (DOPV) { if (g == 3) DA_VREAD(va, 2, vbp); if (g == 7) DA_VREAD(vc, 3, vbp); } \
        DA_SB(); } \
      if (DOQK) { l += s0 + s1; _Pragma("unroll") for (int x = 0; x < 4; ++x) { PWN[0][x] = cvtpk(C0[2 * x], C0[2 * x + 1]); PWN[1][x] = cvtpk(C0[8 + 2 * x], C0[9 + 2 * x]); PWN[2][x] = cvtpk(C1[2 * x], C1[2 * x + 1]); PWN[3][x] = cvtpk(C1[8 + 2 * x], C1[9 + 2 * x]); } } \
      else { _Pragma("unroll") for (int x = 0; x < 4; ++x) PWN[x] = (v4u){0u, 0u, 0u, 0u}; } } \
    if (DOQK && resc) { _Pragma("unroll") for (int i = 0; i < 4; ++i) _Pragma("unroll") for (int r = 0; r < 16; ++r) o[i][r] *= fsc; } \
  } while (0)

template <int MODE> __device__ __forceinline__ void diff_unit(int b, int h, int qblk, const bf16* kvq, float lam, const float* subg, bf16* Ob, LAS unsigned char* lds, int wave, int lane) {
    LAUNDER_V(lane);
    const int r32 = lane & 31, hi = lane >> 5, qt = wave >> 1, c = wave & 1;
    const int q0 = qblk * 128 + qt * 32, NT = 2 * qblk + 2;
    const int NTw = (q0 + 31) / 64 + 1;
    const size_t rowb = (size_t)b * SEQ;
    const LAS float* tabL = (const LAS float*)(lds + TABL);
    bf16x8 qf[4];
    { const bf16* qp = kvq + (rowb + q0 + r32) * NKVQ + 2048 + h * 128 + c * 64 + hi * 8;
#pragma unroll
      for (int d0 = 0; d0 < 4; ++d0) qf[d0] = *(const bf16x8*)(qp + 16 * d0); }
    const bf16* ksrc = kvq + (rowb + lane) * NKVQ + h * 128 + wave * 8;
    const bf16* vsrc = kvq + (rowb + 16 * (wave & 3) + (lane >> 2)) * NKVQ + 1024 + h * 128 + (wave >> 2) * 32 + (lane & 3) * 8;
    const unsigned dma_lds = (unsigned)(uintptr_t)(lds + wave * 1024);
    const LAS unsigned char* vb0 = lds + VOFF + ((lane >> 4) & 1) * 32 + (lane & 3) * 8 + (4 * hi + ((lane & 15) >> 2)) * 64;
    f32x16 o[4];
#pragma unroll
    for (int i = 0; i < 4; ++i)
#pragma unroll
        for (int r = 0; r < 16; ++r) o[i][r] = 0.f;
    float m = -INFINITY, l = 0.f;
    v4u pw[4];
#pragma unroll
    for (int k = 0; k < 4; ++k) pw[k] = (v4u){0u, 0u, 0u, 0u};
#define DA_DMA(t, so) do { const size_t off_ = (size_t)(t) * 64 * NKVQ; const unsigned d_ = (unsigned)__builtin_amdgcn_readfirstlane((int)(dma_lds + (so))); \
        glds16(ksrc + off_, d_ + KOFF); glds16(ksrc + off_ + 64, d_ + KOFF + 8192); glds16(vsrc + off_, d_ + VOFF); glds16(vsrc + off_ + 64, d_ + VOFF + 8192); } while (0)
    asm volatile("" : "+v"(qf[0]), "+v"(qf[1]), "+v"(qf[2]), "+v"(qf[3]));
    DA_DMA(0, 0);
    int so_m1 = 2 * SLOT, so_0 = 0, so_p1 = SLOT;
#define DA_ITER(PWP, PWN) do { \
        asm volatile("s_waitcnt vmcnt(0)" ::: "memory"); __builtin_amdgcn_s_barrier(); asm volatile("" ::: "memory"); DA_SB(); \
        if (MODE != 2) { if (t + 1 < NT) DA_DMA(t + 1, so_p1); } \
        if (MODE != 1) { if (t < NTw) DA_STEP(true, true, PWP, PWN, t, so_0, so_m1);       \
        else if (t == NTw) DA_STEP(false, true, PWP, PWN, t, so_0, so_m1); } \
        { const int tmp_ = so_m1; so_m1 = so_0; so_0 = so_p1; so_p1 = tmp_; } ++t; } while (0)
    int t = 0;
#pragma unroll 1
    for (int it = 0; it < NT + 1; ++it) DA_ITER(pw, pw);
#undef DA_ITER
#undef DA_DMA
    __syncthreads();
    int lane_e = lane; LAUNDER_V(lane_e);
    const int r32e = lane_e & 31, hie = lane_e >> 5;
    const float il = 1.f / swapsum(l);
    LAS float* xch = (LAS float*)(lds + XCH) + (qt * 64) * 64 + lane_e;
    if (c == 1) {
#pragma unroll
        for (int i = 0; i < 4; ++i)
#pragma unroll
            for (int r = 0; r < 16; ++r) xch[(i * 16 + r) * 64] = o[i][r] * il;
    }
    __syncthreads();
    if (c == 0) {
        float ss = 0.f;
#pragma unroll
        for (int i = 0; i < 4; ++i)
#pragma unroll
            for (int r = 0; r < 16; ++r) { const float v = o[i][r] * il - lam * xch[(i * 16 + r) * 64]; o[i][r] = v; ss += v * v; }
        ss = swapsum(ss);
        const float rs = 1.f / sqrtf(ss * (1.f / 128.f) + SUBLN_EPS) * (1.f - LAMBDA_INIT);
        bf16* op = Ob + ((size_t)b * SEQ + qblk * 128 + qt * 32 + r32e) * DM + h * 128 + 4 * hie;
#pragma unroll
        for (int i = 0; i < 4; ++i)
#pragma unroll
            for (int rr = 0; rr < 4; ++rr) { const f32x4 sg = *(const f32x4*)(subg + 32 * i + 8 * rr + 4 * hie);
                v2u w; w.x = cvtpk(o[i][4 * rr] * rs * sg.x, o[i][4 * rr + 1] * rs * sg.y); w.y = cvtpk(o[i][4 * rr + 2] * rs * sg.z, o[i][4 * rr + 3] * rs * sg.w);
                *(v2u*)(op + 32 * i + 8 * rr) = w; }
    }
    __syncthreads();
}
}

template <int MODE> __device__ __forceinline__ void diff_attn_phase(const bf16* kvq, const float* tabB, const float* par, bf16* Ob, LAS unsigned char* lds) {
    PHASE_IDS
    float lam;
    { const float* lp = par + PAR_LAM; const float p1 = lp[lane] * lp[64 + lane], p2 = lp[128 + lane] * lp[192 + lane]; lam = expf(wave_sum(p1)) - expf(wave_sum(p2)) + LAMBDA_INIT; }
    const float* subg = par + PAR_SUBG;
    const int xcd_ = vcu_ >> 5, wi = vcu_ & 31;
    LAS float* tabL = (LAS float*)(lds + da::TABL);
    for (int i = tid_; i < 16384 / 4; i += NTHR) ((LAS unsigned*)(lds + (da::NSLOT - 1) * da::SLOT + da::VOFF))[i] = 0u;
#pragma unroll 1
    for (int u = 0; u < 8; ++u) {
        const int bh = xcd_ * 8 + u, b = bh >> 3, h = bh & 7;
        const int base = (wi + 8 * (u >> 1)) & 31; const int qblk = (u & 1) ? 31 - base : base;
        { const float* src = tabB + h * TABB_STRIDE; for (int i = tid_; i < da::TABL_FLOATS; i += NTHR) tabL[i] = src[i]; }
        __syncthreads();
        da::diff_unit<MODE>(b, h, qblk, kvq, lam, subg, Ob, lds, wave, lane);
    }
}

namespace dl {
using da::bf16x8; using da::s16x4; using da::f32x16; using da::cvtpk; using da::vtr; using da::swapmax; using da::swapsum;
constexpr int STAGE = 0, TAB = 32768;
__device__ __forceinline__ void task(int b, int h, int tb, int g, int ti, const bf16* qkv, bf16* Og, float* LSE, LAS unsigned char* lds, int wave, int lane) {
    const int r32 = lane & 31, hi = lane >> 5;
    const int sh = 2 * g;
    int c, m0;
    if (g == 0) { c = 0; m0 = tb * 512 + 32 * ti; } else if (g == 1) { c = ti & 3; m0 = tb * 128 + 32 * (ti >> 2); } else { c = ti; m0 = tb * 32; }
    const size_t rowb = (size_t)b * SEQ;
    const int gcol = g * 1536 + h * 64;
    const int qtok = ((m0 + r32) << sh) + c;
    bf16x8 qf[4];
    { const bf16* qp = qkv + (rowb + qtok) * NQKVA + gcol + hi * 8;
#pragma unroll
      for (int d0 = 0; d0 < 4; ++d0) qf[d0] = *(const bf16x8*)(qp + 16 * d0); }
    const int jmin = (m0 >= 128) ? 0 : 4 - (m0 >> 5);
    f32x16 o[2];
#pragma unroll
    for (int i = 0; i < 2; ++i)
#pragma unroll
        for (int r = 0; r < 16; ++r) o[i][r] = 0.f;
    float m = -INFINITY, l = 0.f;
    LAS unsigned char* stg = lds + STAGE + wave * 4096;
    const LAS unsigned char* vb = stg + ((lane >> 4) & 1) * 32 + (lane & 3) * 8 + (4 * hi + ((lane & 15) >> 2)) * 64;
    const LAS float* tab = (const LAS float*)(lds + TAB) + g * 132;
    const bf16* kbase = qkv + rowb * NQKVA + gcol + 512 + hi * 8;
    const bf16* vbase = qkv + rowb * NQKVA + gcol + 1024 + (lane & 3) * 8;
    bf16x8 kn[4]; v4u vn[4];
#define DL_LOAD(j) do { const int ku0_ = m0 - 128 + 32 * (j); const bf16* kp_ = kbase + (size_t)(((ku0_ + r32) << sh) + c) * NQKVA; \
        _Pragma("unroll") for (int d0 = 0; d0 < 4; ++d0) kn[d0] = *(const bf16x8*)(kp_ + 16 * d0); \
        _Pragma("unroll") for (int i = 0; i < 4; ++i) vn[i] = *(const v4u*)(vbase + (size_t)(((ku0_ + 16 * (i & 1) + (lane >> 2)) << sh) + c) * NQKVA + 32 * (i >> 1)); } while (0)
    DL_LOAD(jmin);
#pragma unroll 1
    for (int j = jmin; j <= 4; ++j) {
        bf16x8 kf[4]; v4u vv[4];
#pragma unroll
        for (int i = 0; i < 4; ++i) { kf[i] = kn[i]; vv[i] = vn[i]; }
        if (j < 4) DL_LOAD(j + 1);
        f32x16 p;
#pragma unroll
        for (int r = 0; r < 16; ++r) p[r] = 0.f;
#pragma unroll
        for (int d0 = 0; d0 < 4; ++d0) p = __builtin_amdgcn_mfma_f32_32x32x16_bf16(kf[d0], qf[d0], p, 0, 0, 0);
        const int du0 = 128 - 32 * j + r32 - 4 * hi;
        const LAS float* tb = tab + du0 - 27;
#pragma unroll
        for (int r = 0; r < 16; ++r) p[r] += tb[27 - DA_CST0(r)];
        if (j == 0 || j == 4) {
#pragma unroll
            for (int r = 0; r < 16; ++r) { const int du = du0 - DA_CST0(r); if (du < 0 || du > 128) p[r] = -INFINITY; }
        }
        float rm = p[0];
#pragma unroll
        for (int r = 1; r < 16; ++r) rm = fmaxf(rm, p[r]);
        rm = swapmax(rm);
        const float mn = fmaxf(m, rm); const float al = __builtin_amdgcn_exp2f(m - mn); m = mn;
        float ls = 0.f;
#pragma unroll
        for (int r = 0; r < 16; ++r) { p[r] = __builtin_amdgcn_exp2f(p[r] - mn); ls += p[r]; }
        l = l * al + ls;
#pragma unroll
        for (int i = 0; i < 2; ++i)
#pragma unroll
            for (int r = 0; r < 16; ++r) o[i][r] *= al;
        v4u pw[2];
#pragma unroll
        for (int x = 0; x < 4; ++x) { pw[0][x] = cvtpk(p[2 * x], p[2 * x + 1]); pw[1][x] = cvtpk(p[8 + 2 * x], p[9 + 2 * x]); }
#pragma unroll
        for (int i = 0; i < 4; ++i) *(LAS v4u*)(stg + i * 1024 + lane * 16) = vv[i];
#pragma unroll
        for (int db = 0; db < 2; ++db)
#pragma unroll
            for (int ks = 0; ks < 2; ++ks) { const s16x4 lo = vtr(vb + (db * 2 + ks) * 1024), hh = vtr(vb + (db * 2 + ks) * 1024 + 512);
                const bf16x8 vf = (bf16x8){lo[0], lo[1], lo[2], lo[3], hh[0], hh[1], hh[2], hh[3]};
                o[db] = __builtin_amdgcn_mfma_f32_32x32x16_bf16(vf, __builtin_bit_cast(bf16x8, pw[ks]), o[db], 0, 0, 0); }
    }
#undef DL_LOAD
    const float lt = swapsum(l); const float il = 1.f / lt;
    bf16* op = Og + ((size_t)g * TOK + rowb + qtok) * AW + h * 64 + 4 * hi;
#pragma unroll
    for (int i = 0; i < 2; ++i)
#pragma unroll
        for (int rr = 0; rr < 4; ++rr) { v2u w; w.x = cvtpk(o[i][4 * rr] * il, o[i][4 * rr + 1] * il); w.y = cvtpk(o[i][4 * rr + 2] * il, o[i][4 * rr + 3] * il); *(v2u*)(op + 32 * i + 8 * rr) = w; }
    if (hi == 0) LSE[((size_t)g * TOK + rowb + qtok) * 8 + h] = m + __builtin_amdgcn_logf(lt);
}
}

__device__ __forceinline__ void dilated_attn_phase(const bf16* qkv, const float* tabA, bf16* Og, float* LSE, bf16* Oa, LAS unsigned char* lds) {
    PHASE_IDS
#pragma unroll 1
    for (int unit = vcu_; unit < 512; unit += G_) {
        const int b = unit >> 6, h = (unit >> 3) & 7, tb = unit & 7;
        { LAS float* tl = (LAS float*)(lds + dl::TAB); for (int i = tid_; i < 3 * 132; i += NTHR) tl[i] = tabA[((i / 132) * 8 + h) * 132 + (i % 132)]; }
        __syncthreads();
#pragma unroll 1
        for (int i = 0; i < 6; ++i) { const int t = wave + 8 * i; dl::task(b, h, tb, t >> 4, t & 15, qkv, Og, LSE, lds, wave, lane); }
        __syncthreads();
        const size_t tok0 = (size_t)b * SEQ + tb * 512;
#pragma unroll 1
        for (int it = tid_; it < 4096; it += NTHR) { const int tk = it >> 3, ch = it & 7; const size_t tok = tok0 + tk;
            const float l0 = LSE[tok * 8 + h], l1 = LSE[((size_t)TOK + tok) * 8 + h], l2 = LSE[((size_t)2 * TOK + tok) * 8 + h];
            const float mx = fmaxf(l0, fmaxf(l1, l2)); float a0 = __builtin_amdgcn_exp2f(l0 - mx), a1 = __builtin_amdgcn_exp2f(l1 - mx), a2 = __builtin_amdgcn_exp2f(l2 - mx);
            const float inv = 1.f / (a0 + a1 + a2); a0 *= inv; a1 *= inv; a2 *= inv;
            float f0[8], f1[8], f2[8]; ld8(Og + tok * AW + h * 64 + ch * 8, f0); ld8(Og + ((size_t)TOK + tok) * AW + h * 64 + ch * 8, f1); ld8(Og + ((size_t)2 * TOK + tok) * AW + h * 64 + ch * 8, f2);
            float r8[8];
#pragma unroll
            for (int e = 0; e < 8; ++e) r8[e] = a0 * f0[e] + a1 * f1[e] + a2 * f2[e];
            v4u w; w.x = pk2(r8[0], r8[1]); w.y = pk2(r8[2], r8[3]); w.z = pk2(r8[4], r8[5]); w.w = pk2(r8[6], r8[7]);
            *(v4u*)(Oa + tok * AW + h * 64 + ch * 8) = w; }
        __syncthreads();
    }
}

__device__ __forceinline__ float dpp_ror1(float v) { return __builtin_bit_cast(float, __builtin_amdgcn_update_dpp(0, __builtin_bit_cast(int, v), 0x121, 0xf, 0xf, false)); }
__device__ __forceinline__ float dpp_ror2(float v) { return __builtin_bit_cast(float, __builtin_amdgcn_update_dpp(0, __builtin_bit_cast(int, v), 0x122, 0xf, 0xf, false)); }
struct EpiConvGate {
    static constexpr bool PERM = true, AFTER_DRAIN = false, AMAP = true;
    bf16* gated; float* part; float* last; const float* cw; const float* cb;
    __device__ __forceinline__ void operator()(const pg8::f32x4 (&acc)[2][2][4][2], const pg8::Unit& u, int wr, int wc, int fr, int fq) const {
        typedef pg8::f32x4 f4;
        const int blk = u.pm * 2 + wr; const size_t row0 = (size_t)blk * 128;
        const bool is15 = fr == 15, ge14 = fr >= 14;
#pragma unroll
        for (int n = 0; n < 2; ++n) {
            const int j0 = u.pn * 128 + wc * 32 + 8 * fq + 4 * n;
            f4 w[2][3], bb[2];
#pragma unroll
            for (int bj = 0; bj < 2; ++bj) { bb[bj] = *(const f4*)(cb + bj * FF + j0);
#pragma unroll
                for (int jj = 0; jj < 3; ++jj) w[bj][jj] = *(const f4*)(cw + jj * NUP + bj * FF + j0); }
            f4 pv[2] = {(f4){0.f, 0.f, 0.f, 0.f}, (f4){0.f, 0.f, 0.f, 0.f}};
#pragma unroll
            for (int ai = 0; ai < 2; ++ai)
#pragma unroll
                for (int m = 0; m < 4; ++m) {
                    f4 c[2];
#pragma unroll
                    for (int bj = 0; bj < 2; ++bj) { const f4 cur = acc[ai][bj][m][n]; f4 s1, s2;
#pragma unroll
                        for (int e = 0; e < 4; ++e) { s1[e] = dpp_ror1(is15 ? pv[bj][e] : cur[e]); s2[e] = dpp_ror2(ge14 ? pv[bj][e] : cur[e]); }
                        c[bj] = bb[bj] + w[bj][2] * cur + w[bj][1] * s1 + w[bj][0] * s2; pv[bj] = cur; }
                    if (ai == 0 && m == 0 && fr < 2) {
#pragma unroll
                        for (int bj = 0; bj < 2; ++bj) *(f4*)(part + ((size_t)blk * 2 + fr) * NUP + bj * FF + j0) = c[bj];
                    } else {
                        const pg8::f32x2 ga = pg8::gelu_pk((pg8::f32x2){c[0][0], c[0][1]}), gb = pg8::gelu_pk((pg8::f32x2){c[0][2], c[0][3]});
                        v2u o; o.x = pg8::cvt_pk_bf16(ga.x * c[1][0], ga.y * c[1][1]); o.y = pg8::cvt_pk_bf16(gb.x * c[1][2], gb.y * c[1][3]);
                        *(v2u*)(gated + (row0 + 64 * ai + 16 * m + fr) * FF + j0) = o;
                    }
                    if (ai == 1 && m == 3 && ge14) {
#pragma unroll
                        for (int bj = 0; bj < 2; ++bj) *(f4*)(last + ((size_t)blk * 2 + (fr - 14)) * NUP + bj * FF + j0) = acc[1][bj][3][n];
                    }
                }
        }
    }
};
__device__ __forceinline__ void conv_fixup(const float* part, const float* last, const float* cw, bf16* gated) {
    PHASE_IDS
    for (int it = gtid; it < 256 * 2 * 352; it += gstride) {
        const int j = (it % 352) * 8, rho = (it / 352) & 1, blk = it / 704;
        float cg[8], cv[8];
        { const float* pp = part + ((size_t)blk * 2 + rho) * NUP + j;
#pragma unroll
          for (int e = 0; e < 8; ++e) { cg[e] = pp[e]; cv[e] = pp[FF + e]; } }
        if (blk & 31) {
            const float* l0 = last + ((size_t)(blk - 1) * 2) * NUP + j; const float* l1 = l0 + NUP;
#pragma unroll
            for (int e = 0; e < 8; ++e) {
                if (rho == 0) { cg[e] += cw[NUP + j + e] * l1[e] + cw[j + e] * l0[e]; cv[e] += cw[NUP + FF + j + e] * l1[FF + e] + cw[FF + j + e] * l0[FF + e]; }
                else { cg[e] += cw[j + e] * l1[e]; cv[e] += cw[FF + j + e] * l1[FF + e]; } }
        }
        float r[8];
#pragma unroll
        for (int e = 0; e < 8; e += 2) { const pg8::f32x2 g2 = pg8::gelu_pk((pg8::f32x2){cg[e], cg[e + 1]}); r[e] = g2.x * cv[e]; r[e + 1] = g2.y * cv[e + 1]; }
        v4u w; w.x = pk2(r[0], r[1]); w.y = pk2(r[2], r[3]); w.z = pk2(r[4], r[5]); w.w = pk2(r[6], r[7]);
        *(v4u*)(gated + ((size_t)blk * 128 + rho) * FF + j) = w;
    }
}

#define XB_TMO      128
#define XB_XCNT(j)  (256  + 64 * (j))
#define XB_XSUB(j)  (1280 + 64 * (j))
#define XB_XGEN(j)  (2304 + 64 * (j))
#define XB_TOP      3328
#define XB_TOPGEN   3392
#define XCD_BAR_WORDS 3456
#define XB_SPIN_CAP (1u << 18)

__device__ __forceinline__ unsigned xb_ld(unsigned* p)              { return __hip_atomic_load(p, __ATOMIC_RELAXED, __HIP_MEMORY_SCOPE_AGENT); }
__device__ __forceinline__ unsigned xb_add(unsigned* p, unsigned v) { return __hip_atomic_fetch_add(p, v, __ATOMIC_RELAXED, __HIP_MEMORY_SCOPE_AGENT); }
__device__ __forceinline__ unsigned xb_xcc_id() { return (unsigned)__builtin_amdgcn_s_getreg((3 << 11) | 20) & 0xFu; }
#define XB_SPIN(cond, bar) do { unsigned _sp = 0; while (cond) { __builtin_amdgcn_s_sleep(1); \
    if ((++_sp & 255u) == 0u) { if (xb_ld(&(bar)[XB_TMO])) break; if (_sp > XB_SPIN_CAP) { atomicAdd(&(bar)[XB_TMO], 1u); break; } } } } while (0)

struct XcdBarrier {
    unsigned* bar; unsigned x;
    volatile LAS unsigned* st;
};

__device__ __forceinline__ XcdBarrier xcd_barrier_post(unsigned* bar, volatile LAS unsigned* st) {
    XcdBarrier b; b.bar = bar; b.x = xb_xcc_id(); b.st = st;
    if (threadIdx.x == 0) (void)xb_add(&bar[XB_XCNT(b.x)], 1u);
    return b;
}
__device__ __forceinline__ void xcd_barrier_complete(unsigned* bar, unsigned x, unsigned& nloc, unsigned& nx) {
    const unsigned G = gridDim.x * gridDim.y * gridDim.z;
    unsigned sum, cnt, mine, sp = 0u;
    for (;;) {
        sum = 0u; cnt = 0u; mine = 0u;
#pragma unroll
        for (unsigned j = 0; j < 16; ++j) { const unsigned c = xb_ld(&bar[XB_XCNT(j)]); sum += c; cnt += (c > 0u) ? 1u : 0u; mine = (j == x) ? c : mine; }
        if (sum == G) break;
        __builtin_amdgcn_s_sleep(1);
        if ((++sp & 255u) == 0u) { if (xb_ld(&bar[XB_TMO])) break; if (sp > XB_SPIN_CAP) { atomicAdd(&bar[XB_TMO], 1u); break; } }
    }
    nloc = mine > 0u ? mine : 1u; nx = cnt > 0u ? cnt : 1u;
}

__device__ __forceinline__ void xcd_barrier(const XcdBarrier& b) {
    asm volatile("s_waitcnt vmcnt(0)" ::: "memory");
    __syncthreads();
    if (threadIdx.x == 0) {
        unsigned* bar = b.bar; asm volatile("" : "+s"(bar));
        __builtin_amdgcn_s_waitcnt(0);
        unsigned bx_ = b.x; asm volatile("" : "+s"(bx_));
        unsigned nloc = b.st[0], nx = b.st[1];
        if (nloc == 0u) { xcd_barrier_complete(bar, bx_, nloc, nx); b.st[0] = nloc; b.st[1] = nx; }
        const unsigned old = xb_add(&bar[XB_XSUB(bx_)], 1u);
        const unsigned gen = old / nloc;
        if (old + 1u == (gen + 1u) * nloc) {
            __builtin_amdgcn_fence(__ATOMIC_RELEASE, "agent");
            asm volatile("s_waitcnt vmcnt(0)" ::: "memory");
            const unsigned og = xb_add(&bar[XB_TOP], 1u);
            const unsigned tg = og / nx;
            if (og + 1u == (tg + 1u) * nx) xb_add(&bar[XB_TOPGEN], 1u);
            else XB_SPIN(xb_ld(&bar[XB_TOPGEN]) == tg, bar);
            __builtin_amdgcn_fence(__ATOMIC_ACQUIRE, "agent");
            xb_add(&bar[XB_XGEN(bx_)], 1u);
            asm volatile("s_waitcnt vmcnt(0)" ::: "memory");
        } else {
            XB_SPIN(xb_ld(&bar[XB_XGEN(bx_)]) == gen, bar);
            __builtin_amdgcn_fence(__ATOMIC_ACQUIRE, "agent");
            asm volatile("s_waitcnt vmcnt(0)" ::: "memory");
        }
    }
    __syncthreads();
}

namespace cg = cooperative_groups;
#define GEMM_PHASE(A_, B_, M_, N_, K_, O_, LDC_) do { pg8::Gemm g{(const bf16*)(A_), (const bf16*)(B_), M_, N_, K_}; pg8::StaticOrder S; S.init(M_, N_, (int)gridDim.x, (int)blockIdx.x); \
    pg8::EpiBf16<0> E{(bf16*)(O_), LDC_, nullptr, 0, 0, 1.f}; pg8::gemm_phase<pg8::EpiBf16<0>, pg8::StaticOrder, PG8_ALIGN, PG8_SP2>(lds, g, S, E); } while (0)
__global__ void __launch_bounds__(NTHR, 2) fwd(Args a) {
    extern __shared__ __attribute__((aligned(16))) unsigned char lds_raw[];
    LAS unsigned char* lds = (LAS unsigned char*)lds_raw;
    cg::grid_group grid = cg::this_grid();
    { volatile LAS unsigned* misc = (volatile LAS unsigned*)(lds + LDS_MISC_OFF); if (threadIdx.x < 32) misc[threadIdx.x] = 0u; }
    __syncthreads();
    XcdBarrier bar = xcd_barrier_post((unsigned*)(a.ws + WS_CTL) + 1024, (volatile LAS unsigned*)(lds + LDS_MISC_OFF) + 8);
    unsigned char* ws = a.ws;
    prologue(a, lds); grid.sync();
    const float* xin = a.in[0]; float* out = a.out;
#define WSP(T, off) ((T*)(ws + (off)))
#define PARP(off) (WSP(const float, WS_PAR) + (off))
    GEMM_PHASE(WSP(bf16, WS_XN), ws + WS_WIN, TOK, NQKVA, DM, WSP(bf16, WS_BIG), NQKVA); xcd_barrier(bar);
    dilated_attn_phase(WSP(const bf16, WS_BIG), WSP(const float, WS_TABA), WSP(bf16, 416 * MiB), WSP(float, 64 * MiB), WSP(bf16, 68 * MiB), lds); xcd_barrier(bar);
    GEMM_PHASE(WSP(bf16, 68 * MiB), ws + WS_WOA, TOK, DM, AW, WSP(bf16, WS_MIX), DM); xcd_barrier(bar);
    rowpass(WSP(const bf16, WS_MIX), PARP(PAR_NORMG + 1 * DM), xin, out, WSP(bf16, WS_XN)); xcd_barrier(bar);
#pragma unroll 1
    for (int lay = 0; lay < 2; ++lay) {
        if (lay == 1) {
            GEMM_PHASE(WSP(bf16, WS_XN), ws + WS_WKVQ, TOK, NKVQ, DM, WSP(bf16, WS_BIG), NKVQ); xcd_barrier(bar);
            diff_attn_phase<0>(WSP(const bf16, WS_BIG), WSP(const float, WS_TABB), PARP(0), WSP(bf16, 320 * MiB), lds); xcd_barrier(bar);
#ifdef PROBE_MODE
            diff_attn_phase<PROBE_MODE>(WSP(const bf16, WS_BIG), WSP(const float, WS_TABB), PARP(0), WSP(bf16, 384 * MiB), lds); xcd_barrier(bar);
#endif
            GEMM_PHASE(WSP(bf16, 320 * MiB), ws + WS_WOB, TOK, DM, DM, WSP(bf16, WS_MIX), DM); xcd_barrier(bar);
            rowpass(WSP(const bf16, WS_MIX), PARP(PAR_NORMG + 5 * DM), out, out, WSP(bf16, WS_XN)); xcd_barrier(bar);
        }
        { pg8::Gemm g{WSP(const bf16, WS_XN), (const bf16*)(ws + (lay ? WS_WUP1 : WS_WUP0)), TOK, NUP, DM}; pg8::StaticOrder S; S.init(TOK, NUP, (int)gridDim.x, (int)blockIdx.x);
          EpiConvGate E{WSP(bf16, WS_GATED), WSP(float, WS_PART), WSP(float, WS_LAST), PARP(PAR_CONVW + lay * 3 * NUP), PARP(PAR_CONVB + lay * NUP)};
          pg8::gemm_phase<EpiConvGate, pg8::StaticOrder, PG8_ALIGN, PG8_SP2>(lds, g, S, E); }
        xcd_barrier(bar);
        conv_fixup(WSP(const float, WS_PART), WSP(const float, WS_LAST), PARP(PAR_CONVW + lay * 3 * NUP), WSP(bf16, WS_GATED)); xcd_barrier(bar);
        GEMM_PHASE(WSP(bf16, WS_GATED), ws + (lay ? WS_WDN1 : WS_WDN0), TOK, DM, FF, WSP(bf16, WS_MIX), DM); xcd_barrier(bar);
        rowpass(WSP(const bf16, WS_MIX), PARP(PAR_NORMG + (lay * 4 + 3) * DM), out, out, lay == 0 ? WSP(bf16, WS_XN) : (bf16*)nullptr);
        if (lay == 0) xcd_barrier(bar);
    }
}

extern "C" void kernel_launch(void* const* d_in, const int* in_sizes, int n_in, void* d_out, int out_size, void* d_ws, size_t ws_size, hipStream_t stream) {
    static int grid = 0;
    if (grid == 0) {
        if (n_in != 19 || in_sizes[0] != TOK * DM || out_size != TOK * DM || ws_size < WS_END) {
            fprintf(stderr, "kernel_launch: unexpected shapes: n_in %d in0 %d out %d ws %zu (need %zu)\n", n_in, n_in > 0 ? in_sizes[0] : -1, out_size, ws_size, (size_t)WS_END); grid = -1; return; }
        int dev = 0, cus = 0, per_cu = 0;
        if (hipGetDevice(&dev) != hipSuccess || hipDeviceGetAttribute(&cus, hipDeviceAttributeMultiprocessorCount, dev) != hipSuccess) { grid = -1; return; }
        if (hipFuncSetAttribute((const void*)fwd, hipFuncAttributeMaxDynamicSharedMemorySize, LDS_BYTES) != hipSuccess) { fprintf(stderr, "kernel_launch: hipFuncSetAttribute failed\n"); grid = -1; return; }
        if (hipOccupancyMaxActiveBlocksPerMultiprocessor(&per_cu, (const void*)fwd, NTHR, LDS_BYTES) != hipSuccess || per_cu < 1) { fprintf(stderr, "kernel_launch: occupancy query says %d blocks/CU\n", per_cu); grid = -1; return; }
        grid = cus;
    }
    if (grid < 0) return;
    Args a{};
    for (int i = 0; i < 19; ++i) a.in[i] = (const float*)d_in[i];
    a.out = (float*)d_out; a.ws = (unsigned char*)d_ws;
    if (hipMemsetAsync((char*)d_ws + WS_CTL, 0, CTL_ZERO_BYTES, stream) != hipSuccess) { fprintf(stderr, "kernel_launch: hipMemsetAsync failed\n"); return; }
    void* args[] = {&a};
    hipError_t e = hipLaunchCooperativeKernel((const void*)fwd, dim3(grid), dim3(NTHR), args, LDS_BYTES, stream);
    if (e != hipSuccess) fprintf(stderr, "cooperative launch failed: %s (grid %d)\n", hipGetErrorString(e), grid);
}
```
